# Optimizing an MI355X kernel written in HIP

```python
import math
import jax
import jax.numpy as jnp
from jax import lax
import numpy as np

D_MODEL = 1024
BATCH = 8
SEQ = 4096
DEPTH = 2

GDN_HEADS = 4
GDN_HEAD_DIM = 128
GDN_WIDTH = GDN_HEADS * GDN_HEAD_DIM
GDN_CONV = 4
GDN_CHUNK = 64
S5_GROUP = 16
S5_GROUPS = 16
S5_WIDTH = S5_GROUPS * S5_GROUP
S5_STATE = 64
MOBA_HEADS = 4
MOBA_HEAD_DIM = 64
MOBA_WIDTH = MOBA_HEADS * MOBA_HEAD_DIM
MOBA_BLOCK = 256
MOBA_TOPK = 3
MOBA_Q_CHUNK = 64
N_BRANCH = 3
IN_SIZES = (3 * GDN_WIDTH, GDN_WIDTH, GDN_HEADS, GDN_HEADS, S5_WIDTH, 3 * MOBA_WIDTH, N_BRANCH * D_MODEL)
IN_COLS = 3 * GDN_WIDTH + GDN_WIDTH + 2 * GDN_HEADS + S5_WIDTH + 3 * MOBA_WIDTH + N_BRANCH * D_MODEL
PEER_HEADS = 8
PEER_NKEYS = 128
PEER_EXPERTS = PEER_NKEYS * PEER_NKEYS
PEER_QDIM = 256
PEER_TOPK = 16
PEER_TOKEN_CHUNK = 128
RMS_EPS = 1e-6
NEG_INF = -1e30

kernel_name = 'hybrid_gdn_s5_moba_peer_adaln'

F32 = jnp.float32


def _rmsnorm(x, w):
    xf = x.astype(F32)
    y = xf * lax.rsqrt(jnp.mean(xf * xf, axis=-1, keepdims=True) + RMS_EPS)
    return (y * w.astype(F32)).astype(x.dtype)


def _l2norm(t):
    return t * lax.rsqrt(jnp.sum(t * t, axis=-1, keepdims=True) + 1e-6)


def _causal_conv(x, w):
    k, ch = w.shape
    return lax.conv_general_dilated(
        x, w[:, None, :].astype(x.dtype), window_strides=(1,), padding=[(k - 1, 0)],
        dimension_numbers=('NWC', 'WIO', 'NWC'), feature_group_count=ch)


def _inv_unit_lower(a):
    n = -a
    eye = jnp.eye(a.shape[-1], dtype=a.dtype)
    t = eye + n
    p = n
    for _ in range(int(math.log2(a.shape[-1])) - 1):
        p = p @ p
        t = t + t @ p
    return t


def _gated_delta_rule(q, k, v, g, beta):
    bt, nh, L, dk = q.shape
    dv = v.shape[-1]
    C = GDN_CHUNK
    nc = L // C
    q, k, v = (t.reshape(bt, nh, nc, C, -1) for t in (q, k, v))
    g = jnp.cumsum(g.reshape(bt, nh, nc, C), axis=-1)
    beta = beta.reshape(bt, nh, nc, C)
    tril = jnp.tril(jnp.ones((C, C), bool))
    strict = jnp.tril(jnp.ones((C, C), bool), -1)
    diff = g[..., :, None] - g[..., None, :]
    decay = jnp.where(tril, jnp.exp(jnp.where(tril, diff, 0.0)), 0.0)
    k_beta = k * beta[..., None]
    a = jnp.where(strict, jnp.einsum('bhnid,bhnjd->bhnij', k_beta, k) * decay, 0.0)
    t_inv = _inv_unit_lower(a)
    u = t_inv @ (v * beta[..., None])
    w = t_inv @ (k_beta * jnp.exp(g)[..., None])
    qk = jnp.where(tril, jnp.einsum('bhnid,bhnjd->bhnij', q, k) * decay, 0.0)

    def step(state, xs):
        q_c, k_c, u_c, w_c, qk_c, g_c = xs
        v_new = u_c - jnp.einsum('bhck,bhkv->bhcv', w_c, state)
        o = (jnp.einsum('bhck,bhkv->bhcv', q_c * jnp.exp(g_c)[..., None], state)
             + jnp.einsum('bhcs,bhsv->bhcv', qk_c, v_new))
        g_last = g_c[..., -1:]
        state = (state * jnp.exp(g_last)[..., None]
                 + jnp.einsum('bhck,bhcv->bhkv', k_c * jnp.exp(g_last - g_c)[..., None], v_new))
        return state, o

    xs = tuple(jnp.moveaxis(t, 2, 0) for t in (q, k, u, w, qk, g))
    state0 = jnp.zeros((bt, nh, dk, dv), F32)
    _, o = lax.scan(step, state0, xs)
    return jnp.moveaxis(o, 0, 2).reshape(bt, nh, L, dv)


def _gdn_branch(qkv, z, b, a, conv_w, a_log, dt_bias, norm_w):
    bt, L, _ = qkv.shape
    qkv = jax.nn.silu(_causal_conv(qkv, conv_w))
    q, k, v = jnp.split(qkv, 3, axis=-1)
    heads = lambda t: t.reshape(bt, L, GDN_HEADS, GDN_HEAD_DIM).transpose(0, 2, 1, 3).astype(F32)
    q = _l2norm(heads(q)) * (GDN_HEAD_DIM ** -0.5)
    k = _l2norm(heads(k))
    v = heads(v)
    beta = jax.nn.sigmoid(b.astype(F32)).transpose(0, 2, 1)
    g = (-jnp.exp(a_log.astype(F32)) * jax.nn.softplus(a.astype(F32) + dt_bias.astype(F32))).transpose(0, 2, 1)
    o = _gated_delta_rule(q, k, v, g, beta).transpose(0, 2, 1, 3)
    zf = z.reshape(bt, L, GDN_HEADS, GDN_HEAD_DIM).astype(F32)
    o = o * lax.rsqrt(jnp.mean(o * o, axis=-1, keepdims=True) + RMS_EPS) * norm_w.astype(F32) * jax.nn.silu(zf)
    return o.reshape(bt, L, GDN_WIDTH).astype(qkv.dtype)


def _s5_branch(u, a_re, a_im, b_re, b_im, c_re, c_im, d, log_dt, glu_w, glu_b):
    bt, L, _ = u.shape
    uf = u.astype(F32)
    ug = uf.reshape(bt, L, S5_GROUPS, S5_GROUP)
    lam = lax.complex(a_re.astype(F32), a_im.astype(F32))
    dt = jnp.exp(log_dt.astype(F32))[:, None]
    a_bar = jnp.exp(lam * dt)
    b_bar = ((a_bar - 1.0) / lam)[..., None] * lax.complex(b_re.astype(F32), b_im.astype(F32))
    bu = lax.complex(jnp.einsum('gph,blgh->lbgp', jnp.real(b_bar), ug),
                     jnp.einsum('gph,blgh->lbgp', jnp.imag(b_bar), ug))
    a_seq = jnp.broadcast_to(a_bar, (L, 1) + a_bar.shape)

    def combine(e1, e2):
        a1, s1 = e1
        a2, s2 = e2
        return a1 * a2, a2 * s1 + s2

    _, states = lax.associative_scan(combine, (a_seq, bu), axis=0)
    y = (jnp.einsum('ghp,lbgp->blgh', c_re.astype(F32), jnp.real(states))
         - jnp.einsum('ghp,lbgp->blgh', c_im.astype(F32), jnp.imag(states)))
    y = y.reshape(bt, L, S5_WIDTH) + d.astype(F32) * uf
    zg = jax.nn.gelu(y, approximate=False)
    zz = zg @ glu_w.astype(F32) + glu_b.astype(F32)
    out = zz[..., :S5_WIDTH] * jax.nn.sigmoid(zz[..., S5_WIDTH:])
    return out.astype(u.dtype)


def _moba_attention(q, k, v):
    bt, nh, L, dh = q.shape
    n_blk = -(-L // MOBA_BLOCK)
    lp = n_blk * MOBA_BLOCK
    pad = [(0, 0), (0, 0), (0, lp - L), (0, 0)]
    q, k, v = (jnp.pad(t, pad).astype(F32) for t in (q, k, v))
    kb = k.reshape(bt, nh, n_blk, MOBA_BLOCK, dh)
    vb = v.reshape(bt, nh, n_blk, MOBA_BLOCK, dh)
    k_mean = jnp.mean(kb, axis=3)
    gate = jnp.einsum('bhld,bhnd->bhln', q, k_mean)
    q_blk = jnp.arange(lp) // MOBA_BLOCK
    past = jnp.arange(n_blk)[None, :] < q_blk[:, None]
    gate = jnp.where(past, gate, NEG_INF)
    n_sel = min(MOBA_TOPK, n_blk)
    _, sel = lax.top_k(gate, n_sel)
    scale = dh ** -0.5
    b_ix = jnp.arange(bt)[:, None, None, None]
    h_ix = jnp.arange(nh)[None, :, None, None]

    def one_chunk(ci):
        start = ci * MOBA_Q_CHUNK
        own = start // MOBA_BLOCK
        qc = lax.dynamic_slice_in_dim(q, start, MOBA_Q_CHUNK, axis=2)
        sc = lax.dynamic_slice_in_dim(sel, start, MOBA_Q_CHUNK, axis=2)
        k_sel = kb[b_ix, h_ix, sc]
        v_sel = vb[b_ix, h_ix, sc]
        s_sel = jnp.einsum('bhqd,bhqnsd->bhqns', qc, k_sel) * scale
        s_sel = jnp.where((sc < own)[..., None], s_sel, NEG_INF)
        k_own = lax.dynamic_index_in_dim(kb, own, axis=2, keepdims=False)
        v_own = lax.dynamic_index_in_dim(vb, own, axis=2, keepdims=False)
        s_own = jnp.einsum('bhqd,bhsd->bhqs', qc, k_own) * scale
        q_pos = start + jnp.arange(MOBA_Q_CHUNK)
        k_pos = own * MOBA_BLOCK + jnp.arange(MOBA_BLOCK)
        s_own = jnp.where(k_pos[None, :] <= q_pos[:, None], s_own, NEG_INF)
        s_all = jnp.concatenate([s_sel.reshape(bt, nh, MOBA_Q_CHUNK, n_sel * MOBA_BLOCK), s_own], axis=-1)
        p = jax.nn.softmax(s_all, axis=-1)
        p_sel = p[..., :n_sel * MOBA_BLOCK].reshape(bt, nh, MOBA_Q_CHUNK, n_sel, MOBA_BLOCK)
        p_own = p[..., n_sel * MOBA_BLOCK:]
        return (jnp.einsum('bhqns,bhqnsd->bhqd', p_sel, v_sel)
                + jnp.einsum('bhqs,bhsd->bhqd', p_own, v_own))

    out = lax.map(one_chunk, jnp.arange(lp // MOBA_Q_CHUNK))
    return jnp.moveaxis(out, 0, 2).reshape(bt, nh, lp, dh)[:, :, :L]


def _moba_branch(qkv):
    bt, L, _ = qkv.shape
    q, k, v = jnp.split(qkv, 3, axis=-1)
    heads = lambda t: t.reshape(bt, L, MOBA_HEADS, MOBA_HEAD_DIM).transpose(0, 2, 1, 3)
    o = _moba_attention(heads(q), heads(k), heads(v))
    return o.transpose(0, 2, 1, 3).reshape(bt, L, MOBA_WIDTH).astype(qkv.dtype)


def _hybrid_mixer(h, w_in, conv_w, a_log, dt_bias, gdn_norm_w,
                  s5_a_re, s5_a_im, s5_b_re, s5_b_im, s5_c_re, s5_c_im, s5_d, s5_log_dt,
                  s5_glu_w, s5_glu_b, w_branch_a, w_branch_b, w_branch_c, w_out):
    bt, L, _ = h.shape
    p = h @ w_in
    cuts = np.cumsum(IN_SIZES)[:-1].tolist()
    qkv_a, z_a, beta_a, alpha_a, u_b, qkv_c, gate_in = jnp.split(p, cuts, axis=-1)
    y_a = _gdn_branch(qkv_a, z_a, beta_a, alpha_a, conv_w, a_log, dt_bias, gdn_norm_w) @ w_branch_a
    y_b = _s5_branch(u_b, s5_a_re, s5_a_im, s5_b_re, s5_b_im, s5_c_re, s5_c_im, s5_d,
                     s5_log_dt, s5_glu_w, s5_glu_b) @ w_branch_b
    y_c = _moba_branch(qkv_c) @ w_branch_c
    gates = jax.nn.sigmoid(gate_in.astype(F32)).astype(h.dtype).reshape(bt, L, N_BRANCH, D_MODEL)
    merged = gates[:, :, 0] * y_a + gates[:, :, 1] * y_b + gates[:, :, 2] * y_c
    return merged @ w_out


def _peer(h, wq, k1, k2, u_tab, v_tab):
    bt, L, d = h.shape
    half = PEER_QDIM // 2
    q = (h @ wq).astype(F32).reshape(bt, L, PEER_HEADS, PEER_QDIM)
    s1 = jnp.einsum('blhd,hnd->blhn', q[..., :half], k1.astype(F32))
    s2 = jnp.einsum('blhd,hnd->blhn', q[..., half:], k2.astype(F32))
    v1, i1 = lax.top_k(s1, PEER_TOPK)
    v2, i2 = lax.top_k(s2, PEER_TOPK)
    n_cand = PEER_TOPK * PEER_TOPK
    cand_s = (v1[..., :, None] + v2[..., None, :]).reshape(bt, L, PEER_HEADS, n_cand)
    cand_i = (i1[..., :, None] * PEER_NKEYS + i2[..., None, :]).reshape(bt, L, PEER_HEADS, n_cand)
    top_s, pos = lax.top_k(cand_s, PEER_TOPK)
    expert = jnp.take_along_axis(cand_i, pos, axis=-1)
    gate = jax.nn.softmax(top_s, axis=-1)
    n_sel = PEER_HEADS * PEER_TOPK
    n_chunk = (bt * L) // PEER_TOKEN_CHUNK
    hs = h.reshape(n_chunk, PEER_TOKEN_CHUNK, d)
    es = expert.reshape(n_chunk, PEER_TOKEN_CHUNK, n_sel)
    gs = gate.reshape(n_chunk, PEER_TOKEN_CHUNK, n_sel)

    def chunk(args):
        hc, ec, gc = args
        act = jax.nn.gelu(jnp.einsum('td,tkd->tk', hc.astype(F32), u_tab[ec].astype(F32)), approximate=False)
        return jnp.einsum('tk,tkd->td', gc * act, v_tab[ec].astype(F32))

    out = lax.map(chunk, (hs, es, gs))
    return out.reshape(bt, L, d).astype(h.dtype)


def setup_inputs(seed: int = 0) -> dict:
    key = jax.random.key(seed)
    ks = iter(jax.random.split(key, 48))
    nrm = lambda shape, s: jax.random.normal(next(ks), shape, F32) * s
    D = D_MODEL
    L = DEPTH
    G, P = S5_GROUPS, S5_STATE
    x = nrm((BATCH, SEQ, D), 1.0)
    c = nrm((BATCH, D), 1.0)
    ada_w = nrm((L, D, 6 * D), 0.5 * D ** -0.5)
    ada_b = nrm((L, 6 * D), 0.02)
    norm1_w = 1.0 + nrm((L, D), 0.02)
    w_in = nrm((L, D, IN_COLS), D ** -0.5)
    gdn_conv_w = nrm((L, GDN_CONV, 3 * GDN_WIDTH), GDN_CONV ** -0.5)
    gdn_a_log = jnp.log(jax.random.uniform(next(ks), (L, GDN_HEADS), F32, 1.0, 16.0))
    dt0 = jnp.exp(jax.random.uniform(next(ks), (L, GDN_HEADS), F32, math.log(1e-3), math.log(1e-1)))
    gdn_dt_bias = dt0 + jnp.log(-jnp.expm1(-dt0))
    gdn_norm_w = 1.0 + nrm((L, GDN_HEAD_DIM), 0.02)
    s5_a_re = -0.5 * jnp.exp(nrm((L, G, P), 0.02))
    s5_a_im = jnp.pi * jnp.arange(P, dtype=F32) + nrm((L, G, P), 0.02)
    s5_b_re = nrm((L, G, P, S5_GROUP), (2 * S5_GROUP) ** -0.5)
    s5_b_im = nrm((L, G, P, S5_GROUP), (2 * S5_GROUP) ** -0.5)
    s5_c_re = nrm((L, G, S5_GROUP, P), (2 * P) ** -0.5)
    s5_c_im = nrm((L, G, S5_GROUP, P), (2 * P) ** -0.5)
    s5_d = nrm((L, S5_WIDTH), 1.0)
    s5_log_dt = jax.random.uniform(next(ks), (L, G), F32, math.log(1e-3), math.log(1e-1))
    s5_glu_w = nrm((L, S5_WIDTH, 2 * S5_WIDTH), S5_WIDTH ** -0.5)
    s5_glu_b = nrm((L, 2 * S5_WIDTH), 0.02)
    w_branch_a = nrm((L, GDN_WIDTH, D), GDN_WIDTH ** -0.5)
    w_branch_b = nrm((L, S5_WIDTH, D), S5_WIDTH ** -0.5)
    w_branch_c = nrm((L, MOBA_WIDTH, D), MOBA_WIDTH ** -0.5)
    w_out = nrm((L, D, D), D ** -0.5)
    norm2_w = 1.0 + nrm((L, D), 0.02)
    peer_wq = nrm((L, D, PEER_HEADS * PEER_QDIM), D ** -0.5)
    peer_k1 = nrm((L, PEER_HEADS, PEER_NKEYS, PEER_QDIM // 2), (PEER_QDIM // 2) ** -0.5)
    peer_k2 = nrm((L, PEER_HEADS, PEER_NKEYS, PEER_QDIM // 2), (PEER_QDIM // 2) ** -0.5)
    peer_u = nrm((L, PEER_EXPERTS, D), D ** -0.5)
    peer_v = nrm((L, PEER_EXPERTS, D), 0.5)
    final_norm_w = 1.0 + nrm((D,), 0.02)
    return {'x': x, 'c': c, 'ada_w': ada_w, 'ada_b': ada_b, 'norm1_w': norm1_w, 'w_in': w_in,
            'gdn_conv_w': gdn_conv_w, 'gdn_a_log': gdn_a_log, 'gdn_dt_bias': gdn_dt_bias,
            'gdn_norm_w': gdn_norm_w, 's5_a_re': s5_a_re, 's5_a_im': s5_a_im, 's5_b_re': s5_b_re,
            's5_b_im': s5_b_im, 's5_c_re': s5_c_re, 's5_c_im': s5_c_im, 's5_d': s5_d,
            's5_log_dt': s5_log_dt, 's5_glu_w': s5_glu_w, 's5_glu_b': s5_glu_b,
            'w_branch_a': w_branch_a, 'w_branch_b': w_branch_b, 'w_branch_c': w_branch_c,
            'w_out': w_out, 'norm2_w': norm2_w, 'peer_wq': peer_wq, 'peer_k1': peer_k1,
            'peer_k2': peer_k2, 'peer_u': peer_u, 'peer_v': peer_v, 'final_norm_w': final_norm_w}


def reference(x, c, ada_w, ada_b, norm1_w, w_in, gdn_conv_w, gdn_a_log, gdn_dt_bias, gdn_norm_w,
              s5_a_re, s5_a_im, s5_b_re, s5_b_im, s5_c_re, s5_c_im, s5_d, s5_log_dt, s5_glu_w,
              s5_glu_b, w_branch_a, w_branch_b, w_branch_c, w_out, norm2_w, peer_wq, peer_k1,
              peer_k2, peer_u, peer_v, final_norm_w):
    for l in range(DEPTH):
        mod = jax.nn.silu(c) @ ada_w[l] + ada_b[l]
        sh1, sc1, g1, sh2, sc2, g2 = jnp.split(mod[:, None, :], 6, axis=-1)
        h = _rmsnorm(x, norm1_w[l]) * (1.0 + sc1) + sh1
        x = x + g1 * _hybrid_mixer(h, w_in[l], gdn_conv_w[l], gdn_a_log[l], gdn_dt_bias[l], gdn_norm_w[l],
                                   s5_a_re[l], s5_a_im[l], s5_b_re[l], s5_b_im[l], s5_c_re[l], s5_c_im[l],
                                   s5_d[l], s5_log_dt[l], s5_glu_w[l], s5_glu_b[l],
                                   w_branch_a[l], w_branch_b[l], w_branch_c[l], w_out[l])
        h = _rmsnorm(x, norm2_w[l]) * (1.0 + sc2) + sh2
        x = x + g2 * _peer(h, peer_wq[l], peer_k1[l], peer_k2[l], peer_u[l], peer_v[l])
    return _rmsnorm(x, final_norm_w)
```

```cpp
#include <hip/hip_runtime.h>
#include <math.h>

#define D_MODEL 1024
#define BATCH 8
#define SEQ 4096
#define DEPTH 2
#define IN_COLS 6152
#define OFF_GQKV 0
#define OFF_GZ 1536
#define OFF_GBETA 2048
#define OFF_GALPHA 2052
#define OFF_S5U 2056
#define OFF_MQKV 2312
#define OFF_GATE 3080
#define PEER_E 16384

__device__ __forceinline__ float silu_f(float x) { return x / (1.f + expf(-x)); }
__device__ __forceinline__ float sigmoid_f(float x) { return 1.f / (1.f + expf(-x)); }
__device__ __forceinline__ float gelu_f(float x) { return 0.5f * x * (1.f + erff(x * 0.70710678118654752f)); }
__device__ __forceinline__ float softplus_f(float x) { return fmaxf(x, 0.f) + log1pf(expf(-fabsf(x))); }

__device__ __forceinline__ float wave_sum(float v) {
  for (int o = 32; o > 0; o >>= 1) v += __shfl_xor(v, o);
  return v;
}
__device__ __forceinline__ float wave_max(float v) {
  for (int o = 32; o > 0; o >>= 1) v = fmaxf(v, __shfl_xor(v, o));
  return v;
}

__global__ void k_mod(const float* __restrict__ c, const float* __restrict__ ada_w,
                      const float* __restrict__ ada_b, float* __restrict__ mod) {
  int j = blockIdx.x * 256 + threadIdx.x;
  int l = blockIdx.y;
  __shared__ float sc[BATCH][D_MODEL];
  for (int i = threadIdx.x; i < BATCH * D_MODEL; i += 256) sc[i / D_MODEL][i % D_MODEL] = silu_f(c[i]);
  __syncthreads();
  float acc[BATCH];
  for (int b = 0; b < BATCH; b++) acc[b] = 0.f;
  const float* w = ada_w + (size_t)l * D_MODEL * 6144 + j;
  for (int i = 0; i < D_MODEL; i++) {
    float wv = w[(size_t)i * 6144];
#pragma unroll
    for (int b = 0; b < BATCH; b++) acc[b] += sc[b][i] * wv;
  }
  float bb = ada_b[l * 6144 + j];
#pragma unroll
  for (int b = 0; b < BATCH; b++) mod[((size_t)l * BATCH + b) * 6144 + j] = acc[b] + bb;
}

__global__ void k_modnorm(const float* __restrict__ x, const float* __restrict__ w,
                          const float* __restrict__ sh, const float* __restrict__ sc,
                          float* __restrict__ h) {
  int t = blockIdx.x;
  const float* xr = x + (size_t)t * D_MODEL;
  float v[4];
  float ss = 0.f;
  for (int i = 0; i < 4; i++) { v[i] = xr[threadIdx.x + i * 256]; ss += v[i] * v[i]; }
  __shared__ float red[4];
  ss = wave_sum(ss);
  if ((threadIdx.x & 63) == 0) red[threadIdx.x >> 6] = ss;
  __syncthreads();
  float tot = red[0] + red[1] + red[2] + red[3];
  float r = rsqrtf(tot / D_MODEL + 1e-6f);
  for (int i = 0; i < 4; i++) {
    int d = threadIdx.x + i * 256;
    float y = v[i] * r * w[d];
    if (sh) y = y * (1.f + sc[d]) + sh[d];
    h[(size_t)t * D_MODEL + d] = y;
  }
}

__global__ void k_gemm(const float* __restrict__ A, int lda, const float* __restrict__ B, int ldb,
                       float* __restrict__ C, int ldc, int M, int N, int K) {
  __shared__ float As[16][64 + 4];
  __shared__ float Bs[16][64 + 4];
  int tx = threadIdx.x & 15, ty = threadIdx.x >> 4;
  int m0 = blockIdx.y * 64, n0 = blockIdx.x * 64;
  float acc[4][4] = {};
  for (int k0 = 0; k0 < K; k0 += 16) {
    for (int i = threadIdx.x; i < 64 * 16; i += 256) {
      int r = i >> 4, kk = i & 15;
      As[kk][r] = A[(size_t)(m0 + r) * lda + k0 + kk];
    }
    for (int i = threadIdx.x; i < 16 * 64; i += 256) {
      int kk = i >> 6, cc = i & 63;
      int n = n0 + cc;
      Bs[kk][cc] = (n < N) ? B[(size_t)(k0 + kk) * ldb + n] : 0.f;
    }
    __syncthreads();
#pragma unroll
    for (int kk = 0; kk < 16; kk++) {
      float a[4], b[4];
#pragma unroll
      for (int i = 0; i < 4; i++) a[i] = As[kk][ty * 4 + i];
#pragma unroll
      for (int j = 0; j < 4; j++) b[j] = Bs[kk][tx * 4 + j];
#pragma unroll
      for (int i = 0; i < 4; i++)
#pragma unroll
        for (int j = 0; j < 4; j++) acc[i][j] += a[i] * b[j];
    }
    __syncthreads();
  }
  for (int i = 0; i < 4; i++)
    for (int j = 0; j < 4; j++) {
      int n = n0 + tx * 4 + j;
      if (n < N) C[(size_t)(m0 + ty * 4 + i) * ldc + n] = acc[i][j];
    }
}

__global__ void k_gdn_prep(const float* __restrict__ p, const float* __restrict__ conv_w,
                           const float* __restrict__ a_log, const float* __restrict__ dt_bias,
                           float* __restrict__ gq, float* __restrict__ gk, float* __restrict__ gv,
                           float* __restrict__ gbeta, float* __restrict__ gg) {
  int t = blockIdx.x, hd = blockIdx.y, d = threadIdx.x;
  float val[3];
  for (int part = 0; part < 3; part++) {
    int c = part * 512 + hd * 128 + d;
    float acc = 0.f;
    for (int j = 0; j < 4; j++) {
      int tt = t - 3 + j;
      if (tt >= 0) acc += conv_w[j * 1536 + c] * p[(size_t)tt * IN_COLS + OFF_GQKV + c];
    }
    val[part] = silu_f(acc);
  }
  __shared__ float red[2][2];
  float sq = wave_sum(val[0] * val[0]);
  float sk = wave_sum(val[1] * val[1]);
  if ((d & 63) == 0) { red[0][d >> 6] = sq; red[1][d >> 6] = sk; }
  __syncthreads();
  sq = red[0][0] + red[0][1];
  sk = red[1][0] + red[1][1];
  size_t o = ((size_t)hd * SEQ + t) * 128 + d;
  gq[o] = val[0] * rsqrtf(sq + 1e-6f) * 0.08838834764831845f;
  gk[o] = val[1] * rsqrtf(sk + 1e-6f);
  gv[o] = val[2];
  if (d == 0) {
    float bb = p[(size_t)t * IN_COLS + OFF_GBETA + hd];
    float aa = p[(size_t)t * IN_COLS + OFF_GALPHA + hd];
    gbeta[hd * SEQ + t] = sigmoid_f(bb);
    gg[hd * SEQ + t] = -expf(a_log[hd]) * softplus_f(aa + dt_bias[hd]);
  }
}

__global__ void k_gdn_scan(const float* __restrict__ gq, const float* __restrict__ gk,
                           const float* __restrict__ gv, const float* __restrict__ gbeta,
                           const float* __restrict__ gg, float* __restrict__ go) {
  int hd = blockIdx.x >> 2, vs = blockIdx.x & 3;
  int v = threadIdx.x & 31, kg = threadIdx.x >> 5;
  float S[16];
  for (int i = 0; i < 16; i++) S[i] = 0.f;
  __shared__ float part[2][3][8][32];
  __shared__ float kq[2][2][128];
  for (int t = 0; t < SEQ; t++) {
    int pb = t & 1;
    size_t base = ((size_t)hd * SEQ + t) * 128;
    if (threadIdx.x < 128) kq[pb][0][threadIdx.x] = gk[base + threadIdx.x];
    else kq[pb][1][threadIdx.x - 128] = gq[base + threadIdx.x - 128];
    __syncthreads();
    float ks = 0.f, qs = 0.f, qk = 0.f;
#pragma unroll
    for (int i = 0; i < 16; i++) {
      float kk = kq[pb][0][kg * 16 + i], qq = kq[pb][1][kg * 16 + i];
      ks += kk * S[i];
      qs += qq * S[i];
      qk += kk * qq;
    }
    part[pb][0][kg][v] = ks;
    part[pb][1][kg][v] = qs;
    part[pb][2][kg][v] = qk;
    __syncthreads();
    float kS = 0.f, qS = 0.f, qK = 0.f;
#pragma unroll
    for (int j = 0; j < 8; j++) { kS += part[pb][0][j][v]; qS += part[pb][1][j][v]; qK += part[pb][2][j][v]; }
    float eg = expf(gg[hd * SEQ + t]);
    float beta = gbeta[hd * SEQ + t];
    float vt = gv[base + vs * 32 + v];
    float vnew = beta * (vt - eg * kS);
#pragma unroll
    for (int i = 0; i < 16; i++) S[i] = eg * S[i] + kq[pb][0][kg * 16 + i] * vnew;
    if (kg == 0) go[((size_t)t * 4 + hd) * 128 + vs * 32 + v] = eg * qS + qK * vnew;
  }
}

__global__ void k_gdn_out(const float* __restrict__ go, const float* __restrict__ p,
                          const float* __restrict__ norm_w, float* __restrict__ ga) {
  int t = blockIdx.x, hd = blockIdx.y, d = threadIdx.x;
  float o = go[((size_t)t * 4 + hd) * 128 + d];
  __shared__ float red[2];
  float s = wave_sum(o * o);
  if ((d & 63) == 0) red[d >> 6] = s;
  __syncthreads();
  s = red[0] + red[1];
  float z = p[(size_t)t * IN_COLS + OFF_GZ + hd * 128 + d];
  ga[(size_t)t * 512 + hd * 128 + d] = o * rsqrtf(s / 128.f + 1e-6f) * norm_w[d] * silu_f(z);
}

__global__ void k_s5_scan(const float* __restrict__ p, const float* __restrict__ a_re, const float* __restrict__ a_im,
                          const float* __restrict__ b_re, const float* __restrict__ b_im,
                          const float* __restrict__ c_re, const float* __restrict__ c_im,
                          const float* __restrict__ dd, const float* __restrict__ log_dt,
                          float* __restrict__ zg) {
  int g = blockIdx.x, pp = threadIdx.x;
  float dt = expf(log_dt[g]);
  float lr = a_re[g * 64 + pp], li = a_im[g * 64 + pp];
  float er = expf(lr * dt);
  float ar = er * cosf(li * dt), ai = er * sinf(li * dt);
  float nr = ar - 1.f, ni = ai;
  float den = lr * lr + li * li;
  float fr = (nr * lr + ni * li) / den, fi = (ni * lr - nr * li) / den;
  float bbr[16], bbi[16];
  for (int h = 0; h < 16; h++) {
    float br = b_re[(g * 64 + pp) * 16 + h], bi = b_im[(g * 64 + pp) * 16 + h];
    bbr[h] = fr * br - fi * bi;
    bbi[h] = fr * bi + fi * br;
  }
  int oh = pp & 15, opg = pp >> 4;
  float cr[16], ci[16];
  for (int i = 0; i < 16; i++) {
    cr[i] = c_re[(g * 16 + oh) * 64 + opg * 16 + i];
    ci[i] = c_im[(g * 16 + oh) * 64 + opg * 16 + i];
  }
  float dval = dd[g * 16 + oh];
  __shared__ float ssr[64], ssi[64];
  __shared__ float us[16];
  float sr = 0.f, si = 0.f;
  for (int t = 0; t < SEQ; t++) {
    if (pp < 16) us[pp] = p[(size_t)t * IN_COLS + OFF_S5U + g * 16 + pp];
    __syncthreads();
    float bur = 0.f, bui = 0.f;
#pragma unroll
    for (int h = 0; h < 16; h++) { bur += bbr[h] * us[h]; bui += bbi[h] * us[h]; }
    float nsr = ar * sr - ai * si + bur;
    float nsi = ar * si + ai * sr + bui;
    sr = nsr; si = nsi;
    ssr[pp] = sr; ssi[pp] = si;
    __syncthreads();
    float y = 0.f;
#pragma unroll
    for (int i = 0; i < 16; i++) y += cr[i] * ssr[opg * 16 + i] - ci[i] * ssi[opg * 16 + i];
    y += __shfl_xor(y, 16);
    y += __shfl_xor(y, 32);
    if (opg == 0) {
      y += dval * us[oh];
      zg[(size_t)t * 256 + g * 16 + oh] = gelu_f(y);
    }
    __syncthreads();
  }
}

__global__ void k_glu(const float* __restrict__ zz, const float* __restrict__ glu_b, float* __restrict__ out, int n) {
  int i = blockIdx.x * 256 + threadIdx.x;
  if (i >= n) return;
  int t = i >> 8, j = i & 255;
  float a = zz[(size_t)t * 512 + j] + glu_b[j];
  float b = zz[(size_t)t * 512 + 256 + j] + glu_b[256 + j];
  out[i] = a * sigmoid_f(b);
}

__global__ void k_moba_kmean(const float* __restrict__ p, float* __restrict__ kmean) {
  int blk = blockIdx.x, hd = blockIdx.y, d = threadIdx.x;
  float s = 0.f;
  for (int j = 0; j < 256; j++) s += p[(size_t)(blk * 256 + j) * IN_COLS + OFF_MQKV + 256 + hd * 64 + d];
  kmean[(hd * 16 + blk) * 64 + d] = s * (1.f / 256.f);
}

__global__ void k_moba_attn(const float* __restrict__ p, const float* __restrict__ kmean, float* __restrict__ mo) {
  int t = blockIdx.x, hd = threadIdx.x >> 6, lane = threadIdx.x & 63;
  int own = t >> 8;
  const float* qp = p + (size_t)t * IN_COLS + OFF_MQKV + hd * 64;
  float q[64];
#pragma unroll
  for (int d = 0; d < 64; d++) q[d] = qp[d];
  float g0 = -3e38f, g1 = -3e38f, g2 = -3e38f;
  int i0 = -1, i1 = -1, i2 = -1;
  for (int n = 0; n < own; n++) {
    const float* km = kmean + (hd * 16 + n) * 64;
    float gsum = 0.f;
#pragma unroll
    for (int d = 0; d < 64; d++) gsum += q[d] * km[d];
    if (gsum > g0) { g2 = g1; i2 = i1; g1 = g0; i1 = i0; g0 = gsum; i0 = n; }
    else if (gsum > g1) { g2 = g1; i2 = i1; g1 = gsum; i1 = n; }
    else if (gsum > g2) { g2 = gsum; i2 = n; }
  }
  float s[16];
  int blks[4] = {i0, i1, i2, own};
  float mx = -3e38f;
#pragma unroll
  for (int bi = 0; bi < 4; bi++) {
    int blk = blks[bi];
#pragma unroll
    for (int kk = 0; kk < 4; kk++) {
      float sc = -1e30f;
      if (blk >= 0) {
        int key = blk * 256 + kk * 64 + lane;
        if (key <= t) {
          const float* kp = p + (size_t)key * IN_COLS + OFF_MQKV + 256 + hd * 64;
          float a = 0.f;
#pragma unroll
          for (int d = 0; d < 64; d++) a += q[d] * kp[d];
          sc = a * 0.125f;
        }
      }
      s[bi * 4 + kk] = sc;
      mx = fmaxf(mx, sc);
    }
  }
  mx = wave_max(mx);
  float lsum = 0.f;
#pragma unroll
  for (int i = 0; i < 16; i++) { s[i] = (s[i] > -1e29f) ? expf(s[i] - mx) : 0.f; lsum += s[i]; }
  lsum = wave_sum(lsum);
  float inv = 1.f / lsum;
  float acc = 0.f;
#pragma unroll
  for (int bi = 0; bi < 4; bi++) {
    int blk = blks[bi];
    if (blk < 0) continue;
#pragma unroll
    for (int kk = 0; kk < 4; kk++) {
      float pv = s[bi * 4 + kk];
      for (int l = 0; l < 64; l++) {
        int key = blk * 256 + kk * 64 + l;
        if (key > t) break;
        float pj = __shfl(pv, l);
        acc += pj * p[(size_t)key * IN_COLS + OFF_MQKV + 512 + hd * 64 + lane];
      }
    }
  }
  mo[(size_t)t * 256 + hd * 64 + lane] = acc * inv;
}

__global__ void k_merge(const float* __restrict__ p, const float* __restrict__ ya, const float* __restrict__ yb,
                        const float* __restrict__ yc, float* __restrict__ merged, int n) {
  int i = blockIdx.x * 256 + threadIdx.x;
  if (i >= n) return;
  int t = i >> 10, d = i & 1023;
  const float* gp = p + (size_t)t * IN_COLS + OFF_GATE;
  merged[i] = sigmoid_f(gp[d]) * ya[i] + sigmoid_f(gp[1024 + d]) * yb[i] + sigmoid_f(gp[2048 + d]) * yc[i];
}

__global__ void k_resid(float* __restrict__ x, const float* __restrict__ y, const float* __restrict__ g, int n) {
  int i = blockIdx.x * 256 + threadIdx.x;
  if (i >= n) return;
  x[i] += g[i & 1023] * y[i];
}

__global__ void k_peer_route(const float* __restrict__ q, const float* __restrict__ k1, const float* __restrict__ k2,
                             int* __restrict__ eid, float* __restrict__ egate) {
  int t = blockIdx.x, hd = threadIdx.x >> 6, lane = threadIdx.x & 63;
  const float* qp = q + (size_t)t * 2048 + hd * 256;
  float sA[2], sB[2];
  for (int r = 0; r < 2; r++) {
    int n = lane + r * 64;
    const float* kp1 = k1 + ((size_t)hd * 128 + n) * 128;
    const float* kp2 = k2 + ((size_t)hd * 128 + n) * 128;
    float a = 0.f, b = 0.f;
    for (int d = 0; d < 128; d++) { a += qp[d] * kp1[d]; b += qp[128 + d] * kp2[d]; }
    sA[r] = a; sB[r] = b;
  }
  float v1 = 0.f, v2 = 0.f; int i1 = 0, i2 = 0;
  for (int r = 0; r < 16; r++) {
    {
      float m = fmaxf(sA[0], sA[1]);
      float wm = wave_max(m);
      unsigned long long bal = __ballot(sA[0] == wm);
      int idx;
      if (bal) { idx = __ffsll((long long)bal) - 1; if (lane == idx) sA[0] = -3e38f; }
      else { bal = __ballot(sA[1] == wm); idx = __ffsll((long long)bal) - 1; if (lane == idx) sA[1] = -3e38f; idx += 64; }
      if (lane == r) { v1 = wm; i1 = idx; }
    }
    {
      float m = fmaxf(sB[0], sB[1]);
      float wm = wave_max(m);
      unsigned long long bal = __ballot(sB[0] == wm);
      int idx;
      if (bal) { idx = __ffsll((long long)bal) - 1; if (lane == idx) sB[0] = -3e38f; }
      else { bal = __ballot(sB[1] == wm); idx = __ffsll((long long)bal) - 1; if (lane == idx) sB[1] = -3e38f; idx += 64; }
      if (lane == r) { v2 = wm; i2 = idx; }
    }
  }
  float cs[4];
  int a = lane >> 2;
  float va = __shfl(v1, a);
  for (int j = 0; j < 4; j++) {
    int b = (lane & 3) * 4 + j;
    cs[j] = va + __shfl(v2, b);
  }
  float tv = 0.f; int tc = 0;
  for (int r = 0; r < 16; r++) {
    float m = fmaxf(fmaxf(cs[0], cs[1]), fmaxf(cs[2], cs[3]));
    float wm = wave_max(m);
    int mine = 1 << 30;
    for (int j = 3; j >= 0; j--) if (cs[j] == wm) mine = lane * 4 + j;
    int best = mine;
    for (int o = 32; o > 0; o >>= 1) best = min(best, __shfl_xor(best, o));
    if ((best >> 2) == lane) {
      for (int j = 0; j < 4; j++) if (j == (best & 3)) cs[j] = -3e38f;
    }
    if (lane == r) { tv = wm; tc = best; }
  }
  float mx = __shfl(tv, 0);
  float e = (lane < 16) ? expf(tv - mx) : 0.f;
  float sum = wave_sum(e);
  int ca = tc >> 4, cb = tc & 15;
  int ea = __shfl(i1, ca), eb = __shfl(i2, cb);
  if (lane < 16) {
    eid[((size_t)t * 8 + hd) * 16 + lane] = ea * 128 + eb;
    egate[((size_t)t * 8 + hd) * 16 + lane] = e / sum;
  }
}

__global__ void k_peer_eval(const float* __restrict__ h, const float* __restrict__ u_tab, const float* __restrict__ v_tab,
                            const int* __restrict__ eid, const float* __restrict__ egate, float* __restrict__ out) {
  int t = blockIdx.x, hd = threadIdx.x >> 6, lane = threadIdx.x & 63;
  float hv[16];
  for (int i = 0; i < 16; i++) hv[i] = h[(size_t)t * 1024 + i * 64 + lane];
  float acc[16];
  for (int i = 0; i < 16; i++) acc[i] = 0.f;
  for (int k = 0; k < 16; k++) {
    int e = eid[((size_t)t * 8 + hd) * 16 + k];
    float gt = egate[((size_t)t * 8 + hd) * 16 + k];
    const float* up = u_tab + (size_t)e * 1024;
    const float* vp = v_tab + (size_t)e * 1024;
    float dsum = 0.f;
#pragma unroll
    for (int i = 0; i < 16; i++) dsum += hv[i] * up[i * 64 + lane];
    dsum = wave_sum(dsum);
    float w = gt * gelu_f(dsum);
#pragma unroll
    for (int i = 0; i < 16; i++) acc[i] += w * vp[i * 64 + lane];
  }
  __shared__ float red[8][1024];
  for (int i = 0; i < 16; i++) red[hd][i * 64 + lane] = acc[i];
  __syncthreads();
  for (int d = threadIdx.x; d < 1024; d += 512) {
    float s = 0.f;
    for (int j = 0; j < 8; j++) s += red[j][d];
    out[(size_t)t * 1024 + d] = s;
  }
}

static void gemm(const float* A, int lda, const float* B, int ldb, float* C, int ldc, int M, int N, int K, hipStream_t s) {
  dim3 grid((N + 63) / 64, M / 64);
  k_gemm<<<grid, 256, 0, s>>>(A, lda, B, ldb, C, ldc, M, N, K);
}

extern "C" void kernel_launch(void* const* d_in, const int* in_sizes, int n_in,
                              void* d_out, int out_size, void* d_ws, size_t ws_size,
                              hipStream_t stream) {
  const float* x_in = (const float*)d_in[0];
  const float* c = (const float*)d_in[1];
  const float* ada_w = (const float*)d_in[2];
  const float* ada_b = (const float*)d_in[3];
  const float* norm1_w = (const float*)d_in[4];
  const float* w_in = (const float*)d_in[5];
  const float* conv_w = (const float*)d_in[6];
  const float* a_log = (const float*)d_in[7];
  const float* dt_bias = (const float*)d_in[8];
  const float* gdn_norm_w = (const float*)d_in[9];
  const float* s5_a_re = (const float*)d_in[10];
  const float* s5_a_im = (const float*)d_in[11];
  const float* s5_b_re = (const float*)d_in[12];
  const float* s5_b_im = (const float*)d_in[13];
  const float* s5_c_re = (const float*)d_in[14];
  const float* s5_c_im = (const float*)d_in[15];
  const float* s5_d = (const float*)d_in[16];
  const float* s5_log_dt = (const float*)d_in[17];
  const float* s5_glu_w = (const float*)d_in[18];
  const float* s5_glu_b = (const float*)d_in[19];
  const float* w_br_a = (const float*)d_in[20];
  const float* w_br_b = (const float*)d_in[21];
  const float* w_br_c = (const float*)d_in[22];
  const float* w_out = (const float*)d_in[23];
  const float* norm2_w = (const float*)d_in[24];
  const float* peer_wq = (const float*)d_in[25];
  const float* peer_k1 = (const float*)d_in[26];
  const float* peer_k2 = (const float*)d_in[27];
  const float* peer_u = (const float*)d_in[28];
  const float* peer_v = (const float*)d_in[29];
  const float* final_w = (const float*)d_in[30];

  float* x = (float*)d_out;
  float* ws = (float*)d_ws;
  size_t off = 0;
  auto alloc = [&](size_t n) { float* r = ws + off; off += (n + 63) & ~(size_t)63; return r; };
  float* mod = alloc((size_t)DEPTH * BATCH * 6144);
  float* h = alloc((size_t)SEQ * 1024);
  float* p = alloc((size_t)SEQ * IN_COLS);
  float* gq = alloc((size_t)SEQ * 512);
  float* gk = alloc((size_t)SEQ * 512);
  float* gv = alloc((size_t)SEQ * 512);
  float* gbeta = alloc((size_t)SEQ * 4);
  float* gg = alloc((size_t)SEQ * 4);
  float* go = alloc((size_t)SEQ * 512);
  float* ga = alloc((size_t)SEQ * 512);
  float* zg = alloc((size_t)SEQ * 256);
  float* zz = alloc((size_t)SEQ * 512);
  float* s5o = alloc((size_t)SEQ * 256);
  float* kmean = alloc(4 * 16 * 64);
  float* mo = alloc((size_t)SEQ * 256);
  float* ya = alloc((size_t)SEQ * 1024);
  float* yb = alloc((size_t)SEQ * 1024);
  float* yc = alloc((size_t)SEQ * 1024);
  float* merged = alloc((size_t)SEQ * 1024);
  float* mixo = alloc((size_t)SEQ * 1024);
  float* pq = alloc((size_t)SEQ * 2048);
  int* eid = (int*)alloc((size_t)SEQ * 128);
  float* egate = alloc((size_t)SEQ * 128);
  float* po = alloc((size_t)SEQ * 1024);

  hipMemcpyAsync(x, x_in, (size_t)BATCH * SEQ * 1024 * sizeof(float), hipMemcpyDeviceToDevice, stream);
  k_mod<<<dim3(6144 / 256, DEPTH), 256, 0, stream>>>(c, ada_w, ada_b, mod);

  const int NT = SEQ * 1024;
  for (int l = 0; l < DEPTH; l++) {
    for (int b = 0; b < BATCH; b++) {
      float* xb = x + (size_t)b * SEQ * 1024;
      const float* m = mod + ((size_t)l * BATCH + b) * 6144;
      k_modnorm<<<SEQ, 256, 0, stream>>>(xb, norm1_w + l * 1024, m + 0, m + 1024, h);
      gemm(h, 1024, w_in + (size_t)l * 1024 * IN_COLS, IN_COLS, p, IN_COLS, SEQ, IN_COLS, 1024, stream);
      k_gdn_prep<<<dim3(SEQ, 4), 128, 0, stream>>>(p, conv_w + l * 4 * 1536, a_log + l * 4, dt_bias + l * 4, gq, gk, gv, gbeta, gg);
      k_gdn_scan<<<16, 256, 0, stream>>>(gq, gk, gv, gbeta, gg, go);
      k_gdn_out<<<dim3(SEQ, 4), 128, 0, stream>>>(go, p, gdn_norm_w + l * 128, ga);
      k_s5_scan<<<16, 64, 0, stream>>>(p, s5_a_re + l * 1024, s5_a_im + l * 1024, s5_b_re + l * 16384, s5_b_im + l * 16384,
                                       s5_c_re + l * 16384, s5_c_im + l * 16384, s5_d + l * 256, s5_log_dt + l * 16, zg);
      gemm(zg, 256, s5_glu_w + (size_t)l * 256 * 512, 512, zz, 512, SEQ, 512, 256, stream);
      k_glu<<<SEQ * 256 / 256, 256, 0, stream>>>(zz, s5_glu_b + l * 512, s5o, SEQ * 256);
      k_moba_kmean<<<dim3(16, 4), 64, 0, stream>>>(p, kmean);
      k_moba_attn<<<SEQ, 256, 0, stream>>>(p, kmean, mo);
      gemm(ga, 512, w_br_a + (size_t)l * 512 * 1024, 1024, ya, 1024, SEQ, 1024, 512, stream);
      gemm(s5o, 256, w_br_b + (size_t)l * 256 * 1024, 1024, yb, 1024, SEQ, 1024, 256, stream);
      gemm(mo, 256, w_br_c + (size_t)l * 256 * 1024, 1024, yc, 1024, SEQ, 1024, 256, stream);
      k_merge<<<NT / 256, 256, 0, stream>>>(p, ya, yb, yc, merged, NT);
      gemm(merged, 1024, w_out + (size_t)l * 1024 * 1024, 1024, mixo, 1024, SEQ, 1024, 1024, stream);
      k_resid<<<NT / 256, 256, 0, stream>>>(xb, mixo, m + 2048, NT);
      k_modnorm<<<SEQ, 256, 0, stream>>>(xb, norm2_w + l * 1024, m + 3072, m + 4096, h);
      gemm(h, 1024, peer_wq + (size_t)l * 1024 * 2048, 2048, pq, 2048, SEQ, 2048, 1024, stream);
      k_peer_route<<<SEQ, 512, 0, stream>>>(pq, peer_k1 + (size_t)l * 8 * 128 * 128, peer_k2 + (size_t)l * 8 * 128 * 128, eid, egate);
      k_peer_eval<<<SEQ, 512, 0, stream>>>(h, peer_u + (size_t)l * PEER_E * 1024, peer_v + (size_t)l * PEER_E * 1024, eid, egate, po);
      k_resid<<<NT / 256, 256, 0, stream>>>(xb, po, m + 5120, NT);
    }
  }
  k_modnorm<<<BATCH * SEQ, 256, 0, stream>>>(x, final_w, nullptr, nullptr, x);
}
```

```cpp
#include <hip/hip_runtime.h>
#include <hip/hip_cooperative_groups.h>
#include <math.h>
#include <stdio.h>
namespace cg = cooperative_groups;

#define TOK 32768
#define SEQ 4096
#define NBLK_EXPECT 256
#define NTHR 512
#define IN_COLS 6152
#define LDS_BYTES 147456

typedef unsigned short bf16_t;
typedef float f32x4 __attribute__((ext_vector_type(4)));
typedef unsigned u32x4 __attribute__((ext_vector_type(4)));
typedef unsigned u32x2 __attribute__((ext_vector_type(2)));
typedef float f32x2 __attribute__((ext_vector_type(2)));
typedef short s16x4 __attribute__((ext_vector_type(4)));
#define LAS __attribute__((address_space(3)))

#define MiB ((size_t)1048576)
#define WS_MISC 0
#define WS_W (4 * MiB)
#define WS_A (28 * MiB)
#define WS_B (92 * MiB)
#define WS_C (285 * MiB)
#define WS_D (431 * MiB)
#define WS_END (511 * MiB)
#define MISC_MOD 0
#define MISC_KMEAN (512 * 1024)
#define MISC_CTR (1024 * 1024)
#define MISC_BAR (1024 * 1024 + 4096)
#define MISC_TS (2 * 1024 * 1024)
#define W_IN 0
#define W_G (6 * MiB)
#define W_A (12 * MiB)
#define W_B (13 * MiB)
#define W_C (13 * MiB + 512 * 1024)
#define W_OUT (14 * MiB)
#define W_GLU (16 * MiB)
#define W_EFF (17 * MiB)
#define B_GQ 0
#define B_GK (32 * MiB)
#define B_GV (64 * MiB)
#define B_GZ (96 * MiB)
#define B_S5U (128 * MiB)
#define B_MQ (144 * MiB)
#define B_MK (160 * MiB)
#define B_MV (176 * MiB)
#define B_BA (192 * MiB)
#define B_SCORE 0
#define C_QH 0
#define C_KH (32 * MiB)
#define C_VV (64 * MiB)
#define C_BETA (96 * MiB)
#define C_G (97 * MiB)
#define C_S 0
#define C_MERGED (64 * MiB)
#define D_GA 0
#define D_ZG (32 * MiB)
#define D_S5O (48 * MiB)
#define D_MO (64 * MiB)
#define D_TU 0
#define D_TV (32 * MiB)
#define D_EID (64 * MiB)

struct Params {
  const float* in[31];
  float* out;
  unsigned char* ws;
};
enum { I_X = 0, I_C, I_ADAW, I_ADAB, I_N1W, I_WIN, I_CONVW, I_ALOG, I_DTB, I_GNW, I_S5ARE, I_S5AIM, I_S5BRE, I_S5BIM,
       I_S5CRE, I_S5CIM, I_S5D, I_S5LDT, I_GLUW, I_GLUB, I_WBA, I_WBB, I_WBC, I_WOUT, I_N2W, I_WQ, I_K1, I_K2, I_PU, I_PV, I_FNW };

__device__ __forceinline__ float bf2f(bf16_t v) { return __uint_as_float(((unsigned)v) << 16); }
__device__ __forceinline__ bf16_t f2bf(float f) { unsigned u = __float_as_uint(f); u += 0x7fffu + ((u >> 16) & 1u); return (bf16_t)(u >> 16); }
__device__ __forceinline__ unsigned pk2bf(float lo, float hi) { return (unsigned)f2bf(lo) | ((unsigned)f2bf(hi) << 16); }
__device__ __forceinline__ float bflo(unsigned w) { return __uint_as_float(w << 16); }
__device__ __forceinline__ float bfhi(unsigned w) { return __uint_as_float(w & 0xffff0000u); }
__device__ __forceinline__ unsigned short f2h(float f) { _Float16 h = (_Float16)f; return __builtin_bit_cast(unsigned short, h); }
__device__ __forceinline__ float h2f(unsigned short u) { _Float16 h = __builtin_bit_cast(_Float16, u); return (float)h; }
__device__ __forceinline__ float silu_f(float x) { return x / (1.f + __expf(-x)); }
__device__ __forceinline__ float sigmoid_f(float x) { return 1.f / (1.f + __expf(-x)); }
__device__ __forceinline__ float gelu_f(float v) {
  const float t = __builtin_amdgcn_rcpf(fabsf(v) * 0.2316418882f + 1.0f);
  float q = t * 0.5307027145f + (-0.7265760135f); q = q * t + 0.7107068705f; q = q * t + (-0.142248368f); q = q * t + 0.127414796f; q = q * t;
  const float e = __builtin_amdgcn_exp2f((v * v) * (-0.72134752044f));
  const float m = v * (q * e);
  return v < 0.f ? m : v - m;
}
__device__ __forceinline__ float softplus_f(float x) { return fmaxf(x, 0.f) + log1pf(expf(-fabsf(x))); }
__device__ __forceinline__ float shx(float v, int m, int lane) { return __int_as_float(__builtin_amdgcn_ds_bpermute((lane ^ m) << 2, __float_as_int(v))); }
__device__ __forceinline__ int shxi(int v, int m, int lane) { return __builtin_amdgcn_ds_bpermute((lane ^ m) << 2, v); }
__device__ __forceinline__ float shl(float v, int src) { return __int_as_float(__builtin_amdgcn_ds_bpermute(src << 2, __float_as_int(v))); }
__device__ __forceinline__ int shli(int v, int src) { return __builtin_amdgcn_ds_bpermute(src << 2, v); }
__device__ __forceinline__ float wave_sum(float v, int lane) {
#pragma unroll
  for (int o = 32; o > 0; o >>= 1) v += shx(v, o, lane);
  return v;
}
__device__ __forceinline__ float wave_max(float v, int lane) {
#pragma unroll
  for (int o = 32; o > 0; o >>= 1) v = fmaxf(v, shx(v, o, lane));
  return v;
}
__device__ __forceinline__ int lane_l() { int l; asm volatile("v_mbcnt_lo_u32_b32 %0, -1, 0\n\tv_mbcnt_hi_u32_b32 %0, -1, %0" : "=v"(l)); return l; }
#define lt() ((WID << 6) | lane_l())
typedef const __attribute__((address_space(4))) Params* KP;
__device__ __forceinline__ KP getp() {
  auto k = __builtin_amdgcn_kernarg_segment_ptr();
  asm volatile("" : "+s"(k));
  return (KP)k;
}
#define WSUM(x) wave_sum((x), lane)
#define WMAX(x) wave_max((x), lane)

#define XB_TMO      128
#define XB_XCNT(j)  (256  + 64 * (j))
#define XB_XSUB(j)  (1280 + 64 * (j))
#define XB_XGEN(j)  (2304 + 64 * (j))
#define XB_TOP      3328
#define XB_TOPGEN   3392
#define XCD_BAR_WORDS 3456
#define XB_SPIN_CAP (1u << 18)

__device__ __forceinline__ unsigned xb_ld(unsigned* p)              { return __hip_atomic_load(p, __ATOMIC_RELAXED, __HIP_MEMORY_SCOPE_AGENT); }
__device__ __forceinline__ unsigned xb_add(unsigned* p, unsigned v) { return __hip_atomic_fetch_add(p, v, __ATOMIC_RELAXED, __HIP_MEMORY_SCOPE_AGENT); }
__device__ __forceinline__ unsigned xb_xcc_id() { return (unsigned)__builtin_amdgcn_s_getreg((3 << 11) | 20) & 0xFu; }
#define XB_SPIN(cond, bar) do { unsigned _sp = 0; while (cond) { __builtin_amdgcn_s_sleep(1); \
    if ((++_sp & 255u) == 0u) { if (xb_ld(&(bar)[XB_TMO])) break; if (_sp > XB_SPIN_CAP) { atomicAdd(&(bar)[XB_TMO], 1u); break; } } } } while (0)

struct XcdBarrier {
    unsigned* bar; unsigned x;
    volatile LAS unsigned* st;
};

__device__ __forceinline__ XcdBarrier xcd_barrier_post(unsigned* bar, volatile LAS unsigned* st) {
    XcdBarrier b; b.bar = bar; b.x = xb_xcc_id(); b.st = st;
    if (threadIdx.x == 0) (void)xb_add(&bar[XB_XCNT(b.x)], 1u);
    return b;
}
__device__ __forceinline__ void xcd_barrier_complete(unsigned* bar, unsigned x, unsigned& nloc, unsigned& nx) {
    const unsigned G = gridDim.x * gridDim.y * gridDim.z;
    unsigned sum, cnt, mine, sp = 0u;
    for (;;) {
        sum = 0u; cnt = 0u; mine = 0u;
#pragma unroll
        for (unsigned j = 0; j < 16; ++j) { const unsigned c = xb_ld(&bar[XB_XCNT(j)]); sum += c; cnt += (c > 0u) ? 1u : 0u; mine = (j == x) ? c : mine; }
        if (sum == G) break;
        __builtin_amdgcn_s_sleep(1);
        if ((++sp & 255u) == 0u) { if (xb_ld(&bar[XB_TMO])) break; if (sp > XB_SPIN_CAP) { atomicAdd(&bar[XB_TMO], 1u); break; } }
    }
    nloc = mine > 0u ? mine : 1u; nx = cnt > 0u ? cnt : 1u;
}

__device__ __forceinline__ void xcd_barrier(const XcdBarrier& b) {
    asm volatile("s_waitcnt vmcnt(0)" ::: "memory");
    __syncthreads();
    if (threadIdx.x == 0) {
        unsigned* bar = b.bar;
        __builtin_amdgcn_s_waitcnt(0);
        unsigned nloc = b.st[0], nx = b.st[1];
        if (nloc == 0u) { xcd_barrier_complete(bar, b.x, nloc, nx); b.st[0] = nloc; b.st[1] = nx; }
        const unsigned old = xb_add(&bar[XB_XSUB(b.x)], 1u);
        const unsigned gen = old / nloc;
        if (old + 1u == (gen + 1u) * nloc) {
            __builtin_amdgcn_fence(__ATOMIC_RELEASE, "agent");
            asm volatile("s_waitcnt vmcnt(0)" ::: "memory");
            const unsigned og = xb_add(&bar[XB_TOP], 1u);
            const unsigned tg = og / nx;
            if (og + 1u == (tg + 1u) * nx) xb_add(&bar[XB_TOPGEN], 1u);
            else XB_SPIN(xb_ld(&bar[XB_TOPGEN]) == tg, bar);
            __builtin_amdgcn_fence(__ATOMIC_ACQUIRE, "agent");
            xb_add(&bar[XB_XGEN(b.x)], 1u);
            asm volatile("s_waitcnt vmcnt(0)" ::: "memory");
        } else {
            XB_SPIN(xb_ld(&bar[XB_XGEN(b.x)]) == gen, bar);
            __builtin_amdgcn_fence(__ATOMIC_ACQUIRE, "agent");
            asm volatile("s_waitcnt vmcnt(0)" ::: "memory");
        }
    }
    __syncthreads();
}


__device__ __forceinline__ float reduce8(const float (&a)[8], int lane) {
  float r4[4], r2[2], r1;
  { const bool up = (lane & 32) != 0;
#pragma unroll
    for (int k = 0; k < 4; ++k) { const float snd = up ? a[k] : a[k + 4], keep = up ? a[k + 4] : a[k]; r4[k] = keep + shx(snd, 32, lane); } }
  { const bool up = (lane & 16) != 0;
#pragma unroll
    for (int k = 0; k < 2; ++k) { const float snd = up ? r4[k] : r4[k + 2], keep = up ? r4[k + 2] : r4[k]; r2[k] = keep + shx(snd, 16, lane); } }
  { const bool up = (lane & 8) != 0; const float snd = up ? r2[0] : r2[1], keep = up ? r2[1] : r2[0]; r1 = keep + shx(snd, 8, lane); }
  r1 += shx(r1, 4, lane); r1 += shx(r1, 2, lane); r1 += shx(r1, 1, lane);
  return r1;
}

static constexpr int PASSNO = 1;
#ifndef PROBE_DUP
#define PROBE_DUP -1
#endif
#define REPB(k, ...) { const int rep_ = 0; (void)rep_; const bool dry_ = (PROBE_DUP == (k)); (void)dry_; __VA_ARGS__ } if constexpr (PROBE_DUP == (k)) { const int rep_ = 1; (void)rep_; const bool dry_ = false; (void)dry_; __VA_ARGS__ }
#ifdef PROBE_LO
#define STAMP(i) do { if (blockIdx.x == PROBE_BLK && lane_l() == 0 && WID == 0 && PASSNO == 1) ((unsigned long long*)(getp()->ws + WS_MISC + MISC_TS))[i] = __builtin_amdgcn_s_memrealtime(); } while (0)
#else
#define STAMP(i) do { } while (0)
#endif
namespace pg8 {
#define PG8_LAS __attribute__((address_space(3)))
typedef unsigned short bf16_t;
typedef short bf16x8 __attribute__((ext_vector_type(8)));
typedef float f32x4 __attribute__((ext_vector_type(4)));
typedef unsigned u32x4 __attribute__((ext_vector_type(4)));
typedef int v8i_t __attribute__((ext_vector_type(8)));
typedef int v4i_t __attribute__((ext_vector_type(4)));
constexpr int BM = 256, BK = 64, HALF = 128, HTB = HALF * BK * 2  , STAGE_BYTES = 8 * HTB, NXCD = 8, WGM = 8;

__host__ __device__ __forceinline__ int lds_byte(int r, int c) { const int st = (r >> 4) * 2 + (c >> 5), rr = r & 15, cc = c & 31, ob = rr * 64 + cc * 2; return st * 1024 + (ob ^ (((ob >> 9) & 1) << 5)); }
__host__ __device__ __forceinline__ void stage_rc(int b, int& R, int& C) { const int st = b / 1024, sb = b % 1024, swz = sb ^ (((sb >> 9) & 1) << 5); R = (st >> 1) * 16 + swz / 64; C = (st & 1) * 32 + (swz % 64) / 2; }
__host__ __device__ __forceinline__ int perm32(int rho) { const int n = rho >> 4, i = rho & 15; return 8 * (i >> 2) + 4 * n + (i & 3); }

struct Unit { int pm, pn; };
struct Gemm { const bf16_t* A; const bf16_t* Bt; int M, N, K; int lda; };

struct StaticOrder {
    int nM, nN, nwg, G, c;
    __host__ __device__ void init(int M, int N, int G_, int c_) { nM = M / BM; nN = N / BM; nwg = nM * nN; G = G_; c = c_; }
    __host__ __device__ bool next(int i, Unit& u) const {
        const long L = (long)i * G + c; if (L >= nwg) return false;
        int wgid = (int)L; { const int q = nwg / NXCD, r = nwg % NXCD, xcd = wgid % NXCD, off = wgid / NXCD; wgid = (xcd < r ? xcd * (q + 1) : r * (q + 1) + (xcd - r) * q) + off; }
        const int nig = WGM * nN, gid = wgid / nig, fm = gid * WGM, gsz = (nM - fm) < WGM ? (nM - fm) : WGM;
        u.pm = fm + ((wgid % nig) % gsz); u.pn = (wgid % nig) / gsz; return true;
    }
    __device__ __forceinline__ void a_ready(const Unit&) const {}
    __device__ __forceinline__ void done(const Unit&) const {}
};
__device__ __forceinline__ unsigned cvt_pk_bf16(float lo, float hi) { unsigned r; asm volatile("v_cvt_pk_bf16_f32 %0, %1, %2" : "=v"(r) : "v"(lo), "v"(hi)); return r; }
typedef float f32x2 __attribute__((ext_vector_type(2)));
template <class Epi, class Sched, bool STAMP = false>
__device__ __forceinline__ void gemm_phase(const int WID, PG8_LAS unsigned char* lds, const Gemm g, const Sched& S, const Epi& E, unsigned long long* stamps) {
    const int tid = lt(), wid = __builtin_amdgcn_readfirstlane(tid >> 6), lane = tid & 63, wr = wid >> 2, wc = wid & 3, fr = lane & 15, fq = lane >> 4;
    const int K = g.K, nt = K / BK, lda = Epi::FP8 ? g.lda : K;
    int ts_lo = 0, ts_hi = 0, nts = 0; const unsigned long long rt_entry = STAMP ? (unsigned long long)wall_clock64() : 0ull;
#define PG8_STAMP() do { if (STAMP && wid == 0 && nts < 64) { const unsigned long long _c = (unsigned long long)clock64(); \
        ts_lo = (lane == nts) ? (int)(unsigned)_c : ts_lo; ts_hi = (lane == nts) ? (int)(unsigned)(_c >> 32) : ts_hi; ++nts; } } while (0)
    PG8_STAMP();
    unsigned voffA[2], voffB[2];
#pragma unroll
    for (int i = 0; i < 2; ++i) { int R, C; stage_rc(tid * 16 + i * 8192, R, C); const int Rb = Epi::PERM ? ((R & ~31) + perm32(R & 31)) : R;
        voffA[i] = (unsigned)(R * lda + C) * 2u; voffB[i] = (unsigned)(Rb * K + C) * 2u; }
    const size_t kstep = (size_t)(BK * 2);
    const size_t hstep = (size_t)HALF * K * 2;
    const size_t tstep = 2 * hstep;
    const size_t hstepA = (size_t)HALF * lda * 2, tstepA = 2 * hstepA;
    const unsigned ldsw = (unsigned)wid * 1024u;
    const int aoff = lds_byte(wr * 64 + fr, fq * 8), boff = lds_byte(wc * 32 + fr, fq * 8);
#define PG8_SA(b, h) (((b) * 2 + (h)) * HTB)
#define PG8_SB(b, h) ((4 + (b) * 2 + (h)) * HTB)
#define PG8_STAGE(bufoff, gbase, voff) do { _Pragma("unroll") for (int _i = 0; _i < 2; ++_i) \
        __builtin_amdgcn_global_load_lds((const unsigned*)(Epi::FP8 ? (const char*)(gbase) + (size_t)_i * ((voff) == voffA ? 128 * lda : 128 * K) + (voff)[0] : (const char*)(gbase) + (voff)[_i]), (PG8_LAS unsigned*)(lds + (bufoff) + ldsw + _i * 8192), 16, 0, 0); } while (0)
#define PG8_LDA(dst, b, h) do { if constexpr (Epi::FP8) { _Pragma("unroll") for (int m = 0; m < 4; ++m) dst##8[m] = __builtin_shufflevector(*(const PG8_LAS v4i_t*)(lds + PG8_SA(b, h) + aoff + m * 2048), *(const PG8_LAS v4i_t*)(lds + PG8_SA(b, h) + aoff + m * 2048 + 1024), 0, 1, 2, 3, 4, 5, 6, 7); } \
        else { _Pragma("unroll") for (int m = 0; m < 4; ++m) _Pragma("unroll") for (int k = 0; k < 2; ++k) dst[m][k] = *(const PG8_LAS bf16x8*)(lds + PG8_SA(b, h) + aoff + m * 2048 + k * 1024); } } while (0)
#define PG8_LDB(dst, b, h) do { if constexpr (Epi::FP8) { _Pragma("unroll") for (int n = 0; n < 2; ++n) dst##8[n] = __builtin_shufflevector(*(const PG8_LAS v4i_t*)(lds + PG8_SB(b, h) + boff + n * 2048), *(const PG8_LAS v4i_t*)(lds + PG8_SB(b, h) + boff + n * 2048 + 1024), 0, 1, 2, 3, 4, 5, 6, 7); } \
        else { _Pragma("unroll") for (int n = 0; n < 2; ++n) _Pragma("unroll") for (int k = 0; k < 2; ++k) dst[n][k] = *(const PG8_LAS bf16x8*)(lds + PG8_SB(b, h) + boff + n * 2048 + k * 1024); } } while (0)
#define PG8_MMA(ai, bj, At, Bt) do { __builtin_amdgcn_s_setprio(1); _Pragma("unroll") for (int m = 0; m < 4; ++m) _Pragma("unroll") for (int n = 0; n < 2; ++n) { \
        if constexpr (Epi::FP8) {   \
            acc[ai][bj][m][n] = __builtin_amdgcn_mfma_scale_f32_16x16x128_f8f6f4(Bt##8[n], At##8[m], acc[ai][bj][m][n], 0, 0, 0, 0, 0, 0); \
        } else { _Pragma("unroll") for (int k = 0; k < 2; ++k) acc[ai][bj][m][n] = __builtin_amdgcn_mfma_f32_16x16x32_bf16(Bt[n][k], At[m][k], acc[ai][bj][m][n], 0, 0, 0); } \
        } __builtin_amdgcn_s_setprio(0); } while (0)
#define PG8_WAIT_V(n) asm volatile("s_waitcnt vmcnt(" #n ")" ::: "memory")
#define PG8_WAIT_L(n) asm volatile("s_waitcnt lgkmcnt(" #n ")" ::: "memory")
#define PG8_BAR __builtin_amdgcn_s_barrier()
#define PG8_SCHED __builtin_amdgcn_sched_barrier(0)
    Unit cur, nxt; int ui = 0;
    if (!S.next(0, cur)) return;
    f32x4 acc[2][2][4][2];
#pragma unroll
    for (int a = 0; a < 2; ++a)
#pragma unroll
        for (int b = 0; b < 2; ++b)
#pragma unroll
            for (int m = 0; m < 4; ++m)
#pragma unroll
                for (int n = 0; n < 2; ++n) acc[a][b][m][n] = (f32x4){0.f, 0.f, 0.f, 0.f};
    bf16x8 At[4][2], B0[2][2], B1[2][2];
    v8i_t At8[4], B08[2], B18[2];
    const char* cA = (const char*)g.A + (size_t)cur.pm * tstepA; const char* cB = (const char*)g.Bt + (size_t)cur.pn * tstep;
    S.a_ready(cur);
    PG8_STAGE(PG8_SB(0, 0), cB, voffB); PG8_STAGE(PG8_SA(0, 0), cA, voffA); PG8_STAGE(PG8_SB(0, 1), cB + hstep, voffB); PG8_STAGE(PG8_SA(0, 1), cA + hstepA, voffA);
    if (wr == 1) PG8_BAR;
    PG8_WAIT_V(4); PG8_BAR;
    PG8_STAGE(PG8_SB(1, 0), cB + kstep, voffB); PG8_STAGE(PG8_SA(1, 0), cA + kstep, voffA); PG8_STAGE(PG8_SB(1, 1), cB + hstep + kstep, voffB);
    PG8_WAIT_V(6); PG8_BAR;
    PG8_STAMP();
    for (;;) {
        const bool has_next = S.next(ui + 1, nxt);
        const char* nA = has_next ? (const char*)g.A + (size_t)nxt.pm * tstepA : cA; const char* nB = has_next ? (const char*)g.Bt + (size_t)nxt.pn * tstep : cB;
        for (int t = 0; t < nt; t += 2) {
            const bool last = (t == nt - 2);
            const char* a1 = cA + (size_t)(t + 1) * kstep;
            const char* a2 = last ? nA : cA + (size_t)(t + 2) * kstep; const char* b2 = last ? nB : cB + (size_t)(t + 2) * kstep;
            const char* a3 = a2 + kstep; const char* b3 = b2 + kstep;
            if (last && has_next) S.a_ready(nxt);
            PG8_LDB(B0, 0, 0); PG8_SCHED; PG8_LDA(At, 0, 0); PG8_STAGE(PG8_SA(1, 1), a1 + hstepA, voffA);
            PG8_WAIT_L(8); PG8_BAR; PG8_WAIT_L(0); PG8_MMA(0, 0, At, B0); PG8_BAR; PG8_SCHED;
            PG8_LDB(B1, 0, 1); PG8_STAGE(PG8_SB(0, 0), b2, voffB);
            PG8_BAR; PG8_WAIT_L(0); PG8_MMA(0, 1, At, B1); PG8_BAR;
            PG8_LDA(At, 0, 1); PG8_STAGE(PG8_SA(0, 0), a2, voffA);
            PG8_BAR; PG8_WAIT_L(0); PG8_MMA(1, 0, At, B0); PG8_BAR; PG8_SCHED;
            PG8_STAGE(PG8_SB(0, 1), b2 + hstep, voffB);
            PG8_WAIT_V(6); PG8_BAR; PG8_MMA(1, 1, At, B1); PG8_BAR;
            PG8_LDB(B0, 1, 0); PG8_SCHED; PG8_LDA(At, 1, 0); PG8_STAGE(PG8_SA(0, 1), a2 + hstepA, voffA);
            PG8_WAIT_L(8); PG8_BAR; PG8_WAIT_L(0); PG8_MMA(0, 0, At, B0); PG8_BAR; PG8_SCHED;
            PG8_LDB(B1, 1, 1); PG8_STAGE(PG8_SB(1, 0), b3, voffB);
            PG8_BAR; PG8_WAIT_L(0); PG8_MMA(0, 1, At, B1); PG8_BAR;
            PG8_LDA(At, 1, 1); PG8_STAGE(PG8_SA(1, 0), a3, voffA);
            PG8_BAR; PG8_WAIT_L(0); PG8_MMA(1, 0, At, B0); PG8_BAR; PG8_SCHED;
            PG8_STAGE(PG8_SB(1, 1), b3 + hstep, voffB);
            PG8_WAIT_V(6); PG8_BAR; PG8_MMA(1, 1, At, B1); PG8_BAR;
        }
        PG8_STAMP();
        if constexpr (!Epi::AFTER_DRAIN) { E(acc, cur, wr, wc, fr, fq); S.done(cur); }
        PG8_STAMP();
        if (!has_next) break;
#pragma unroll
        for (int a = 0; a < 2; ++a)
#pragma unroll
            for (int b = 0; b < 2; ++b)
#pragma unroll
                for (int m = 0; m < 4; ++m)
#pragma unroll
                    for (int n = 0; n < 2; ++n) acc[a][b][m][n] = (f32x4){0.f, 0.f, 0.f, 0.f};
        cur = nxt; cA = nA; cB = nB; ++ui;
    }
    PG8_WAIT_V(0);
    if (wr == 0) PG8_BAR;
    PG8_BAR;
    if constexpr (Epi::AFTER_DRAIN) { E.fused(acc, cur, wr, wc, fr, fq, lds, wid, lane); S.done(cur); }
    PG8_STAMP();
    if (STAMP && wid == 0) { stamps[lane] = lane < nts ? (((unsigned long long)(unsigned)ts_hi << 32) | (unsigned)ts_lo) : 0ull;
        if (lane == 62) stamps[62] = rt_entry; if (lane == 63) stamps[63] = (unsigned long long)wall_clock64(); }
#undef PG8_STAMP
#undef PG8_SA
#undef PG8_SB
#undef PG8_STAGE
#undef PG8_LDA
#undef PG8_LDB
#undef PG8_MMA
#undef PG8_WAIT_V
#undef PG8_WAIT_L
#undef PG8_BAR
#undef PG8_SCHED
}
}

using pg8::Unit;
using pg8::cvt_pk_bf16;

struct EpiIn {
  static constexpr bool PERM = true, AFTER_DRAIN = false, FP8 = false;
  unsigned char* rb;
  __device__ __forceinline__ void operator()(const f32x4 (&acc)[2][2][4][2], const Unit& u, int wr, int wc, int fr, int fq) const {
    bf16_t* base; int ldc, colt;
    if (u.pn < 8) { base = (bf16_t*)(rb + (size_t)(u.pn >> 1) * 32 * MiB); ldc = 512; colt = (u.pn & 1) * 256; }
    else { base = (bf16_t*)(rb + B_S5U + (size_t)(u.pn - 8) * 16 * MiB); ldc = 256; colt = 0; }
    const int row0 = u.pm * 256 + wr * 64 + fr, col0 = colt + wc * 32 + 8 * fq;
#pragma unroll
    for (int ai = 0; ai < 2; ++ai)
#pragma unroll
      for (int m = 0; m < 4; ++m) {
        bf16_t* rowp = base + (size_t)(row0 + ai * 128 + m * 16) * ldc + col0;
#pragma unroll
        for (int bj = 0; bj < 2; ++bj) {
          const f32x4 v0 = acc[ai][bj][m][0], v1 = acc[ai][bj][m][1];
          u32x4 w; w.x = cvt_pk_bf16(v0[0], v0[1]); w.y = cvt_pk_bf16(v0[2], v0[3]); w.z = cvt_pk_bf16(v1[0], v1[1]); w.w = cvt_pk_bf16(v1[2], v1[3]);
          *(u32x4*)(rowp + bj * 128) = w;
        }
      }
  }
};
struct EpiGlu {
  static constexpr bool PERM = false, AFTER_DRAIN = false, FP8 = false;
  bf16_t* out; const float* bias;
  __device__ __forceinline__ void operator()(const f32x4 (&acc)[2][2][4][2], const Unit& u, int wr, int wc, int fr, int fq) const {
    const int row0 = u.pm * 256 + wr * 64 + fr, J0 = 128 * u.pn + 16 * wc + 4 * fq;
#pragma unroll
    for (int ai = 0; ai < 2; ++ai)
#pragma unroll
      for (int m = 0; m < 4; ++m) {
        const int row = row0 + ai * 128 + m * 16;
#pragma unroll
        for (int bj = 0; bj < 2; ++bj) {
          const int J = J0 + 64 * bj;
          const f32x4 a = acc[ai][bj][m][0] + *(const f32x4*)(bias + J);
          const f32x4 b = acc[ai][bj][m][1] + *(const f32x4*)(bias + 256 + J);
          u32x2 w; w.x = cvt_pk_bf16(a[0] * sigmoid_f(b[0]), a[1] * sigmoid_f(b[1])); w.y = cvt_pk_bf16(a[2] * sigmoid_f(b[2]), a[3] * sigmoid_f(b[3]));
          *(u32x2*)(out + (size_t)row * 256 + J) = w;
        }
      }
  }
};
__device__ __forceinline__ unsigned pk4u8(float a, float b, float c, float d) {
  const unsigned ua = __float_as_uint(__builtin_fmaf(a, 255.f, 8388608.f)), ub = __float_as_uint(__builtin_fmaf(b, 255.f, 8388608.f));
  const unsigned uc = __float_as_uint(__builtin_fmaf(c, 255.f, 8388608.f)), ud = __float_as_uint(__builtin_fmaf(d, 255.f, 8388608.f));
  return __builtin_amdgcn_perm(ub, ua, 0x0c0c0400u) | __builtin_amdgcn_perm(ud, uc, 0x04000c0cu);
}
__device__ __forceinline__ float ub8(unsigned w, int k) { return (float)((w >> (8 * k)) & 0xffu); }
__device__ __forceinline__ float sig64_f(float x) { return __builtin_amdgcn_rcpf(1.f + __builtin_amdgcn_exp2f(x * -0.09016844f)); }
struct EpiGate {
  static constexpr bool PERM = true, AFTER_DRAIN = false, FP8 = true;
  bf16_t* S;
  __device__ __forceinline__ void operator()(const f32x4 (&acc)[2][2][4][2], const Unit& u, int wr, int wc, int fr, int fq) const {
    u32x4* base = (u32x4*)S + (size_t)(u.pm * 4 + u.pn) * 4096 + (((wr * 4 + wc) << 6) | (fq << 4) | fr);
#pragma unroll
    for (int ai = 0; ai < 2; ++ai)
#pragma unroll
      for (int m = 0; m < 4; ++m) {
        u32x4 w;
#pragma unroll
        for (int bj = 0; bj < 2; ++bj) {
          const f32x4 v0 = acc[ai][bj][m][0], v1 = acc[ai][bj][m][1];
          int q0 = __builtin_amdgcn_cvt_pk_fp8_f32(v0[0], v0[1], 0, false); q0 = __builtin_amdgcn_cvt_pk_fp8_f32(v0[2], v0[3], q0, true);
          int q1 = __builtin_amdgcn_cvt_pk_fp8_f32(v1[0], v1[1], 0, false); q1 = __builtin_amdgcn_cvt_pk_fp8_f32(v1[2], v1[3], q1, true);
          w[2 * bj] = (unsigned)q0; w[2 * bj + 1] = (unsigned)q1;
        }
        base[(ai * 4 + m) * 512] = w;
      }
  }
};
template <bool FIRST> struct EpiMerge {
  static constexpr bool PERM = true, AFTER_DRAIN = false, FP8 = false;
  const bf16_t* S; bf16_t* Mg;
  __device__ __forceinline__ void operator()(const f32x4 (&acc)[2][2][4][2], const Unit& u, int wr, int wc, int fr, int fq) const {
    const int row0 = u.pm * 256 + wr * 64 + fr, col0 = u.pn * 256 + wc * 32 + 8 * fq;
#pragma unroll
    for (int ai = 0; ai < 2; ++ai) {
      u32x4 sv[4], qv[4][2];
      const u32x4* sbase = (const u32x4*)S + (size_t)(u.pm * 4 + u.pn) * 4096 + (((wr * 4 + wc) << 6) | (fq << 4) | fr);
#pragma unroll
      for (int m = 0; m < 4; ++m) {
        sv[m] = sbase[(ai * 4 + m) * 512];
#pragma unroll
        for (int bj = 0; bj < 2; ++bj) {
          const size_t off = (size_t)(row0 + ai * 128 + m * 16) * 1024 + col0 + bj * 128;
          if (!FIRST) qv[m][bj] = *(const u32x4*)(Mg + off);
        }
      }
      __builtin_amdgcn_sched_barrier(0);
#pragma unroll
      for (int m = 0; m < 4; ++m)
#pragma unroll
        for (int bj = 0; bj < 2; ++bj) {
          const size_t off = (size_t)(row0 + ai * 128 + m * 16) * 1024 + col0 + bj * 128;
          const f32x4 v0 = acc[ai][bj][m][0], v1 = acc[ai][bj][m][1];
          const int za = (int)(bj ? sv[m].z : sv[m].x), zb = (int)(bj ? sv[m].w : sv[m].y);
          const f32x2 z0 = __builtin_amdgcn_cvt_pk_f32_fp8(za, false), z1 = __builtin_amdgcn_cvt_pk_f32_fp8(za, true), z2 = __builtin_amdgcn_cvt_pk_f32_fp8(zb, false), z3 = __builtin_amdgcn_cvt_pk_f32_fp8(zb, true);
          float r[8];
          r[0] = sig64_f(z0[0]) * v0[0]; r[1] = sig64_f(z0[1]) * v0[1]; r[2] = sig64_f(z1[0]) * v0[2]; r[3] = sig64_f(z1[1]) * v0[3];
          r[4] = sig64_f(z2[0]) * v1[0]; r[5] = sig64_f(z2[1]) * v1[1]; r[6] = sig64_f(z3[0]) * v1[2]; r[7] = sig64_f(z3[1]) * v1[3];
          if (!FIRST) {
            const u32x4 q = qv[m][bj];
            r[0] += bflo(q.x); r[1] += bfhi(q.x); r[2] += bflo(q.y); r[3] += bfhi(q.y); r[4] += bflo(q.z); r[5] += bfhi(q.z); r[6] += bflo(q.w); r[7] += bfhi(q.w);
          }
          u32x4 w; w.x = cvt_pk_bf16(r[0], r[1]); w.y = cvt_pk_bf16(r[2], r[3]); w.z = cvt_pk_bf16(r[4], r[5]); w.w = cvt_pk_bf16(r[6], r[7]);
          *(u32x4*)(Mg + off) = w;
        }
      __builtin_amdgcn_sched_barrier(0);
    }
  }
};
template <bool XB_IN> struct EpiOut {
  static constexpr bool PERM = true, AFTER_DRAIN = false, FP8 = false;
  const float* xs; float* x; const float* g; bool dry;
  __device__ __forceinline__ void operator()(const f32x4 (&acc)[2][2][4][2], const Unit& u, int wr, int wc, int fr, int fq) const {
    const int row0 = u.pm * 256 + wr * 64 + fr, col0 = u.pn * 256 + wc * 32 + 8 * fq;
    const float* gb = g + (size_t)((u.pm * 256) >> 12) * 6144;
    bf16_t* xb = (bf16_t*)x;
    const bf16_t* xsb = (const bf16_t*)xs;
    f32x4 gv[2][2];
#pragma unroll
    for (int bj = 0; bj < 2; ++bj)
#pragma unroll
      for (int n = 0; n < 2; ++n) gv[bj][n] = *(const f32x4*)(gb + col0 + bj * 128 + n * 4);
#pragma unroll
    for (int ai = 0; ai < 2; ++ai)
#pragma unroll
      for (int mh = 0; mh < 2; ++mh) {
        f32x4 xv[2][2][2];
        u32x4 xw[2][2];
#pragma unroll
        for (int mm = 0; mm < 2; ++mm)
#pragma unroll
          for (int bj = 0; bj < 2; ++bj) {
            const size_t row = (size_t)(row0 + ai * 128 + (mh * 2 + mm) * 16);
            if (XB_IN) xw[mm][bj] = *(const u32x4*)(xsb + row * 2048 + col0 + bj * 128);
            else {
#pragma unroll
              for (int n = 0; n < 2; ++n) xv[mm][bj][n] = *(const f32x4*)(xs + row * 1024 + col0 + bj * 128 + n * 4);
            }
          }
        __builtin_amdgcn_sched_barrier(0);
#pragma unroll
        for (int mm = 0; mm < 2; ++mm)
#pragma unroll
          for (int bj = 0; bj < 2; ++bj) {
            const size_t row = (size_t)(row0 + ai * 128 + (mh * 2 + mm) * 16);
            f32x4 x0, x1;
            if (XB_IN) { const u32x4 q = xw[mm][bj]; x0 = (f32x4){bflo(q.x), bfhi(q.x), bflo(q.y), bfhi(q.y)}; x1 = (f32x4){bflo(q.z), bfhi(q.z), bflo(q.w), bfhi(q.w)}; }
            else { x0 = xv[mm][bj][0]; x1 = xv[mm][bj][1]; }
            const f32x4 n0 = x0 + gv[bj][0] * acc[ai][bj][mh * 2 + mm][0], n1 = x1 + gv[bj][1] * acc[ai][bj][mh * 2 + mm][1];
            u32x4 w; w.x = cvt_pk_bf16(n0[0], n0[1]); w.y = cvt_pk_bf16(n0[2], n0[3]); w.z = cvt_pk_bf16(n1[0], n1[1]); w.w = cvt_pk_bf16(n1[2], n1[3]);
            u32x4* pp = (u32x4*)(xb + row * 2048 + col0 + bj * 128);
            if (!dry) *pp = w; else if (n0[0] == 1.2345e30f) *pp = w;
          }
        __builtin_amdgcn_sched_barrier(0);
      }
  }
};
struct EpiScore {
  static constexpr bool PERM = true, AFTER_DRAIN = false, FP8 = false;
  unsigned short* sc;
  __device__ __forceinline__ void operator()(const f32x4 (&acc)[2][2][4][2], const Unit& u, int wr, int wc, int fr, int fq) const {
    const int row0 = u.pm * 256 + wr * 64 + fr, col0 = u.pn * 256 + wc * 32 + 8 * fq;
#pragma unroll
    for (int ai = 0; ai < 2; ++ai)
#pragma unroll
      for (int m = 0; m < 4; ++m) {
        unsigned short* rowp = sc + (size_t)(row0 + ai * 128 + m * 16) * 2048 + col0;
#pragma unroll
        for (int bj = 0; bj < 2; ++bj) {
          const f32x4 v0 = acc[ai][bj][m][0], v1 = acc[ai][bj][m][1];
          u32x4 w;
          w.x = (unsigned)f2h(v0[0]) | ((unsigned)f2h(v0[1]) << 16); w.y = (unsigned)f2h(v0[2]) | ((unsigned)f2h(v0[3]) << 16);
          w.z = (unsigned)f2h(v1[0]) | ((unsigned)f2h(v1[1]) << 16); w.w = (unsigned)f2h(v1[2]) | ((unsigned)f2h(v1[3]) << 16);
          *(u32x4*)(rowp + bj * 128) = w;
        }
      }
  }
};

template <class Epi>
__device__ __forceinline__ void run_gemm(const int WID, unsigned char* lds, const bf16_t* A, const bf16_t* Bt, int M, int N, int K, const Epi& E, int lda = 0) {
  pg8::Gemm g{A, Bt, M, N, K, lda};
  pg8::StaticOrder S; S.init(M, N, (int)gridDim.x, (int)blockIdx.x);
  pg8::gemm_phase<Epi, pg8::StaticOrder>(WID, (PG8_LAS unsigned char*)lds, g, S, E, nullptr);
  __syncthreads();
}

__device__ __forceinline__ void phase_mod(const int WID, KP p, unsigned char* lds) {
  const int tid = lt();
  float* sc = (float*)lds;
  float* red = sc + 8192;
  const float* c = p->in[I_C];
  for (int i = tid; i < 8192; i += NTHR) sc[i] = silu_f(c[i]);
  __syncthreads();
  float* mod = (float*)(p->ws + WS_MISC + MISC_MOD);
  for (int task = blockIdx.x; task < 192; task += gridDim.x) {
    const int l = task / 96, j0 = (task % 96) * 64, col = tid & 63, ip = tid >> 6;
    const float* w = p->in[I_ADAW] + (size_t)l * 1024 * 6144 + j0 + col;
    float acc[8];
#pragma unroll
    for (int b = 0; b < 8; ++b) acc[b] = 0.f;
#pragma unroll 16
    for (int i = ip * 128; i < ip * 128 + 128; ++i) {
      const float wv = w[(size_t)i * 6144];
#pragma unroll
      for (int b = 0; b < 8; ++b) acc[b] += sc[b * 1024 + i] * wv;
    }
#pragma unroll
    for (int b = 0; b < 8; ++b) red[(ip * 8 + b) * 64 + col] = acc[b];
    __syncthreads();
    {
      const int b = ip; float s = 0.f;
#pragma unroll
      for (int q = 0; q < 8; ++q) s += red[(q * 8 + b) * 64 + col];
      mod[((size_t)l * 8 + b) * 6144 + j0 + col] = s + p->in[I_ADAB][l * 6144 + j0 + col];
    }
    __syncthreads();
  }
  if (blockIdx.x == 0 && tid < 64) ((unsigned*)(p->ws + WS_MISC + MISC_CTR))[tid] = 0u;
}

template <bool XB = false>
__device__ __forceinline__ void phase_norm(const int WID, const float* xsrc, float* xcopy, const float* nw, const float* modl, int sh_off, int sc_off,
                           bf16_t* h, const float* w_in_l, float* ba, unsigned char* lds, const int ntok = TOK, unsigned char* h8 = nullptr) {
  const int tid = lt(), wave = tid >> 6, lane = tid & 63;
  float* w8 = (float*)lds;
  if (ba) {
    for (int i = tid; i < 8192; i += NTHR) w8[i] = w_in_l[(size_t)(i >> 3) * IN_COLS + 2048 + (i & 7)];
    __syncthreads();
  }
  for (int t = blockIdx.x * 8 + wave; t < ntok; t += gridDim.x * 8) {
    const int b = t >> 12;
    f32x4 v[4];
    float ss = 0.f;
#pragma unroll
    for (int i = 0; i < 4; ++i) {
      if (XB) { const u32x2 xw = *(const u32x2*)((const bf16_t*)xsrc + (size_t)t * 2048 + i * 256 + lane * 4); v[i] = (f32x4){bflo(xw.x), bfhi(xw.x), bflo(xw.y), bfhi(xw.y)}; }
      else v[i] = *(const f32x4*)(xsrc + (size_t)t * 1024 + i * 256 + lane * 4);
      ss += v[i][0] * v[i][0] + v[i][1] * v[i][1] + v[i][2] * v[i][2] + v[i][3] * v[i][3];
      if (xcopy) *(f32x4*)(xcopy + (size_t)t * 1024 + i * 256 + lane * 4) = v[i];
    }
    ss = WSUM(ss);
    const float r = rsqrtf(ss * (1.f / 1024.f) + 1e-6f);
    float a8[8];
#pragma unroll
    for (int j = 0; j < 8; ++j) a8[j] = 0.f;
#pragma unroll
    for (int i = 0; i < 4; ++i) {
      const int c = i * 256 + lane * 4;
      const f32x4 w4 = *(const f32x4*)(nw + c);
      const f32x4 sc4 = *(const f32x4*)(modl + (size_t)b * 6144 + sc_off + c);
      const f32x4 sh4 = *(const f32x4*)(modl + (size_t)b * 6144 + sh_off + c);
      const f32x4 hv = v[i] * r * w4 * (sc4 + 1.f) + sh4;
      u32x2 w; w.x = pk2bf(hv[0], hv[1]); w.y = pk2bf(hv[2], hv[3]);
      *(u32x2*)(h + (size_t)t * 1024 + c) = w;
      if (h8) { int q = __builtin_amdgcn_cvt_pk_fp8_f32(hv[0], hv[1], 0, false); q = __builtin_amdgcn_cvt_pk_fp8_f32(hv[2], hv[3], q, true); *(int*)(h8 + (size_t)t * 4096 + c) = q; }
      if (ba) {
#pragma unroll
        for (int k = 0; k < 4; ++k)
#pragma unroll
          for (int j = 0; j < 8; ++j) a8[j] += hv[k] * w8[(c + k) * 8 + j];
      }
    }
    if (ba) {
      const float tot = reduce8(a8, lane);
      if ((lane & 7) == 0) ba[(size_t)t * 8 + ((lane >> 5) & 1) * 4 + ((lane >> 4) & 1) * 2 + ((lane >> 3) & 1)] = tot;
    }
  }
  __syncthreads();
}

__device__ __forceinline__ int wsrc_col(int kind, int r) {
  if (kind == 0) return r < 2048 ? r : r + 8;
  if (kind == 1) return 3080 + r;
  if (kind == 3) { const int n = (r >> 4) & 1; const int J = ((r >> 8) << 7) | (((r >> 7) & 1) << 6) | (((r >> 5) & 3) << 4) | (((r >> 2) & 3) << 2) | (r & 3); return n * 256 + J; }
  return r;
}
__device__ __forceinline__ void conv_T(const int WID, const float* src, int ld, int K, int N, bf16_t* dst, int kind, unsigned char* lds) {
  const int tid = lt();
  float* tile = (float*)lds;
  const int ntk = K / 64, nt = (N / 64) * ntk;
  for (int tl = blockIdx.x; tl < nt; tl += gridDim.x) {
    const int n0 = (tl / ntk) * 64, k0 = (tl % ntk) * 64;
#pragma unroll
    for (int i = 0; i < 8; ++i) {
      const int idx = tid + NTHR * i, kk = idx >> 6, nn = idx & 63;
      tile[kk * 65 + nn] = src[(size_t)(k0 + kk) * ld + wsrc_col(kind, n0 + nn)];
    }
    __syncthreads();
#pragma unroll
    for (int i = 0; i < 4; ++i) {
      const int idx = tid + NTHR * i, nn = idx >> 5, k2 = (idx & 31) * 2;
      *(unsigned*)(dst + (size_t)(n0 + nn) * K + k0 + k2) = pk2bf(tile[k2 * 65 + nn], tile[(k2 + 1) * 65 + nn]);
    }
    __syncthreads();
  }
}
__device__ __forceinline__ void conv_T8(const int WID, const float* src, int ld, int K, int N, unsigned char* dst, int kind, float scale, unsigned char* lds) {
  const int tid = lt();
  float* tile = (float*)lds;
  const int ntk = K / 64, nt = (N / 64) * ntk;
  for (int tl = blockIdx.x; tl < nt; tl += gridDim.x) {
    const int n0 = (tl / ntk) * 64, k0 = (tl % ntk) * 64;
#pragma unroll
    for (int i = 0; i < 8; ++i) {
      const int idx = tid + NTHR * i, kk = idx >> 6, nn = idx & 63;
      tile[kk * 65 + nn] = src[(size_t)(k0 + kk) * ld + wsrc_col(kind, n0 + nn)] * scale;
    }
    __syncthreads();
#pragma unroll
    for (int i = 0; i < 2; ++i) {
      const int idx = tid + NTHR * i, nn = idx >> 4, k4 = (idx & 15) * 4;
      int w = __builtin_amdgcn_cvt_pk_fp8_f32(tile[k4 * 65 + nn], tile[(k4 + 1) * 65 + nn], 0, false);
      w = __builtin_amdgcn_cvt_pk_fp8_f32(tile[(k4 + 2) * 65 + nn], tile[(k4 + 3) * 65 + nn], w, true);
      *(int*)(dst + (size_t)(n0 + nn) * K + k0 + k4) = w;
    }
    __syncthreads();
  }
}
__device__ __forceinline__ void phase_weff(const int WID, const float* wq, const float* k1, const float* k2, bf16_t* WeffT, unsigned char* lds) {
  const int tid = lt();
  float* wt = (float*)lds;
  float* kt = wt + 64 * 129;
  for (int task = blockIdx.x; task < 256; task += gridDim.x) {
    const int hh = task >> 4, it = task & 15, hd = hh >> 1, half = hh & 1, i0 = it * 64;
    const float* kp = (half ? k2 : k1) + (size_t)hd * 128 * 128;
    for (int idx = tid; idx < 64 * 128; idx += NTHR) { const int i = idx >> 7, d = idx & 127; wt[i * 129 + d] = wq[(size_t)(i0 + i) * 2048 + hd * 256 + half * 128 + d]; }
    for (int idx = tid; idx < 128 * 128; idx += NTHR) { const int n = idx >> 7, d = idx & 127; kt[n * 129 + d] = kp[n * 128 + d]; }
    __syncthreads();
    const int i = tid & 63, ng = tid >> 6;
    float acc[16];
#pragma unroll
    for (int j = 0; j < 16; ++j) acc[j] = 0.f;
    for (int d = 0; d < 128; ++d) {
      const float wv = wt[i * 129 + d];
#pragma unroll
      for (int j = 0; j < 16; ++j) acc[j] += wv * kt[(ng * 16 + j) * 129 + d];
    }
#pragma unroll
    for (int j = 0; j < 16; ++j) WeffT[(size_t)(hh * 128 + ng * 16 + j) * 1024 + i0 + i] = f2bf(acc[j]);
    __syncthreads();
  }
}
__device__ __forceinline__ void phase_convert_weights(const int WID, KP p, int l, unsigned char* lds) {
  unsigned char* W = p->ws + WS_W;
  const float* w_in = p->in[I_WIN] + (size_t)l * 1024 * IN_COLS;
  conv_T(WID, w_in, IN_COLS, 1024, 3072, (bf16_t*)(W + W_IN), 0, lds);
  conv_T8(WID, w_in, IN_COLS, 1024, 3072, W + W_G, 1, 16.f, lds);
  conv_T(WID, p->in[I_WBA] + (size_t)l * 512 * 1024, 1024, 512, 1024, (bf16_t*)(W + W_A), 2, lds);
  conv_T(WID, p->in[I_WBB] + (size_t)l * 256 * 1024, 1024, 256, 1024, (bf16_t*)(W + W_B), 2, lds);
  conv_T(WID, p->in[I_WBC] + (size_t)l * 256 * 1024, 1024, 256, 1024, (bf16_t*)(W + W_C), 2, lds);
  conv_T(WID, p->in[I_WOUT] + (size_t)l * 1024 * 1024, 1024, 1024, 1024, (bf16_t*)(W + W_OUT), 2, lds);
  conv_T(WID, p->in[I_GLUW] + (size_t)l * 256 * 512, 512, 256, 512, (bf16_t*)(W + W_GLU), 3, lds);
}
__device__ __forceinline__ void conv_flat(const int WID, const float* src, bf16_t* dst, size_t n) {
  const size_t stride = (size_t)gridDim.x * NTHR * 8;
  for (size_t i = ((size_t)blockIdx.x * NTHR + lt()) * 8; i < n; i += stride) {
    const f32x4 a = *(const f32x4*)(src + i), b = *(const f32x4*)(src + i + 4);
    u32x4 w; w.x = pk2bf(a[0], a[1]); w.y = pk2bf(a[2], a[3]); w.z = pk2bf(b[0], b[1]); w.w = pk2bf(b[2], b[3]);
    *(u32x4*)(dst + i) = w;
  }
}

__device__ __forceinline__ void gdn_prep_naive(const int WID, KP p, int l) {
  const int tid = lt(), wave = tid >> 6, lane = tid & 63;
  const bf16_t* gsrc[3] = {(const bf16_t*)(p->ws + WS_B + B_GQ), (const bf16_t*)(p->ws + WS_B + B_GK), (const bf16_t*)(p->ws + WS_B + B_GV)};
  bf16_t* gdst[3] = {(bf16_t*)(p->ws + WS_C + C_QH), (bf16_t*)(p->ws + WS_C + C_KH), (bf16_t*)(p->ws + WS_C + C_VV)};
  const float* ba = (const float*)(p->ws + WS_B + B_BA);
  float* beta = (float*)(p->ws + WS_C + C_BETA);
  float* gg = (float*)(p->ws + WS_C + C_G);
  const float* convw = p->in[I_CONVW] + (size_t)l * 4 * 1536;
  for (int item = blockIdx.x * 8 + wave; item < TOK * 4; item += gridDim.x * 8) {
    const int t = item >> 2, hd = item & 3, tl = t & 4095;
    const int c = hd * 128 + lane * 2;
    float val[3][2];
#pragma unroll
    for (int part = 0; part < 3; ++part) {
      float a0 = 0.f, a1 = 0.f;
#pragma unroll
      for (int j = 0; j < 4; ++j) {
        if (tl - 3 + j >= 0) {
          const unsigned w = *(const unsigned*)(gsrc[part] + (size_t)(t - 3 + j) * 512 + c);
          a0 += convw[j * 1536 + part * 512 + c] * bflo(w);
          a1 += convw[j * 1536 + part * 512 + c + 1] * bfhi(w);
        }
      }
      val[part][0] = silu_f(a0); val[part][1] = silu_f(a1);
    }
    const float sq = WSUM(val[0][0] * val[0][0] + val[0][1] * val[0][1]);
    const float sk = WSUM(val[1][0] * val[1][0] + val[1][1] * val[1][1]);
    const float rq = rsqrtf(sq + 1e-6f) * 0.08838834764831845f, rk = rsqrtf(sk + 1e-6f);
    *(unsigned*)(gdst[0] + (size_t)t * 512 + c) = pk2bf(val[0][0] * rq, val[0][1] * rq);
    *(unsigned*)(gdst[1] + (size_t)t * 512 + c) = pk2bf(val[1][0] * rk, val[1][1] * rk);
    *(unsigned*)(gdst[2] + (size_t)t * 512 + c) = pk2bf(val[2][0], val[2][1]);
    if (lane == 0) {
      beta[(size_t)t * 4 + hd] = sigmoid_f(ba[(size_t)t * 8 + hd]);
      gg[(size_t)t * 4 + hd] = -expf(p->in[I_ALOG][l * 4 + hd]) * softplus_f(ba[(size_t)t * 8 + 4 + hd] + p->in[I_DTB][l * 4 + hd]);
    }
  }
}
__device__ __forceinline__ void moba_kmean(const int WID, KP p, unsigned char* lds) {
  const int tid = lt();
  float* red = (float*)lds;
  const bf16_t* mk = (const bf16_t*)(p->ws + WS_B + B_MK);
  float* kmean = (float*)(p->ws + WS_MISC + MISC_KMEAN);
  for (int task = blockIdx.x; task < 512; task += gridDim.x) {
    const int b = task >> 6, hd = (task >> 4) & 3, blk = task & 15;
    const int d = tid & 63, part = tid >> 6;
    float s = 0.f;
#pragma unroll 16
    for (int j = part * 32; j < part * 32 + 32; ++j) s += bf2f(mk[(size_t)(b * 4096 + blk * 256 + j) * 256 + hd * 64 + d]);
    red[part * 64 + d] = s;
    __syncthreads();
    if (tid < 64) { float a = 0.f; for (int q = 0; q < 8; ++q) a += red[q * 64 + tid]; kmean[(size_t)task * 64 + tid] = a * (1.f / 256.f); }
    __syncthreads();
  }
}
__device__ __forceinline__ void gdn_scan_naive(const int WID, KP p, unsigned char* lds) {
  const int tid = lt();
  float* part = (float*)lds;
  float* kq = part + 2 * 3 * 16 * 32;
  const bf16_t* qh = (const bf16_t*)(p->ws + WS_C + C_QH);
  const bf16_t* kh = (const bf16_t*)(p->ws + WS_C + C_KH);
  const bf16_t* vv = (const bf16_t*)(p->ws + WS_C + C_VV);
  const float* beta = (const float*)(p->ws + WS_C + C_BETA);
  const float* gg = (const float*)(p->ws + WS_C + C_G);
  bf16_t* go = (bf16_t*)(p->ws + WS_D + D_GA);
  const int v = tid & 31, kg = tid >> 5;
  for (int task = blockIdx.x; task < 128; task += gridDim.x) {
    const int b = task >> 4, hd = (task >> 2) & 3, vs = task & 3;
    float S[8];
#pragma unroll
    for (int i = 0; i < 8; ++i) S[i] = 0.f;
    for (int t = 0; t < SEQ; ++t) {
      const size_t tok = (size_t)b * 4096 + t;
      const int pb = t & 1;
      if (tid < 128) kq[(pb * 2 + 0) * 128 + tid] = bf2f(kh[tok * 512 + hd * 128 + tid]);
      else if (tid < 256) kq[(pb * 2 + 1) * 128 + tid - 128] = bf2f(qh[tok * 512 + hd * 128 + tid - 128]);
      __syncthreads();
      float ks = 0.f, qs = 0.f, qk = 0.f;
#pragma unroll
      for (int i = 0; i < 8; ++i) {
        const float kk = kq[(pb * 2 + 0) * 128 + kg * 8 + i], qq = kq[(pb * 2 + 1) * 128 + kg * 8 + i];
        ks += kk * S[i]; qs += qq * S[i]; qk += kk * qq;
      }
      part[((pb * 3 + 0) * 16 + kg) * 32 + v] = ks;
      part[((pb * 3 + 1) * 16 + kg) * 32 + v] = qs;
      part[((pb * 3 + 2) * 16 + kg) * 32 + v] = qk;
      __syncthreads();
      float kS = 0.f, qS = 0.f, qK = 0.f;
#pragma unroll
      for (int j = 0; j < 16; ++j) { kS += part[((pb * 3 + 0) * 16 + j) * 32 + v]; qS += part[((pb * 3 + 1) * 16 + j) * 32 + v]; qK += part[((pb * 3 + 2) * 16 + j) * 32 + v]; }
      const float eg = __expf(gg[tok * 4 + hd]);
      const float bt = beta[tok * 4 + hd];
      const float vt = bf2f(vv[tok * 512 + hd * 128 + vs * 32 + v]);
      const float vnew = bt * (vt - eg * kS);
#pragma unroll
      for (int i = 0; i < 8; ++i) S[i] = eg * S[i] + kq[(pb * 2 + 0) * 128 + kg * 8 + i] * vnew;
      if (kg == 0) go[tok * 512 + hd * 128 + vs * 32 + v] = f2bf(eg * qS + qK * vnew);
    }
    __syncthreads();
  }
}
__device__ __forceinline__ void gdn_outnorm(const int WID, KP p, int l) {
  const int tid = lt(), wave = tid >> 6, lane = tid & 63;
  bf16_t* go = (bf16_t*)(p->ws + WS_D + D_GA);
  const bf16_t* gz = (const bf16_t*)(p->ws + WS_B + B_GZ);
  const float* nw = p->in[I_GNW] + l * 128 + (lane & 15) * 8;
  const f32x4 na = *(const f32x4*)nw, nb = *(const f32x4*)(nw + 4);
  const int stride = gridDim.x * 8;
  for (int item = blockIdx.x * 8 + wave; item < TOK; item += 4 * stride) {
    u32x4 w[4], z[4];
#pragma unroll
    for (int k = 0; k < 4; ++k) {
      const int it = item + k * stride;
      const size_t off = (size_t)(it < TOK ? it : item) * 512 + lane * 8;
      w[k] = *(const u32x4*)(go + off); z[k] = *(const u32x4*)(gz + off);
    }
#pragma unroll
    for (int k = 0; k < 4; ++k) {
      const int it = item + k * stride;
      if (it < TOK) {
        const size_t off = (size_t)it * 512 + lane * 8;
        float o[8], zz[8];
        o[0] = bflo(w[k].x); o[1] = bfhi(w[k].x); o[2] = bflo(w[k].y); o[3] = bfhi(w[k].y); o[4] = bflo(w[k].z); o[5] = bfhi(w[k].z); o[6] = bflo(w[k].w); o[7] = bfhi(w[k].w);
        zz[0] = bflo(z[k].x); zz[1] = bfhi(z[k].x); zz[2] = bflo(z[k].y); zz[3] = bfhi(z[k].y); zz[4] = bflo(z[k].z); zz[5] = bfhi(z[k].z); zz[6] = bflo(z[k].w); zz[7] = bfhi(z[k].w);
        float ss = 0.f;
#pragma unroll
        for (int e = 0; e < 8; ++e) ss += o[e] * o[e];
        ss += shx(ss, 1, lane); ss += shx(ss, 2, lane); ss += shx(ss, 4, lane); ss += shx(ss, 8, lane);
        const float r = rsqrtf(ss * (1.f / 128.f) + 1e-6f);
        u32x4 ov;
        ov.x = pk2bf(o[0] * r * na[0] * silu_f(zz[0]), o[1] * r * na[1] * silu_f(zz[1])); ov.y = pk2bf(o[2] * r * na[2] * silu_f(zz[2]), o[3] * r * na[3] * silu_f(zz[3]));
        ov.z = pk2bf(o[4] * r * nb[0] * silu_f(zz[4]), o[5] * r * nb[1] * silu_f(zz[5])); ov.w = pk2bf(o[6] * r * nb[2] * silu_f(zz[6]), o[7] * r * nb[3] * silu_f(zz[7]));
        *(u32x4*)(go + off) = ov;
      }
    }
  }
}
__device__ __forceinline__ void s5_naive(const int WID, KP p, int l) {
  const int tid = lt();
  if (tid >= 64) return;
  const int pp = tid;
  const bf16_t* s5u = (const bf16_t*)(p->ws + WS_B + B_S5U);
  bf16_t* zg = (bf16_t*)(p->ws + WS_D + D_ZG);
  for (int task = (int)gridDim.x - 1 - (int)blockIdx.x; task < 128; task += gridDim.x) {
    const int b = task >> 4, g = task & 15;
    const float dt = expf(p->in[I_S5LDT][l * 16 + g]);
    const float lr = p->in[I_S5ARE][l * 1024 + g * 64 + pp], li = p->in[I_S5AIM][l * 1024 + g * 64 + pp];
    const float er = expf(lr * dt);
    const float ar = er * cosf(li * dt), ai = er * sinf(li * dt);
    const float nr = ar - 1.f, ni = ai, den = lr * lr + li * li;
    const float fr = (nr * lr + ni * li) / den, fi = (ni * lr - nr * li) / den;
    float bbr[16], bbi[16];
#pragma unroll
    for (int h = 0; h < 16; ++h) {
      const float br = p->in[I_S5BRE][(size_t)l * 16384 + (g * 64 + pp) * 16 + h], bi = p->in[I_S5BIM][(size_t)l * 16384 + (g * 64 + pp) * 16 + h];
      bbr[h] = fr * br - fi * bi; bbi[h] = fr * bi + fi * br;
    }
    const int oh = pp & 15, opg = pp >> 4;
    float cr[16], ci[16];
#pragma unroll
    for (int i = 0; i < 16; ++i) {
      cr[i] = p->in[I_S5CRE][(size_t)l * 16384 + (g * 16 + oh) * 64 + opg * 16 + i];
      ci[i] = p->in[I_S5CIM][(size_t)l * 16384 + (g * 16 + oh) * 64 + opg * 16 + i];
    }
    const float dval = p->in[I_S5D][l * 256 + g * 16 + oh];
    float sr = 0.f, si = 0.f;
    for (int t = 0; t < SEQ; ++t) {
      const size_t tok = (size_t)b * 4096 + t;
      const float uv = bf2f(s5u[tok * 256 + g * 16 + (pp & 15)]);
      float bur = 0.f, bui = 0.f;
#pragma unroll
      for (int h = 0; h < 16; ++h) { const float uh = shl(uv, h); bur += bbr[h] * uh; bui += bbi[h] * uh; }
      const float nsr = ar * sr - ai * si + bur, nsi = ar * si + ai * sr + bui;
      sr = nsr; si = nsi;
      float y = 0.f;
#pragma unroll
      for (int i = 0; i < 16; ++i) y += cr[i] * shl(sr, opg * 16 + i) - ci[i] * shl(si, opg * 16 + i);
      y += shx(y, 16, pp);
      y += shx(y, 32, pp);
      if (opg == 0) zg[tok * 256 + g * 16 + oh] = f2bf(gelu_f(y + dval * uv));
    }
  }
}
__device__ __forceinline__ void moba_one(KP p, int t, int hd, int lane) {
  const bf16_t* mq = (const bf16_t*)(p->ws + WS_B + B_MQ);
  const bf16_t* mk = (const bf16_t*)(p->ws + WS_B + B_MK);
  const bf16_t* mv = (const bf16_t*)(p->ws + WS_B + B_MV);
  const float* kmean = (const float*)(p->ws + WS_MISC + MISC_KMEAN);
  bf16_t* mo = (bf16_t*)(p->ws + WS_D + D_MO);
  const int b = t >> 12, tl = t & 4095, own = tl >> 8;
  float q[64];
#pragma unroll
  for (int i = 0; i < 8; ++i) {
    const u32x4 w = *(const u32x4*)(mq + (size_t)t * 256 + hd * 64 + i * 8);
    q[i * 8 + 0] = bflo(w.x); q[i * 8 + 1] = bfhi(w.x); q[i * 8 + 2] = bflo(w.y); q[i * 8 + 3] = bfhi(w.y);
    q[i * 8 + 4] = bflo(w.z); q[i * 8 + 5] = bfhi(w.z); q[i * 8 + 6] = bflo(w.w); q[i * 8 + 7] = bfhi(w.w);
  }
  float g0 = -3e38f, g1 = -3e38f, g2 = -3e38f;
  int i0 = -1, i1 = -1, i2 = -1;
  for (int n = 0; n < own; ++n) {
    const float* km = kmean + ((size_t)(b * 4 + hd) * 16 + n) * 64;
    float gsum = 0.f;
#pragma unroll
    for (int d = 0; d < 64; ++d) gsum += q[d] * km[d];
    if (gsum > g0) { g2 = g1; i2 = i1; g1 = g0; i1 = i0; g0 = gsum; i0 = n; }
    else if (gsum > g1) { g2 = g1; i2 = i1; g1 = gsum; i1 = n; }
    else if (gsum > g2) { g2 = gsum; i2 = n; }
  }
  float s[16];
  const int blks[4] = {i0, i1, i2, own};
  float mx = -3e38f;
#pragma unroll
  for (int bi = 0; bi < 4; ++bi) {
    const int blk = blks[bi];
#pragma unroll
    for (int kk = 0; kk < 4; ++kk) {
      float sc = -1e30f;
      if (blk >= 0) {
        const int key = blk * 256 + kk * 64 + lane;
        if (key <= tl) {
          const bf16_t* kp = mk + (size_t)(b * 4096 + key) * 256 + hd * 64;
          float a = 0.f;
#pragma unroll
          for (int i = 0; i < 8; ++i) {
            const u32x4 w = *(const u32x4*)(kp + i * 8);
            a += q[i * 8 + 0] * bflo(w.x) + q[i * 8 + 1] * bfhi(w.x) + q[i * 8 + 2] * bflo(w.y) + q[i * 8 + 3] * bfhi(w.y)
               + q[i * 8 + 4] * bflo(w.z) + q[i * 8 + 5] * bfhi(w.z) + q[i * 8 + 6] * bflo(w.w) + q[i * 8 + 7] * bfhi(w.w);
          }
          sc = a * 0.125f;
        }
      }
      s[bi * 4 + kk] = sc;
      mx = fmaxf(mx, sc);
    }
  }
  mx = WMAX(mx);
  float lsum = 0.f;
#pragma unroll
  for (int i = 0; i < 16; ++i) { s[i] = (s[i] > -1e29f) ? __expf(s[i] - mx) : 0.f; lsum += s[i]; }
  lsum = WSUM(lsum);
  const float inv = 1.f / lsum;
  float acc = 0.f;
#pragma unroll
  for (int bi = 0; bi < 4; ++bi) {
    const int blk = blks[bi];
    if (blk < 0) continue;
#pragma unroll
    for (int kk = 0; kk < 4; ++kk) {
      const float pv = s[bi * 4 + kk];
      for (int ll = 0; ll < 64; ++ll) {
        const int key = blk * 256 + kk * 64 + ll;
        if (key > tl) break;
        const float pj = shl(pv, ll);
        acc += pj * bf2f(mv[(size_t)(b * 4096 + key) * 256 + hd * 64 + lane]);
      }
    }
  }
  mo[(size_t)t * 256 + hd * 64 + lane] = f2bf(acc * inv);
}
__device__ __forceinline__ void moba_naive(const int WID, KP p, int l, unsigned char* lds) {
  const int tid = lt(), wave = tid >> 6, lane = tid & 63;
  int* nxt = (int*)(lds + 16384);
  unsigned* ctr = (unsigned*)(p->ws + WS_MISC + MISC_CTR) + l;
  for (;;) {
    __syncthreads();
    if (tid == 0) *nxt = (int)atomicAdd(ctr, 1u);
    __syncthreads();
    const int chunk = *nxt;
    if (chunk >= TOK / 16) break;
    for (int it = 0; it < 8; ++it) moba_one(p, chunk * 16 + it * 2 + (wave >> 2), wave & 3, lane);
  }
}

__device__ __forceinline__ void peer_naive(const int WID, KP p, int l, unsigned char* lds) {
  const int tid = lt(), hd = tid >> 6, lane = tid & 63;
  float* red = (float*)lds;
  unsigned* eids = (unsigned*)(lds + 32768);
  float* egs = (float*)(lds + 32768 + 512);
  float* sred = (float*)(lds + 32768 + 1024);
  float* w8 = (float*)(lds + 36864);
  const bool last = (l == 1);
  const unsigned short* sc = (const unsigned short*)(p->ws + WS_B + B_SCORE);
  bf16_t* h = (bf16_t*)(p->ws + WS_A);
  const bf16_t* tu = (const bf16_t*)(p->ws + WS_D + D_TU);
  const bf16_t* tv = (const bf16_t*)(p->ws + WS_D + D_TV);
  const float* mod = (const float*)(p->ws + WS_MISC + MISC_MOD);
  float* x = p->out;
  float* ba = (float*)(p->ws + WS_B + B_BA);
  if (!last) {
    const float* w_in_n = p->in[I_WIN] + (size_t)(l + 1) * 1024 * IN_COLS;
    for (int i = tid; i < 8192; i += NTHR) w8[i] = w_in_n[(size_t)(i >> 3) * IN_COLS + 2048 + (i & 7)];
  }
  __syncthreads();
  for (int t = blockIdx.x; t < TOK; t += gridDim.x) {
    const int b = t >> 12;
    const unsigned short* sp = sc + (size_t)t * 2048 + hd * 256;
    float sA[2] = {h2f(sp[lane]), h2f(sp[64 + lane])};
    float sB[2] = {h2f(sp[128 + lane]), h2f(sp[192 + lane])};
    float v1 = 0.f, v2 = 0.f; int i1 = 0, i2 = 0;
    for (int r = 0; r < 16; ++r) {
      {
        const float wm = WMAX(fmaxf(sA[0], sA[1]));
        unsigned long long bal = __ballot(sA[0] == wm);
        int idx;
        if (bal) { idx = __ffsll((long long)bal) - 1; if (lane == idx) sA[0] = -3e38f; }
        else { bal = __ballot(sA[1] == wm); idx = __ffsll((long long)bal) - 1; if (lane == idx) sA[1] = -3e38f; idx += 64; }
        if (lane == r) { v1 = wm; i1 = idx; }
      }
      {
        const float wm = WMAX(fmaxf(sB[0], sB[1]));
        unsigned long long bal = __ballot(sB[0] == wm);
        int idx;
        if (bal) { idx = __ffsll((long long)bal) - 1; if (lane == idx) sB[0] = -3e38f; }
        else { bal = __ballot(sB[1] == wm); idx = __ffsll((long long)bal) - 1; if (lane == idx) sB[1] = -3e38f; idx += 64; }
        if (lane == r) { v2 = wm; i2 = idx; }
      }
    }
    float cs[4];
    {
      const float va = shl(v1, lane >> 2);
#pragma unroll
      for (int j = 0; j < 4; ++j) cs[j] = va + shl(v2, (lane & 3) * 4 + j);
    }
    float tvv = 0.f; int tc = 0;
    for (int r = 0; r < 16; ++r) {
      const float wm = WMAX(fmaxf(fmaxf(cs[0], cs[1]), fmaxf(cs[2], cs[3])));
      int mine = 1 << 30;
#pragma unroll
      for (int j = 3; j >= 0; --j) if (cs[j] == wm) mine = lane * 4 + j;
      int best = mine;
#pragma unroll
      for (int o = 32; o > 0; o >>= 1) best = min(best, shxi(best, o, lane));
      if ((best >> 2) == lane) {
#pragma unroll
        for (int j = 0; j < 4; ++j) if (j == (best & 3)) cs[j] = -3e38f;
      }
      if (lane == r) { tvv = wm; tc = best; }
    }
    {
      const float mx = shl(tvv, 0);
      const float e = (lane < 16) ? __expf(tvv - mx) : 0.f;
      const float sum = WSUM(e);
      const int ea = shli(i1, tc >> 4), eb = shli(i2, tc & 15);
      if (lane < 16) { eids[hd * 16 + lane] = (unsigned)(ea * 128 + eb); egs[hd * 16 + lane] = e / sum; }
    }
    float hv[16];
    {
      const u32x4 a = *(const u32x4*)(h + (size_t)t * 1024 + lane * 16), c = *(const u32x4*)(h + (size_t)t * 1024 + lane * 16 + 8);
      hv[0] = bflo(a.x); hv[1] = bfhi(a.x); hv[2] = bflo(a.y); hv[3] = bfhi(a.y); hv[4] = bflo(a.z); hv[5] = bfhi(a.z); hv[6] = bflo(a.w); hv[7] = bfhi(a.w);
      hv[8] = bflo(c.x); hv[9] = bfhi(c.x); hv[10] = bflo(c.y); hv[11] = bfhi(c.y); hv[12] = bflo(c.z); hv[13] = bfhi(c.z); hv[14] = bflo(c.w); hv[15] = bfhi(c.w);
    }
    float acc[16];
#pragma unroll
    for (int j = 0; j < 16; ++j) acc[j] = 0.f;
    __syncthreads();
    for (int k = 0; k < 16; ++k) {
      const unsigned e = eids[hd * 16 + k];
      const float gt = egs[hd * 16 + k];
      const u32x4 a = *(const u32x4*)(tu + (size_t)e * 1024 + lane * 16), c = *(const u32x4*)(tu + (size_t)e * 1024 + lane * 16 + 8);
      float d = hv[0] * bflo(a.x) + hv[1] * bfhi(a.x) + hv[2] * bflo(a.y) + hv[3] * bfhi(a.y) + hv[4] * bflo(a.z) + hv[5] * bfhi(a.z) + hv[6] * bflo(a.w) + hv[7] * bfhi(a.w)
              + hv[8] * bflo(c.x) + hv[9] * bfhi(c.x) + hv[10] * bflo(c.y) + hv[11] * bfhi(c.y) + hv[12] * bflo(c.z) + hv[13] * bfhi(c.z) + hv[14] * bflo(c.w) + hv[15] * bfhi(c.w);
      d = WSUM(d);
      const float w = gt * gelu_f(d);
      const u32x4 va = *(const u32x4*)(tv + (size_t)e * 1024 + lane * 16), vc = *(const u32x4*)(tv + (size_t)e * 1024 + lane * 16 + 8);
      acc[0] += w * bflo(va.x); acc[1] += w * bfhi(va.x); acc[2] += w * bflo(va.y); acc[3] += w * bfhi(va.y);
      acc[4] += w * bflo(va.z); acc[5] += w * bfhi(va.z); acc[6] += w * bflo(va.w); acc[7] += w * bfhi(va.w);
      acc[8] += w * bflo(vc.x); acc[9] += w * bfhi(vc.x); acc[10] += w * bflo(vc.y); acc[11] += w * bfhi(vc.y);
      acc[12] += w * bflo(vc.z); acc[13] += w * bfhi(vc.z); acc[14] += w * bflo(vc.w); acc[15] += w * bfhi(vc.w);
    }
#pragma unroll
    for (int j = 0; j < 16; ++j) red[hd * 1024 + lane * 16 + j] = acc[j];
    __syncthreads();
    const int c0 = tid * 2;
    float o0 = 0.f, o1 = 0.f;
#pragma unroll
    for (int j = 0; j < 8; ++j) { o0 += red[j * 1024 + c0]; o1 += red[j * 1024 + c0 + 1]; }
    const float* g2 = mod + ((size_t)l * 8 + b) * 6144 + 5120;
    float* xr = x + (size_t)t * 1024 + c0;
    const float x0 = xr[0] + g2[c0] * o0, x1 = xr[1] + g2[c0 + 1] * o1;
    float ss = WSUM(x0 * x0 + x1 * x1);
    if (lane == 0) sred[hd * 9 + 8] = ss;
    __syncthreads();
    ss = 0.f;
#pragma unroll
    for (int j = 0; j < 8; ++j) ss += sred[j * 9 + 8];
    const float r = rsqrtf(ss * (1.f / 1024.f) + 1e-6f);
    if (last) {
      const float* fw = p->in[I_FNW];
      xr[0] = x0 * r * fw[c0]; xr[1] = x1 * r * fw[c0 + 1];
      __syncthreads();
    } else {
      xr[0] = x0; xr[1] = x1;
      const float* nw = p->in[I_N1W] + (l + 1) * 1024;
      const float* mn = mod + ((size_t)(l + 1) * 8 + b) * 6144;
      const float h0 = x0 * r * nw[c0] * (1.f + mn[1024 + c0]) + mn[c0];
      const float h1 = x1 * r * nw[c0 + 1] * (1.f + mn[1024 + c0 + 1]) + mn[c0 + 1];
      *(unsigned*)(h + (size_t)t * 1024 + c0) = pk2bf(h0, h1);
      float a8[8];
#pragma unroll
      for (int j = 0; j < 8; ++j) a8[j] = WSUM(h0 * w8[c0 * 8 + j] + h1 * w8[(c0 + 1) * 8 + j]);
      __syncthreads();
      if (lane == 0) {
#pragma unroll
        for (int j = 0; j < 8; ++j) sred[hd * 9 + j] = a8[j];
      }
      __syncthreads();
      if (tid < 8) { float a = 0.f; for (int j = 0; j < 8; ++j) a += sred[j * 9 + tid]; ba[(size_t)t * 8 + tid] = a; }
      __syncthreads();
    }
  }
}

#define C_W 0
#define C_QG (32 * MiB)
#define C_KDT (64 * MiB)
#define C_U (96 * MiB)
#define C_QK (128 * MiB)
#define C_EGL (144 * MiB)
typedef short bf16x8 __attribute__((ext_vector_type(8)));

__device__ __forceinline__ bf16x8 frag_row(const bf16_t* X, int stride, int row, int col8) { return *(const bf16x8*)(X + row * stride + col8); }
__device__ __forceinline__ bf16x8 frag_tr(const bf16_t* X, int stride, int row0, int colbase, int l15) {
  const bf16_t* a0 = X + (row0 + (l15 >> 2)) * stride + colbase + 4 * (l15 & 3);
  const s16x4 t0 = __builtin_amdgcn_ds_read_tr16_b64_v4i16((LAS s16x4*)a0);
  const s16x4 t1 = __builtin_amdgcn_ds_read_tr16_b64_v4i16((LAS s16x4*)(a0 + 4 * stride));
  bf16x8 v; v[0] = t0[0]; v[1] = t0[1]; v[2] = t0[2]; v[3] = t0[3]; v[4] = t1[0]; v[5] = t1[1]; v[6] = t1[2]; v[7] = t1[3];
  return v;
}
#define LBAR() do { asm volatile("s_waitcnt lgkmcnt(0)" ::: "memory"); __builtin_amdgcn_s_barrier(); asm volatile("" ::: "memory"); } while (0)

__device__ __forceinline__ void gdn_prep(const int WID, KP p, int l, unsigned char* lds) {
  const int tid = lt(), lane = tid & 63, l15 = lane & 15, lg = lane >> 4, w = WID;
  bf16_t* Kb = (bf16_t*)lds;
  bf16_t* Qb = Kb + 64 * 136;
  bf16_t* Vb = Qb + 64 * 136;
  bf16_t* Kw = Vb + 64 * 136;
  bf16_t* PT = Kw + 64 * 136;
  bf16_t* P2 = PT + 64 * 72;
  bf16_t* TT = P2 + 64 * 72;
  bf16_t* T2 = TT + 64 * 72;
  float* Gs = (float*)(T2 + 64 * 72);
  const bf16_t* gsrc[3] = {(const bf16_t*)(p->ws + WS_B + B_GQ), (const bf16_t*)(p->ws + WS_B + B_GK), (const bf16_t*)(p->ws + WS_B + B_GV)};
  const float* ba = (const float*)(p->ws + WS_B + B_BA);
  const float* convw = p->in[I_CONVW] + (size_t)l * 4 * 1536;
  bf16_t* Wg = (bf16_t*)(p->ws + WS_C + C_W);
  bf16_t* QGg = (bf16_t*)(p->ws + WS_C + C_QG);
  bf16_t* KDTg = (bf16_t*)(p->ws + WS_C + C_KDT);
  bf16_t* Ug = (bf16_t*)(p->ws + WS_C + C_U);
  bf16_t* QKg = (bf16_t*)(p->ws + WS_C + C_QK);
  float* EGL = (float*)(p->ws + WS_C + C_EGL);
  for (int item = blockIdx.x; item < 2048; item += gridDim.x) {
    const int b = item >> 8, h = (item >> 6) & 3, c = item & 63;
    const int tok0 = b * 4096 + c * 64;
    if (item == (int)blockIdx.x) STAMP(50);
    if (tid < 64) {
      const size_t t = (size_t)tok0 + tid;
      const float g = -expf(p->in[I_ALOG][l * 4 + h]) * softplus_f(ba[t * 8 + 4 + h] + p->in[I_DTB][l * 4 + h]);
      const float bt = sigmoid_f(ba[t * 8 + h]);
      float G = g;
#pragma unroll
      for (int o = 1; o < 64; o <<= 1) { const float v = shl(G, lane - o); if (lane >= o) G += v; }
      const float Glast = shl(G, 63);
      Gs[tid] = G; Gs[64 + tid] = bt; Gs[128 + tid] = __expf(G); Gs[192 + tid] = __expf(Glast - G);
      if (tid == 0) EGL[item] = __expf(Glast);
    }
    LBAR();
    if (item == (int)blockIdx.x) STAMP(51);
    {
      const int tok = tid >> 3, dg = tid & 7, t = tok0 + tok, tl = c * 64 + tok;
      const float bt = Gs[64 + tok], eg = Gs[128 + tok];
#pragma unroll
      for (int part = 0; part < 3; ++part) {
        float acc[16];
#pragma unroll
        for (int i = 0; i < 16; ++i) acc[i] = 0.f;
        u32x4 raw[4][2];
#pragma unroll
        for (int j = 0; j < 4; ++j) {
          const bf16_t* src = gsrc[part] + (size_t)(tl - 3 + j >= 0 ? t - 3 + j : t) * 512 + h * 128 + dg * 8;
          raw[j][0] = *(const u32x4*)src; raw[j][1] = *(const u32x4*)(src + 64);
        }
#pragma unroll
        for (int j = 0; j < 4; ++j) {
          const float on = (tl - 3 + j >= 0) ? 1.f : 0.f;
          const u32x4 r0 = raw[j][0], r1 = raw[j][1];
          const float* wp = convw + j * 1536 + part * 512 + h * 128 + dg * 8;
          const f32x4 w0 = *(const f32x4*)wp * on, w1 = *(const f32x4*)(wp + 4) * on, w2 = *(const f32x4*)(wp + 64) * on, w3 = *(const f32x4*)(wp + 68) * on;
          acc[0] += w0[0] * bflo(r0.x); acc[1] += w0[1] * bfhi(r0.x); acc[2] += w0[2] * bflo(r0.y); acc[3] += w0[3] * bfhi(r0.y);
          acc[4] += w1[0] * bflo(r0.z); acc[5] += w1[1] * bfhi(r0.z); acc[6] += w1[2] * bflo(r0.w); acc[7] += w1[3] * bfhi(r0.w);
          acc[8] += w2[0] * bflo(r1.x); acc[9] += w2[1] * bfhi(r1.x); acc[10] += w2[2] * bflo(r1.y); acc[11] += w2[3] * bfhi(r1.y);
          acc[12] += w3[0] * bflo(r1.z); acc[13] += w3[1] * bfhi(r1.z); acc[14] += w3[2] * bflo(r1.w); acc[15] += w3[3] * bfhi(r1.w);
        }
        float ss = 0.f;
#pragma unroll
        for (int i = 0; i < 16; ++i) { acc[i] = silu_f(acc[i]); ss += acc[i] * acc[i]; }
        float r = bt;
        if (part < 2) {
          ss += shx(ss, 1, lane); ss += shx(ss, 2, lane); ss += shx(ss, 4, lane);
          r = rsqrtf(ss + 1e-6f) * (part == 0 ? 0.08838834764831845f : 1.f);
        }
        bf16_t* d = (part == 0 ? Qb : part == 1 ? Kb : Vb) + tok * 136 + dg * 8;
        u32x4 o0, o1;
        o0.x = pk2bf(acc[0] * r, acc[1] * r); o0.y = pk2bf(acc[2] * r, acc[3] * r); o0.z = pk2bf(acc[4] * r, acc[5] * r); o0.w = pk2bf(acc[6] * r, acc[7] * r);
        o1.x = pk2bf(acc[8] * r, acc[9] * r); o1.y = pk2bf(acc[10] * r, acc[11] * r); o1.z = pk2bf(acc[12] * r, acc[13] * r); o1.w = pk2bf(acc[14] * r, acc[15] * r);
        *(u32x4*)d = o0; *(u32x4*)(d + 64) = o1;
        if (part == 1) {
          const float r2 = r * bt * eg;
          bf16_t* d2 = Kw + tok * 136 + dg * 8;
          o0.x = pk2bf(acc[0] * r2, acc[1] * r2); o0.y = pk2bf(acc[2] * r2, acc[3] * r2); o0.z = pk2bf(acc[4] * r2, acc[5] * r2); o0.w = pk2bf(acc[6] * r2, acc[7] * r2);
          o1.x = pk2bf(acc[8] * r2, acc[9] * r2); o1.y = pk2bf(acc[10] * r2, acc[11] * r2); o1.z = pk2bf(acc[12] * r2, acc[13] * r2); o1.w = pk2bf(acc[14] * r2, acc[15] * r2);
          *(u32x4*)d2 = o0; *(u32x4*)(d2 + 64) = o1;
        }
      }
    }
    LBAR();
    if (item == (int)blockIdx.x) STAMP(52);
    f32x4 tacc[2];
    if (w < 4) {
      const int ti = w;
#pragma unroll 1
      for (int tj = 0; tj < 4; ++tj) {
        f32x4 a = (f32x4){0.f, 0.f, 0.f, 0.f};
        if (tj <= ti) {
#pragma unroll
          for (int ks = 0; ks < 4; ++ks)
            a = __builtin_amdgcn_mfma_f32_16x16x32_bf16(frag_row(Kb, 136, 16 * ti + l15, 32 * ks + 8 * lg), frag_row(Kb, 136, 16 * tj + l15, 32 * ks + 8 * lg), a, 0, 0, 0);
        }
        const int j = 16 * tj + l15;
        const float Gj = Gs[j];
        float nv[4];
#pragma unroll
        for (int r = 0; r < 4; ++r) {
          const int i = 16 * ti + 4 * lg + r;
          nv[r] = (j < i) ? -Gs[64 + i] * a[r] * __expf(Gs[i] - Gj) : 0.f;
        }
        u32x2 wv; wv.x = pk2bf(nv[0], nv[1]); wv.y = pk2bf(nv[2], nv[3]);
        *(u32x2*)(PT + j * 72 + 16 * ti + 4 * lg) = wv;
#pragma unroll
        for (int r = 0; r < 4; ++r) nv[r] += (j == 16 * ti + 4 * lg + r) ? 1.f : 0.f;
        wv.x = pk2bf(nv[0], nv[1]); wv.y = pk2bf(nv[2], nv[3]);
        *(u32x2*)(TT + j * 72 + 16 * ti + 4 * lg) = wv;
      }
    } else {
      const int ti = w - 4;
      bf16_t* qkp = QKg + (size_t)item * 4096;
#pragma unroll 1
      for (int tj = 0; tj < 4; ++tj) {
        f32x4 a = (f32x4){0.f, 0.f, 0.f, 0.f};
        if (tj <= ti) {
#pragma unroll
          for (int ks = 0; ks < 4; ++ks)
            a = __builtin_amdgcn_mfma_f32_16x16x32_bf16(frag_row(Kb, 136, 16 * tj + l15, 32 * ks + 8 * lg), frag_row(Qb, 136, 16 * ti + l15, 32 * ks + 8 * lg), a, 0, 0, 0);
        }
        const int i = 16 * ti + l15;
        const float Gi = Gs[i];
        float qv[4];
#pragma unroll
        for (int r = 0; r < 4; ++r) {
          const int j = 16 * tj + 4 * lg + r;
          qv[r] = (j <= i) ? a[r] * __expf(Gi - Gs[j]) : 0.f;
        }
        u32x2 wv; wv.x = pk2bf(qv[0], qv[1]); wv.y = pk2bf(qv[2], qv[3]);
        *(u32x2*)(qkp + i * 64 + 16 * tj + 4 * lg) = wv;
      }
    }
    LBAR();
#pragma unroll
    for (int q = 0; q < 2; ++q) {
      const int id = 2 * w + q, ti = id >> 2, tj = id & 3;
      const u32x2 tv = *(const u32x2*)(TT + (16 * tj + l15) * 72 + 16 * ti + 4 * lg);
      tacc[q] = (f32x4){bflo(tv.x), bfhi(tv.x), bflo(tv.y), bfhi(tv.y)};
    }
    if (item == (int)blockIdx.x) STAMP(53);
    bf16_t* Pc = P2; bf16_t* Pn = PT; bf16_t* Tc = TT; bf16_t* Tn = T2;
    {
#pragma unroll
      for (int q = 0; q < 2; ++q) {
        const int id = 2 * w + q, ti = id >> 2, tj = id & 3;
        f32x4 pacc = (f32x4){0.f, 0.f, 0.f, 0.f};
#pragma unroll
        for (int ks = 0; ks < 2; ++ks)
          pacc = __builtin_amdgcn_mfma_f32_16x16x32_bf16(frag_tr(PT, 72, 32 * ks + 8 * lg, 16 * ti, l15), frag_row(PT, 72, 16 * tj + l15, 32 * ks + 8 * lg), pacc, 0, 0, 0);
        u32x2 wv; wv.x = pk2bf(pacc[0], pacc[1]); wv.y = pk2bf(pacc[2], pacc[3]);
        *(u32x2*)(P2 + (16 * tj + l15) * 72 + 16 * ti + 4 * lg) = wv;
      }
    }
    LBAR();
#pragma unroll 1
    for (int it = 0; it < 5; ++it) {
#pragma unroll
      for (int q = 0; q < 2; ++q) {
        const int id = 2 * w + q, ti = id >> 2, tj = id & 3;
        f32x4 pacc = (f32x4){0.f, 0.f, 0.f, 0.f};
#pragma unroll
        for (int ks = 0; ks < 2; ++ks) {
          const bf16x8 bP = frag_row(Pc, 72, 16 * tj + l15, 32 * ks + 8 * lg);
          tacc[q] = __builtin_amdgcn_mfma_f32_16x16x32_bf16(frag_tr(Tc, 72, 32 * ks + 8 * lg, 16 * ti, l15), bP, tacc[q], 0, 0, 0);
          pacc = __builtin_amdgcn_mfma_f32_16x16x32_bf16(frag_tr(Pc, 72, 32 * ks + 8 * lg, 16 * ti, l15), bP, pacc, 0, 0, 0);
        }
        u32x2 wv; wv.x = pk2bf(tacc[q][0], tacc[q][1]); wv.y = pk2bf(tacc[q][2], tacc[q][3]);
        *(u32x2*)(Tn + (16 * tj + l15) * 72 + 16 * ti + 4 * lg) = wv;
        wv.x = pk2bf(pacc[0], pacc[1]); wv.y = pk2bf(pacc[2], pacc[3]);
        *(u32x2*)(Pn + (16 * tj + l15) * 72 + 16 * ti + 4 * lg) = wv;
      }
      LBAR();
      bf16_t* sw = Pc; Pc = Pn; Pn = sw; sw = Tc; Tc = Tn; Tn = sw;
    }
    const bf16_t* TF = Tc;
    if (item == (int)blockIdx.x) STAMP(54);
    {
      bf16_t* up = Ug + (size_t)item * 8192;
      bf16_t* wp = Wg + (size_t)item * 8192;
#pragma unroll 1
      for (int q = 0; q < 2; ++q) {
        const int ct = 2 * w + q;
        const bf16_t* R = (ct < 8) ? Vb : Kw;
        bf16_t* outp = (ct < 8) ? up : wp;
        const int cb = 16 * (ct & 7);
        bf16x8 af[2];
#pragma unroll
        for (int ks = 0; ks < 2; ++ks) af[ks] = frag_tr(R, 136, 32 * ks + 8 * lg, cb, l15);
#pragma unroll
        for (int tt = 0; tt < 4; ++tt) {
          f32x4 a = (f32x4){0.f, 0.f, 0.f, 0.f};
#pragma unroll
          for (int ks = 0; ks < 2; ++ks)
            a = __builtin_amdgcn_mfma_f32_16x16x32_bf16(af[ks], frag_tr(TF, 72, 32 * ks + 8 * lg, 16 * tt, l15), a, 0, 0, 0);
          u32x2 wv; wv.x = pk2bf(a[0], a[1]); wv.y = pk2bf(a[2], a[3]);
          *(u32x2*)(outp + (16 * tt + l15) * 128 + cb + 4 * lg) = wv;
        }
      }
    }
    if (item == (int)blockIdx.x) STAMP(55);
    {
      bf16_t* qgp = QGg + (size_t)item * 8192;
      bf16_t* kdp = KDTg + (size_t)item * 8192;
#pragma unroll
      for (int n = 0; n < 2; ++n) {
        const int idx = tid + 512 * n, tok = idx >> 4, c8 = (idx & 15) * 8;
        const float e = Gs[128 + tok];
        const u32x4 v = *(const u32x4*)(Qb + tok * 136 + c8);
        u32x4 o; o.x = pk2bf(bflo(v.x) * e, bfhi(v.x) * e); o.y = pk2bf(bflo(v.y) * e, bfhi(v.y) * e); o.z = pk2bf(bflo(v.z) * e, bfhi(v.z) * e); o.w = pk2bf(bflo(v.w) * e, bfhi(v.w) * e);
        *(u32x4*)(qgp + tok * 128 + c8) = o;
      }
      {
        const int k = tid & 127, tg = tid >> 7;
        unsigned o[8];
#pragma unroll
        for (int i = 0; i < 8; ++i) {
          const int t0 = tg * 16 + 2 * i;
          o[i] = pk2bf(bf2f(Kb[t0 * 136 + k]) * Gs[192 + t0], bf2f(Kb[(t0 + 1) * 136 + k]) * Gs[192 + t0 + 1]);
        }
        *(u32x4*)(kdp + k * 64 + tg * 16) = (u32x4){o[0], o[1], o[2], o[3]};
        *(u32x4*)(kdp + k * 64 + tg * 16 + 8) = (u32x4){o[4], o[5], o[6], o[7]};
      }
    }
    LBAR();
    if (item == (int)blockIdx.x) STAMP(56);
  }
}

#define SCB_W 0
#define SCB_Q 16384
#define SCB_D 32768
#define SCB_K 49152
#define SCB_U 57344
#define SCB_BYTES 61952
__device__ __forceinline__ void gdn_scan(const int WID, KP p, unsigned char* lds) {
  const int tid = lt(), lane = tid & 63, l15 = lane & 15, lg = lane >> 4;
  const int w = WID, rt = w >> 1, ct = w & 1;
  bf16_t* ST = (bf16_t*)lds;
  bf16_t* VT = ST + 32 * 136;
  unsigned char* BUF = lds + 13312;
  bf16_t* OL = (bf16_t*)(lds + 13312 + 2 * SCB_BYTES);
  const unsigned char* Wg = p->ws + WS_C + C_W;
  const unsigned char* QGg = p->ws + WS_C + C_QG;
  const unsigned char* KDTg = p->ws + WS_C + C_KDT;
  const unsigned char* Ug = p->ws + WS_C + C_U;
  const unsigned char* QKg = p->ws + WS_C + C_QK;
  const float* EGL = (const float*)(p->ws + WS_C + C_EGL);
  bf16_t* go = (bf16_t*)(p->ws + WS_D + D_GA);
  const int p0 = tid, p1 = tid + 512;
  const int dW0 = (p0 >> 4) * 256 + (((p0 & 15) ^ ((p0 >> 4) & 15)) << 4), dW1 = (p1 >> 4) * 256 + (((p1 & 15) ^ ((p1 >> 4) & 15)) << 4);
  const int dD0 = (p0 >> 3) * 128 + (((p0 & 7) ^ ((p0 >> 3) & 7)) << 4), dD1 = (p1 >> 3) * 128 + (((p1 & 7) ^ ((p1 >> 3) & 7)) << 4);
  const int dK0 = dD0;
  const int dU0 = (tid >> 2) * 72 + ((tid & 3) << 4);
  for (int task = blockIdx.x; task < 128; task += gridDim.x) {
    const int xq = task & 7, yq = task >> 3;
    const int bh = (yq >> 2) * 8 + xq, vs = yq & 3, b = bh >> 2, h = bh & 3;
    for (int i = tid; i < 32 * 136 / 2; i += NTHR) ((unsigned*)ST)[i] = 0u;
    f32x4 Sacc[2] = {(f32x4){0.f, 0.f, 0.f, 0.f}, (f32x4){0.f, 0.f, 0.f, 0.f}};
    u32x4 rA[8], rB[8];
    float eA, eB;
#define SG_LOAD(rr, ee, cc) do { const size_t ch_ = (size_t)bh * 64 + ((cc) < 64 ? (cc) : 63); \
      rr[0] = *(const u32x4*)(Wg + ch_ * 16384 + (size_t)p0 * 16); rr[1] = *(const u32x4*)(Wg + ch_ * 16384 + (size_t)p1 * 16); \
      rr[2] = *(const u32x4*)(QGg + ch_ * 16384 + (size_t)p0 * 16); rr[3] = *(const u32x4*)(QGg + ch_ * 16384 + (size_t)p1 * 16); \
      rr[4] = *(const u32x4*)(KDTg + ch_ * 16384 + (size_t)p0 * 16); rr[5] = *(const u32x4*)(KDTg + ch_ * 16384 + (size_t)p1 * 16); \
      rr[6] = *(const u32x4*)(QKg + ch_ * 8192 + (size_t)p0 * 16); \
      if (tid < 256) rr[7] = *(const u32x4*)(Ug + ch_ * 16384 + (size_t)(tid >> 2) * 256 + vs * 64 + (tid & 3) * 16); \
      ee = EGL[ch_]; } while (0)
#define SG_STORE(rr, bufi) do { unsigned char* B_ = BUF + (bufi) * SCB_BYTES; \
      *(u32x4*)(B_ + SCB_W + dW0) = rr[0]; *(u32x4*)(B_ + SCB_W + dW1) = rr[1]; *(u32x4*)(B_ + SCB_Q + dW0) = rr[2]; *(u32x4*)(B_ + SCB_Q + dW1) = rr[3]; \
      *(u32x4*)(B_ + SCB_D + dD0) = rr[4]; *(u32x4*)(B_ + SCB_D + dD1) = rr[5]; *(u32x4*)(B_ + SCB_K + dK0) = rr[6]; \
      if (tid < 256) *(u32x4*)(B_ + SCB_U + dU0) = rr[7]; } while (0)
#define SG_FLUSH(cp) do { if (tid < 256) { const u32x4 ov_ = *(const u32x4*)(OL + (tid >> 2) * 40 + (tid & 3) * 8); \
      *(u32x4*)(go + ((size_t)b * 4096 + (cp) * 64 + (tid >> 2)) * 512 + h * 128 + vs * 32 + (tid & 3) * 8) = ov_; } } while (0)
#define SG_STEP(bufi, egl, c) do { if ((c) < 64) { const unsigned char* B_ = BUF + (bufi) * SCB_BYTES; \
      f32x4 P = (f32x4){0.f, 0.f, 0.f, 0.f}, O = (f32x4){0.f, 0.f, 0.f, 0.f}; \
      _Pragma("unroll") for (int k = 0; k < 4; ++k) { const bf16x8 bS = *(const bf16x8*)(ST + (ct * 16 + l15) * 136 + 32 * k + 8 * lg); \
        const int fo = (16 * rt + l15) * 256 + (((4 * k + lg) ^ l15) << 4); \
        P = __builtin_amdgcn_mfma_f32_16x16x32_bf16(*(const bf16x8*)(B_ + SCB_W + fo), bS, P, 0, 0, 0); \
        O = __builtin_amdgcn_mfma_f32_16x16x32_bf16(*(const bf16x8*)(B_ + SCB_Q + fo), bS, O, 0, 0, 0); } \
      { const bf16_t* up_ = (const bf16_t*)(B_ + SCB_U) + (16 * rt + 4 * lg) * 36 + ct * 16 + l15; \
        u32x2 wv; wv.x = pk2bf(bf2f(up_[0]) - P[0], bf2f(up_[36]) - P[1]); wv.y = pk2bf(bf2f(up_[72]) - P[2], bf2f(up_[108]) - P[3]); \
        *(u32x2*)(VT + (ct * 16 + l15) * 72 + 16 * rt + 4 * lg) = wv; } \
      LBAR(); \
      bf16x8 bV[2]; \
      _Pragma("unroll") for (int s = 0; s < 2; ++s) bV[s] = *(const bf16x8*)(VT + (ct * 16 + l15) * 72 + 32 * s + 8 * lg); \
      _Pragma("unroll") for (int s = 0; s < 2; ++s) O = __builtin_amdgcn_mfma_f32_16x16x32_bf16(*(const bf16x8*)(B_ + SCB_K + (16 * rt + l15) * 128 + (((4 * s + lg) ^ (l15 & 7)) << 4)), bV[s], O, 0, 0, 0); \
      { bf16_t* ol_ = OL + (16 * rt + 4 * lg) * 40 + ct * 16 + l15; \
        _Pragma("unroll") for (int r = 0; r < 4; ++r) ol_[r * 40] = f2bf(O[r]); } \
      _Pragma("unroll") for (int kt = 0; kt < 2; ++kt) { Sacc[kt] = Sacc[kt] * egl; \
        _Pragma("unroll") for (int s = 0; s < 2; ++s) Sacc[kt] = __builtin_amdgcn_mfma_f32_16x16x32_bf16(*(const bf16x8*)(B_ + SCB_D + (16 * (2 * (w >> 1) + kt) + l15) * 128 + (((4 * s + lg) ^ (l15 & 7)) << 4)), bV[s], Sacc[kt], 0, 0, 0); \
        u32x2 wv; wv.x = pk2bf(Sacc[kt][0], Sacc[kt][1]); wv.y = pk2bf(Sacc[kt][2], Sacc[kt][3]); \
        *(u32x2*)(ST + (ct * 16 + l15) * 136 + 16 * (2 * (w >> 1) + kt) + 4 * lg) = wv; } } } while (0)
    SG_LOAD(rA, eA, 0);
    SG_STORE(rA, 0);
    float e0 = eA;
    SG_LOAD(rB, eB, 1);
    __syncthreads();
#pragma unroll 1
    for (int c = 0; c < 64; c += 2) {
      SG_LOAD(rA, eA, c + 2);
      if (c > 0) SG_FLUSH(c - 1);
      SG_STEP(0, e0, c);
      SG_STORE(rB, 1); const float e1 = eB;
      LBAR();
      SG_LOAD(rB, eB, c + 3);
      SG_FLUSH(c);
      SG_STEP(1, e1, c + 1);
      SG_STORE(rA, 0); e0 = eA;
      LBAR();
    }
    SG_FLUSH(63);
    __syncthreads();
  }
}

#define MB_STRIDE 72
__device__ __forceinline__ void moba_attn(const int WID, KP p, int ctr_idx, unsigned char* lds) {
  const int tid = lt(), lane = tid & 63, l15 = lane & 15, lg = lane >> 4, w = WID;
  bf16_t* Ks = (bf16_t*)lds;
  bf16_t* Vs = Ks + 2 * 128 * MB_STRIDE;
  int* nxt = (int*)(lds + 4 * 128 * MB_STRIDE * 2);
  const bf16_t* mq = (const bf16_t*)(p->ws + WS_B + B_MQ);
  const bf16_t* mk = (const bf16_t*)(p->ws + WS_B + B_MK);
  const bf16_t* mv = (const bf16_t*)(p->ws + WS_B + B_MV);
  const float* kmean = (const float*)(p->ws + WS_MISC + MISC_KMEAN);
  bf16_t* mo = (bf16_t*)(p->ws + WS_D + D_MO);
  unsigned* ctr = (unsigned*)(p->ws + WS_MISC + MISC_CTR) + ctr_idx;
  const int skey = tid >> 3, sd = (tid & 7) * 8;
  for (;;) {
    __syncthreads();
    if (tid == 0) *nxt = (int)atomicAdd(ctr, 1u);
    __syncthreads();
    const int task = *nxt;
    if (task >= 1024) break;
    const int qt = 31 - (task >> 5), b = (task & 31) >> 2, h = task & 3;
    const int own = qt >> 1;
    const int NT = 4 * own + 2 + 2 * (qt & 1);
    const size_t tokb = (size_t)b * 4096;
    const int tl = qt * 128 + w * 16 + l15;
    bf16x8 qf[2];
    {
      const bf16_t* qp = mq + (tokb + tl) * 256 + h * 64 + 8 * lg;
      qf[0] = *(const bf16x8*)qp; qf[1] = *(const bf16x8*)(qp + 32);
    }
    unsigned sel = 1u << own;
    if (own > 0) {
      f32x4 g4 = (f32x4){0.f, 0.f, 0.f, 0.f};
#pragma unroll
      for (int ks = 0; ks < 2; ++ks) {
        const float* kmp = kmean + ((size_t)(b * 4 + h) * 16 + l15) * 64 + 32 * ks + 8 * lg;
        const f32x4 a0 = *(const f32x4*)kmp, a1 = *(const f32x4*)(kmp + 4);
        u32x4 pk; pk.x = pk2bf(a0[0], a0[1]); pk.y = pk2bf(a0[2], a0[3]); pk.z = pk2bf(a1[0], a1[1]); pk.w = pk2bf(a1[2], a1[3]);
        g4 = __builtin_amdgcn_mfma_f32_16x16x32_bf16(__builtin_bit_cast(bf16x8, pk), qf[ks], g4, 0, 0, 0);
      }
      float gv[16];
#pragma unroll
      for (int s = 0; s < 4; ++s)
#pragma unroll
        for (int r = 0; r < 4; ++r) gv[s * 4 + r] = shl(g4[r], s * 16 + l15);
      float g0 = -3e38f, g1 = -3e38f, g2 = -3e38f; int i0 = -1, i1 = -1, i2 = -1;
#pragma unroll
      for (int n = 0; n < 15; ++n) {
        const float gs = (n < own) ? gv[n] : -3e38f;
        if (n < own) {
          if (gs > g0) { g2 = g1; i2 = i1; g1 = g0; i1 = i0; g0 = gs; i0 = n; }
          else if (gs > g1) { g2 = g1; i2 = i1; g1 = gs; i1 = n; }
          else if (gs > g2) { g2 = gs; i2 = n; }
        }
      }
      if (i0 >= 0) sel |= 1u << i0;
      if (i1 >= 0) sel |= 1u << i1;
      if (i2 >= 0) sel |= 1u << i2;
    }
    f32x4 OT[4];
#pragma unroll
    for (int dt = 0; dt < 4; ++dt) OT[dt] = (f32x4){0.f, 0.f, 0.f, 0.f};
    float m_run = -1e30f, l_run = 0.f;
    const int NI = NT >> 1;
    u32x4 kA[2], vA[2], kB[2], vB[2], kC[2], vC[2];
#define MB_LD(kk, vv, pair) do { const int pr_ = (pair) < NI ? (pair) : NI - 1; _Pragma("unroll") for (int q2 = 0; q2 < 2; ++q2) { \
      const size_t g_ = (tokb + (size_t)pr_ * 128 + q2 * 64 + skey) * 256 + h * 64 + sd; kk[q2] = *(const u32x4*)(mk + g_); vv[q2] = *(const u32x4*)(mv + g_); } } while (0)
#define MB_ST(kk, vv, bufi) do { _Pragma("unroll") for (int q2 = 0; q2 < 2; ++q2) { \
      *(u32x4*)(Ks + ((bufi) * 128 + q2 * 64 + skey) * MB_STRIDE + sd) = kk[q2]; *(u32x4*)(Vs + ((bufi) * 128 + q2 * 64 + skey) * MB_STRIDE + sd) = vv[q2]; } } while (0)
    MB_LD(kA, vA, 0);
    MB_LD(kB, vB, 1);
    MB_LD(kC, vC, 2);
    MB_ST(kA, vA, 0);
    asm volatile("s_waitcnt lgkmcnt(0)" ::: "memory"); __builtin_amdgcn_s_barrier(); asm volatile("" ::: "memory");
    const float SC = 0.18033688011112042f;
#define MB_ITER(itx, LK, LV, SK, SV) do { const int it = (itx); if (it < NI) { \
      const int cur = it & 1; \
      MB_LD(LK, LV, it + 3); \
      const int kb = it * 128, blk = it >> 1; \
      const bool mine = (sel >> blk) & 1u; \
      if (__ballot(mine) != 0ull) { \
        const bf16_t* Kc = Ks + cur * 128 * MB_STRIDE + l15 * MB_STRIDE + 8 * lg; \
        const bf16_t* Vc = Vs + cur * 128 * MB_STRIDE + (4 * lg + (l15 >> 2)) * MB_STRIDE + 4 * (l15 & 3); \
        f32x4 sT[8]; \
      _Pragma("unroll") \
        for (int kt = 0; kt < 8; ++kt) { \
          sT[kt] = (f32x4){0.f, 0.f, 0.f, 0.f}; \
      _Pragma("unroll") \
          for (int ks = 0; ks < 2; ++ks) { \
            const bf16x8 ka = *(const bf16x8*)(Kc + (16 * kt) * MB_STRIDE + 32 * ks); \
            sT[kt] = __builtin_amdgcn_mfma_f32_16x16x32_bf16(ka, qf[ks], sT[kt], 0, 0, 0); \
          } \
        } \
        if (__builtin_expect(__builtin_amdgcn_readfirstlane((int)(kb + 127 > qt * 128 + w * 16)) != 0, 0)) { asm volatile("; diag tile" ::: "memory"); \
      _Pragma("unroll") \
          for (int kt = 0; kt < 8; ++kt) \
      _Pragma("unroll") \
            for (int r = 0; r < 4; ++r) sT[kt][r] = (kb + 16 * kt + 4 * lg + r <= tl) ? sT[kt][r] : -INFINITY; \
        } \
        float lmax = fmaxf(fmaxf(sT[0][0], sT[0][1]), fmaxf(sT[0][2], sT[0][3])); \
      _Pragma("unroll") \
        for (int kt = 1; kt < 8; ++kt) lmax = fmaxf(lmax, fmaxf(fmaxf(sT[kt][0], sT[kt][1]), fmaxf(sT[kt][2], sT[kt][3]))); \
        lmax *= SC; \
        if (__ballot(mine && lmax > m_run + 16.f) != 0ull) { \
          float tmax = fmaxf(lmax, shx(lmax, 16, lane)); \
          tmax = fmaxf(tmax, shx(tmax, 32, lane)); \
          const float m_new = mine ? fmaxf(m_run, tmax) : m_run; \
          const float alpha = __builtin_amdgcn_exp2f(m_run - m_new); \
          l_run *= alpha; \
      _Pragma("unroll") \
          for (int dt = 0; dt < 4; ++dt) OT[dt] = OT[dt] * alpha; \
          m_run = m_new; \
        } \
        const float nb = mine ? -m_run : -INFINITY; \
        float psum = 0.f; \
        unsigned pp[16]; \
      _Pragma("unroll") \
        for (int kt = 0; kt < 8; ++kt) { \
          const float p0 = __builtin_amdgcn_exp2f(fmaf(sT[kt][0], SC, nb)), p1 = __builtin_amdgcn_exp2f(fmaf(sT[kt][1], SC, nb)); \
          const float p2 = __builtin_amdgcn_exp2f(fmaf(sT[kt][2], SC, nb)), p3 = __builtin_amdgcn_exp2f(fmaf(sT[kt][3], SC, nb)); \
          psum += (p0 + p1) + (p2 + p3); \
          pp[kt * 2] = cvt_pk_bf16(p0, p1); pp[kt * 2 + 1] = cvt_pk_bf16(p2, p3); \
        } \
        l_run += psum; \
      _Pragma("unroll") \
        for (int ks2 = 0; ks2 < 4; ++ks2) { \
          u32x4 pb; pb.x = pp[ks2 * 4]; pb.y = pp[ks2 * 4 + 1]; pb.z = pp[ks2 * 4 + 2]; pb.w = pp[ks2 * 4 + 3]; \
          const bf16x8 pf = __builtin_bit_cast(bf16x8, pb); \
      _Pragma("unroll") \
          for (int dt = 0; dt < 4; ++dt) { \
            const bf16_t* a0 = Vc + (32 * ks2) * MB_STRIDE + 16 * dt; \
            const s16x4 t0 = __builtin_amdgcn_ds_read_tr16_b64_v4i16((LAS s16x4*)a0); \
            const s16x4 t1 = __builtin_amdgcn_ds_read_tr16_b64_v4i16((LAS s16x4*)(a0 + 16 * MB_STRIDE)); \
            bf16x8 va; va[0] = t0[0]; va[1] = t0[1]; va[2] = t0[2]; va[3] = t0[3]; va[4] = t1[0]; va[5] = t1[1]; va[6] = t1[2]; va[7] = t1[3]; \
            OT[dt] = __builtin_amdgcn_mfma_f32_16x16x32_bf16(va, pf, OT[dt], 0, 0, 0); \
          } \
        } \
      } \
      MB_ST(SK, SV, cur ^ 1); \
      asm volatile("s_waitcnt lgkmcnt(0)" ::: "memory"); __builtin_amdgcn_s_barrier(); asm volatile("" ::: "memory"); \
    } } while (0)
#pragma unroll 1
    for (int it3 = 0; it3 < NI; it3 += 3) {
      MB_ITER(it3, kA, vA, kB, vB);
      MB_ITER(it3 + 1, kB, vB, kC, vC);
      MB_ITER(it3 + 2, kC, vC, kA, vA);
    }
    l_run += shx(l_run, 16, lane);
    l_run += shx(l_run, 32, lane);
    {
      const float inv = 1.f / l_run;
      bf16_t* op = mo + (tokb + tl) * 256 + h * 64 + 4 * lg;
#pragma unroll
      for (int dt = 0; dt < 4; ++dt) {
        u32x2 wv; wv.x = cvt_pk_bf16(OT[dt][0] * inv, OT[dt][1] * inv); wv.y = cvt_pk_bf16(OT[dt][2] * inv, OT[dt][3] * inv);
        *(u32x2*)(op + 16 * dt) = wv;
      }
    }
  }
}

#define MB_PART 0
#define MB_ML (64 * MiB)
#define MB_LIST (68 * MiB)
#define MB_CNT (72 * MiB)
__device__ __forceinline__ void moba_select(const int WID, KP p, int l, unsigned char* lds) {
  const int tid = lt(), lane = tid & 63, l15 = lane & 15, lg = lane >> 4, w = WID;
  int* cnt = (int*)lds;
  const bf16_t* mq = (const bf16_t*)(p->ws + WS_B + B_MQ);
  const float* kmean = (const float*)(p->ws + WS_MISC + MISC_KMEAN);
  unsigned short* list = (unsigned short*)(p->ws + WS_B + MB_LIST);
  unsigned* CNT = (unsigned*)(p->ws + WS_B + MB_CNT);
  unsigned* done = (unsigned*)(p->ws + WS_MISC + MISC_CTR) + 16 + l;
  for (int bh = (int)gridDim.x - 1 - (int)blockIdx.x; bh < 32; bh += gridDim.x) {
    const int b = bh >> 2, h = bh & 3;
    if (tid < 16) cnt[tid] = 0;
    __syncthreads();
    bf16x8 kmf[2];
#pragma unroll
    for (int ks = 0; ks < 2; ++ks) {
      const float* kmp = kmean + ((size_t)bh * 16 + l15) * 64 + 32 * ks + 8 * lg;
      const f32x4 a0 = *(const f32x4*)kmp, a1 = *(const f32x4*)(kmp + 4);
      u32x4 pk; pk.x = pk2bf(a0[0], a0[1]); pk.y = pk2bf(a0[2], a0[3]); pk.z = pk2bf(a1[0], a1[1]); pk.w = pk2bf(a1[2], a1[3]);
      kmf[ks] = __builtin_bit_cast(bf16x8, pk);
    }
    bf16x8 nq0, nq1;
    {
      const bf16_t* qp = mq + ((size_t)b * 4096 + (16 + w) * 16 + l15) * 256 + h * 64 + 8 * lg;
      nq0 = *(const bf16x8*)qp; nq1 = *(const bf16x8*)(qp + 32);
    }
    for (int qg = 16 + w; qg < 256; qg += 8) {
      const int own = qg >> 4, t = qg * 16 + l15;
      const bf16x8 q0 = nq0, q1 = nq1;
      {
        const int qn = qg + 8 < 256 ? qg + 8 : qg;
        const bf16_t* qp = mq + ((size_t)b * 4096 + qn * 16 + l15) * 256 + h * 64 + 8 * lg;
        nq0 = *(const bf16x8*)qp; nq1 = *(const bf16x8*)(qp + 32);
      }
      f32x4 g4 = (f32x4){0.f, 0.f, 0.f, 0.f};
      g4 = __builtin_amdgcn_mfma_f32_16x16x32_bf16(kmf[0], q0, g4, 0, 0, 0);
      g4 = __builtin_amdgcn_mfma_f32_16x16x32_bf16(kmf[1], q1, g4, 0, 0, 0);
      float gv[16];
#pragma unroll
      for (int s = 0; s < 4; ++s)
#pragma unroll
        for (int r = 0; r < 4; ++r) gv[s * 4 + r] = shl(g4[r], s * 16 + l15);
      float g0 = -3e38f, g1 = -3e38f, g2 = -3e38f; int i0 = -1, i1 = -1, i2 = -1;
#pragma unroll
      for (int n = 0; n < 15; ++n) {
        if (n < own) {
          const float gs = gv[n];
          if (gs > g0) { g2 = g1; i2 = i1; g1 = g0; i1 = i0; g0 = gs; i0 = n; }
          else if (gs > g1) { g2 = g1; i2 = i1; g1 = gs; i1 = n; }
          else if (gs > g2) { g2 = gs; i2 = n; }
        }
      }
      if (lg == 0) {
        if (i0 >= 0) { const int pos = atomicAdd(&cnt[i0], 1); list[((size_t)bh * 16 + i0) * 4096 + pos] = (unsigned short)(t | (0 << 12)); }
        if (i1 >= 0) { const int pos = atomicAdd(&cnt[i1], 1); list[((size_t)bh * 16 + i1) * 4096 + pos] = (unsigned short)(t | (1 << 12)); }
        if (i2 >= 0) { const int pos = atomicAdd(&cnt[i2], 1); list[((size_t)bh * 16 + i2) * 4096 + pos] = (unsigned short)(t | (2 << 12)); }
      }
    }
    __syncthreads();
    if (tid < 16) CNT[bh * 16 + tid] = (unsigned)cnt[tid];
    __syncthreads();
    if (tid == 0) { __threadfence(); atomicAdd(done, 1u); }
  }
}
__device__ __forceinline__ void moba_combine(const int WID, KP p) {
  const int tid = lt(), wave = tid >> 6, lane = tid & 63;
  const bf16_t* part = (const bf16_t*)(p->ws + WS_B + MB_PART);
  const float* mlp = (const float*)(p->ws + WS_B + MB_ML);
  bf16_t* mo = (bf16_t*)(p->ws + WS_D + D_MO);
  const int stride = gridDim.x * 8;
  for (int item0 = blockIdx.x * 8 + wave; item0 < 32 * 4096; item0 += 4 * stride) {
    f32x4 ma[4], mb[4];
    bf16_t pv[4][4];
#pragma unroll
    for (int k = 0; k < 4; ++k) {
      const int item = item0 + k * stride;
      const size_t it = (size_t)(item < 32 * 4096 ? item : item0);
      ma[k] = *(const f32x4*)(mlp + it * 8); mb[k] = *(const f32x4*)(mlp + it * 8 + 4);
#pragma unroll
      for (int r = 0; r < 4; ++r) pv[k][r] = part[(it * 4 + r) * 64 + lane];
    }
#pragma unroll
    for (int k = 0; k < 4; ++k) {
      const int item = item0 + k * stride;
      if (item < 32 * 4096) {
        const int bh = item >> 12, t = item & 4095, own = t >> 8, nv = own < 3 ? own : 3;
        const float m[4] = {ma[k][0], ma[k][2], mb[k][0], mb[k][2]}, ls[4] = {ma[k][1], ma[k][3], mb[k][1], mb[k][3]};
        float M = m[3];
#pragma unroll
        for (int r = 0; r < 3; ++r) M = (r < nv) ? fmaxf(M, m[r]) : M;
        float L = 0.f, O = 0.f;
#pragma unroll
        for (int r = 0; r < 4; ++r) {
          const bool ok = (r < nv) || (r == 3);
          const float wg = ok ? __builtin_amdgcn_exp2f(m[r] - M) : 0.f;
          L += ok ? wg * ls[r] : 0.f;
          O += ok ? wg * bf2f(pv[k][r]) : 0.f;
        }
        mo[((size_t)(bh >> 2) * 4096 + t) * 256 + (bh & 3) * 64 + lane] = f2bf(O / L);
      }
    }
  }
}
__device__ __forceinline__ void moba_attn2(const int WID, KP p, int l, int ctr_idx, unsigned char* lds) {
  const int tid = lt(), lane = tid & 63, l15 = lane & 15, lg = lane >> 4, w = WID;
  bf16_t* Ks = (bf16_t*)lds;
  bf16_t* Vs = Ks + 2 * 128 * MB_STRIDE;
  int* nxt = (int*)(lds + 4 * 128 * MB_STRIDE * 2);
  const bf16_t* mq = (const bf16_t*)(p->ws + WS_B + B_MQ);
  const bf16_t* mk = (const bf16_t*)(p->ws + WS_B + B_MK);
  const bf16_t* mv = (const bf16_t*)(p->ws + WS_B + B_MV);
  const float* kmean = (const float*)(p->ws + WS_MISC + MISC_KMEAN);
  bf16_t* mo = (bf16_t*)(p->ws + WS_D + D_MO);
  unsigned* ctr = (unsigned*)(p->ws + WS_MISC + MISC_CTR) + ctr_idx;
  const int skey = tid >> 3, sd = (tid & 7) * 8;
  int* found = nxt + 1;
  int* pre = nxt + 2;
  int* cl = pre + 516;
  int* bhs = cl + 512;
  const unsigned short* list = (const unsigned short*)(p->ws + WS_B + MB_LIST);
  const unsigned* CNT = (const unsigned*)(p->ws + WS_B + MB_CNT);
  bf16_t* part = (bf16_t*)(p->ws + WS_B + MB_PART);
  float* mlp = (float*)(p->ws + WS_B + MB_ML);
  if (tid == 0) {
    unsigned* done = (unsigned*)(p->ws + WS_MISC + MISC_CTR) + 16 + l;
    while (__hip_atomic_load(done, __ATOMIC_RELAXED, __HIP_MEMORY_SCOPE_AGENT) < 32u) __builtin_amdgcn_s_sleep(4);
    __threadfence();
  }
  __syncthreads();
  cl[tid] = (int)CNT[tid];
  __syncthreads();
  if (tid < 32) { int s_ = 0; for (int k = 0; k < 16; ++k) s_ += (cl[tid * 16 + k] + 511) >> 9; bhs[tid + 1] = s_; }
  __syncthreads();
  if (tid == 0) { bhs[0] = 0; for (int k = 1; k <= 32; ++k) bhs[k] += bhs[k - 1]; }
  __syncthreads();
  { int s_ = bhs[tid >> 4]; for (int k = 0; k < (tid & 15); ++k) s_ += (cl[(tid & ~15) + k] + 511) >> 9; pre[tid] = s_; if (tid == 511) pre[512] = s_ + ((cl[511] + 511) >> 9); }
  __syncthreads();
  const int totalA = pre[512];
  for (;;) {
    __syncthreads();
    if (tid == 0) *nxt = (int)atomicAdd(ctr, 1u);
    __syncthreads();
    const int task = *nxt;
    if (task >= totalA + 1024) break;
    const bool kindA = task < totalA;
    int bh, kbase0, NT, qt, idx = 0, c0 = 0, c1 = 1;
    if (kindA) {
      if (pre[tid] <= task && task < pre[tid + 1]) *found = tid;
      __syncthreads();
      idx = *found;
      bh = idx >> 4;
      c0 = (task - pre[idx]) * 4;
      const int nch = (cl[idx] + 127) >> 7;
      c1 = c0 + 4 < nch ? c0 + 4 : nch;
      kbase0 = (idx & 15) * 256; NT = 4; qt = 1 << 20;
    } else {
      const int tk = task - totalA;
      qt = 31 - (tk >> 5); bh = tk & 31;
      kbase0 = (qt >> 1) * 256; NT = 2 + 2 * (qt & 1);
    }
    const int b = bh >> 2, h = bh & 3;
    const size_t tokb = (size_t)b * 4096 + kbase0;
    const int NI = NT >> 1;
    {
      u32x4 k0[2], v0[2], k1[2], v1[2];
#pragma unroll
      for (int q2 = 0; q2 < 2; ++q2) {
        const size_t g0_ = (tokb + q2 * 64 + skey) * 256 + h * 64 + sd;
        k0[q2] = *(const u32x4*)(mk + g0_); v0[q2] = *(const u32x4*)(mv + g0_);
        const size_t g1_ = (tokb + (NI > 1 ? 128 : 0) + q2 * 64 + skey) * 256 + h * 64 + sd;
        k1[q2] = *(const u32x4*)(mk + g1_); v1[q2] = *(const u32x4*)(mv + g1_);
      }
#pragma unroll
      for (int q2 = 0; q2 < 2; ++q2) {
        *(u32x4*)(Ks + (q2 * 64 + skey) * MB_STRIDE + sd) = k0[q2]; *(u32x4*)(Vs + (q2 * 64 + skey) * MB_STRIDE + sd) = v0[q2];
        *(u32x4*)(Ks + (128 + q2 * 64 + skey) * MB_STRIDE + sd) = k1[q2]; *(u32x4*)(Vs + (128 + q2 * 64 + skey) * MB_STRIDE + sd) = v1[q2];
      }
    }
    asm volatile("s_waitcnt lgkmcnt(0)" ::: "memory"); __builtin_amdgcn_s_barrier(); asm volatile("" ::: "memory");
    for (int ch = c0; ch < c1; ++ch) {
    int tl, slot; bool mine;
    if (kindA) {
      const int eidx = ch * 128 + w * 16 + l15;
      mine = eidx < cl[idx];
      const unsigned ent = mine ? (unsigned)list[(size_t)idx * 4096 + eidx] : 0u;
      tl = mine ? (int)(ent & 0xfffu) : ((idx & 15) + 1) * 256;
      slot = (int)(ent >> 12);
    } else { tl = qt * 128 + w * 16 + l15; mine = true; slot = 3; }
    bf16x8 qf[2];
    {
      const bf16_t* qp = mq + ((size_t)b * 4096 + tl) * 256 + h * 64 + 8 * lg;
      qf[0] = *(const bf16x8*)qp; qf[1] = *(const bf16x8*)(qp + 32);
    }
    const int tlr = tl - kbase0;
    f32x4 OT[4];
#pragma unroll
    for (int dt = 0; dt < 4; ++dt) OT[dt] = (f32x4){0.f, 0.f, 0.f, 0.f};
    float m_run = -1e30f, l_run = 0.f;
#undef MB_ITER
    const float SC = 0.18033688011112042f;
#define MB_ITER(itx, LK, LV, SK, SV) do { const int it = (itx); if (it < NI) { \
      const int cur = it & 1; \
      const int kb = it * 128; \
      if (__ballot(mine) != 0ull) { \
        const bf16_t* Kc = Ks + cur * 128 * MB_STRIDE + l15 * MB_STRIDE + 8 * lg; \
        const bf16_t* Vc = Vs + cur * 128 * MB_STRIDE + (4 * lg + (l15 >> 2)) * MB_STRIDE + 4 * (l15 & 3); \
        f32x4 sT[8]; \
      _Pragma("unroll") \
        for (int kt = 0; kt < 8; ++kt) { \
          sT[kt] = (f32x4){0.f, 0.f, 0.f, 0.f}; \
      _Pragma("unroll") \
          for (int ks = 0; ks < 2; ++ks) { \
            const bf16x8 ka = *(const bf16x8*)(Kc + (16 * kt) * MB_STRIDE + 32 * ks); \
            sT[kt] = __builtin_amdgcn_mfma_f32_16x16x32_bf16(ka, qf[ks], sT[kt], 0, 0, 0); \
          } \
        } \
        if (__builtin_expect(__builtin_amdgcn_readfirstlane((int)(!kindA && kbase0 + kb + 127 > qt * 128 + w * 16)) != 0, 0)) { asm volatile("; diag tile" ::: "memory"); \
      _Pragma("unroll") \
          for (int kt = 0; kt < 8; ++kt) \
      _Pragma("unroll") \
            for (int r = 0; r < 4; ++r) sT[kt][r] = (kb + 16 * kt + 4 * lg + r <= tlr) ? sT[kt][r] : -INFINITY; \
        } \
        float lmax = fmaxf(fmaxf(sT[0][0], sT[0][1]), fmaxf(sT[0][2], sT[0][3])); \
      _Pragma("unroll") \
        for (int kt = 1; kt < 8; ++kt) lmax = fmaxf(lmax, fmaxf(fmaxf(sT[kt][0], sT[kt][1]), fmaxf(sT[kt][2], sT[kt][3]))); \
        lmax *= SC; \
        if (__ballot(mine && lmax > m_run + 16.f) != 0ull) { \
          float tmax = fmaxf(lmax, shx(lmax, 16, lane)); \
          tmax = fmaxf(tmax, shx(tmax, 32, lane)); \
          const float m_new = mine ? fmaxf(m_run, tmax) : m_run; \
          const float alpha = __builtin_amdgcn_exp2f(m_run - m_new); \
          l_run *= alpha; \
      _Pragma("unroll") \
          for (int dt = 0; dt < 4; ++dt) OT[dt] = OT[dt] * alpha; \
          m_run = m_new; \
        } \
        const float nb = mine ? -m_run : -INFINITY; \
        float psum = 0.f; \
        unsigned pp[16]; \
      _Pragma("unroll") \
        for (int kt = 0; kt < 8; ++kt) { \
          const float p0 = __builtin_amdgcn_exp2f(fmaf(sT[kt][0], SC, nb)), p1 = __builtin_amdgcn_exp2f(fmaf(sT[kt][1], SC, nb)); \
          const float p2 = __builtin_amdgcn_exp2f(fmaf(sT[kt][2], SC, nb)), p3 = __builtin_amdgcn_exp2f(fmaf(sT[kt][3], SC, nb)); \
          psum += (p0 + p1) + (p2 + p3); \
          pp[kt * 2] = cvt_pk_bf16(p0, p1); pp[kt * 2 + 1] = cvt_pk_bf16(p2, p3); \
        } \
        l_run += psum; \
      _Pragma("unroll") \
        for (int ks2 = 0; ks2 < 4; ++ks2) { \
          u32x4 pb; pb.x = pp[ks2 * 4]; pb.y = pp[ks2 * 4 + 1]; pb.z = pp[ks2 * 4 + 2]; pb.w = pp[ks2 * 4 + 3]; \
          const bf16x8 pf = __builtin_bit_cast(bf16x8, pb); \
      _Pragma("unroll") \
          for (int dt = 0; dt < 4; ++dt) { \
            const bf16_t* a0 = Vc + (32 * ks2) * MB_STRIDE + 16 * dt; \
            const s16x4 t0 = __builtin_amdgcn_ds_read_tr16_b64_v4i16((LAS s16x4*)a0); \
            const s16x4 t1 = __builtin_amdgcn_ds_read_tr16_b64_v4i16((LAS s16x4*)(a0 + 16 * MB_STRIDE)); \
            bf16x8 va; va[0] = t0[0]; va[1] = t0[1]; va[2] = t0[2]; va[3] = t0[3]; va[4] = t1[0]; va[5] = t1[1]; va[6] = t1[2]; va[7] = t1[3]; \
            OT[dt] = __builtin_amdgcn_mfma_f32_16x16x32_bf16(va, pf, OT[dt], 0, 0, 0); \
          } \
        } \
      } \
    } } while (0)
    MB_ITER(0, kA, vA, kB, vB);
    MB_ITER(1, kA, vA, kB, vB);
    l_run += shx(l_run, 16, lane);
    l_run += shx(l_run, 32, lane);
    if (mine) {
      const size_t pi = ((size_t)bh * 4096 + tl) * 4 + slot;
      bf16_t* op = part + pi * 64 + 4 * lg;
#pragma unroll
      for (int dt = 0; dt < 4; ++dt) {
        u32x2 wv; wv.x = cvt_pk_bf16(OT[dt][0], OT[dt][1]); wv.y = cvt_pk_bf16(OT[dt][2], OT[dt][3]);
        *(u32x2*)(op + 16 * dt) = wv;
      }
      if (lg == 0) *(f32x2*)(mlp + pi * 2) = (f32x2){m_run, l_run};
    }
    }
  }
}

#define A_S5K 0
#define A_S5E (1 * MiB)
#define A_S5C (5 * MiB)
#define A_S5A64 (9 * MiB)
__device__ __forceinline__ void s5_tables(const int WID, KP p, int l, unsigned char* lds) {
  const int tid = lt();
  float* apr = (float*)lds;
  float* api = apr + 64 * 66;
  float* bbr = api + 64 * 66;
  float* bbi = bbr + 1024;
  float* crs = bbi + 1024;
  float* cis = crs + 1024;
  float* zz = cis + 1024;
  bf16_t* Kt = (bf16_t*)(p->ws + WS_A + A_S5K);
  bf16_t* Et = (bf16_t*)(p->ws + WS_A + A_S5E);
  bf16_t* Ct = (bf16_t*)(p->ws + WS_A + A_S5C);
  float* A64 = (float*)(p->ws + WS_A + A_S5A64);
  for (int task = (int)gridDim.x - 1 - (int)blockIdx.x; task < 256; task += gridDim.x) {
    const int g = task >> 4, part = task & 15;
    if (tid < 64) {
      const int pp = tid;
      const float dt = expf(p->in[I_S5LDT][l * 16 + g]);
      const float lr = p->in[I_S5ARE][l * 1024 + g * 64 + pp], li = p->in[I_S5AIM][l * 1024 + g * 64 + pp];
      const float er = expf(lr * dt);
      const float ar = er * cosf(li * dt), ai = er * sinf(li * dt);
      const float nr = ar - 1.f, ni = ai, den = lr * lr + li * li;
      const float fr = (nr * lr + ni * li) / den, fi = (ni * lr - nr * li) / den;
      zz[pp] = lr * dt; zz[64 + pp] = li * dt;
#pragma unroll
      for (int h = 0; h < 16; ++h) {
        const float br = p->in[I_S5BRE][(size_t)l * 16384 + (g * 64 + pp) * 16 + h], bi = p->in[I_S5BIM][(size_t)l * 16384 + (g * 64 + pp) * 16 + h];
        bbr[pp * 16 + h] = fr * br - fi * bi; bbi[pp * 16 + h] = fr * bi + fi * br;
      }
    }
    for (int i = tid; i < 1024; i += NTHR) { crs[i] = p->in[I_S5CRE][(size_t)l * 16384 + g * 1024 + i]; cis[i] = p->in[I_S5CIM][(size_t)l * 16384 + g * 1024 + i]; }
    __syncthreads();
    for (int idx = tid; idx < 64 * 65; idx += NTHR) {
      const int pp = idx / 65, tau = idx - pp * 65;
      const float er = expf(zz[pp] * (float)tau);
      float sn, cs; sincosf(zz[64 + pp] * (float)tau, &sn, &cs);
      apr[pp * 66 + tau] = er * cs; api[pp * 66 + tau] = er * sn;
    }
    __syncthreads();
    for (int e = tid; e < 1024; e += NTHR) {
      const int tau = part * 4 + (e >> 8), h = (e >> 4) & 15, hp = e & 15;
      float s = 0.f;
      for (int pp = 0; pp < 64; ++pp) {
        const float ar = apr[pp * 66 + tau], ai = api[pp * 66 + tau], cr = crs[h * 64 + pp], ci = cis[h * 64 + pp];
        const float mr = cr * ar - ci * ai, mi = cr * ai + ci * ar;
        s += mr * bbr[pp * 16 + hp] - mi * bbi[pp * 16 + hp];
      }
      Kt[((size_t)g * 65 + tau + 1) * 256 + h * 16 + hp] = f2bf(s);
    }
    if (part == 0 && tid < 256) Kt[(size_t)g * 65 * 256 + tid] = 0;
    for (int e = tid; e < 8192; e += NTHR) {
      const int pq = part * 8 + (e >> 10), k = e & 1023, j = k >> 4, hp = k & 15;
      const int pp = pq & 63;
      const float ar = apr[pp * 66 + 63 - j], ai = api[pp * 66 + 63 - j], br = bbr[pp * 16 + hp], bi = bbi[pp * 16 + hp];
      const float v = (pq < 64) ? (ar * br - ai * bi) : (ar * bi + ai * br);
      Et[((size_t)g * 128 + pq) * 1024 + k] = f2bf(v);
    }
    for (int e = tid; e < 8192; e += NTHR) {
      const int row = part * 64 + (e >> 7), pq = e & 127, t = row >> 4, h = row & 15, pp = pq & 63;
      const float ar = apr[pp * 66 + t + 1], ai = api[pp * 66 + t + 1], cr = crs[h * 64 + pp], ci = cis[h * 64 + pp];
      const float v = (pq < 64) ? (cr * ar - ci * ai) : -(cr * ai + ci * ar);
      Ct[((size_t)g * 1024 + row) * 128 + pq] = f2bf(v);
    }
    if (part == 0 && tid < 64) { A64[(g * 64 + tid) * 2] = apr[tid * 66 + 64]; A64[(g * 64 + tid) * 2 + 1] = api[tid * 66 + 64]; }
    __syncthreads();
  }
}

__device__ __forceinline__ void s5_mfma(const int WID, KP p, int l, unsigned char* lds) {
  const int tid = lt(), lane = tid & 63, l15 = lane & 15, lg = lane >> 4, w = WID, m = w & 3, tpar = w >> 2;
  bf16_t* Ktab = (bf16_t*)lds;
  float* Eloc = (float*)(lds + 65536);
  bf16_t* Sprev = (bf16_t*)(lds + 65536 + 33792);
  const bf16_t* s5u = (const bf16_t*)(p->ws + WS_B + B_S5U);
  bf16_t* zg = (bf16_t*)(p->ws + WS_D + D_ZG);
  const bf16_t* Kt = (const bf16_t*)(p->ws + WS_A + A_S5K);
  const bf16_t* Et = (const bf16_t*)(p->ws + WS_A + A_S5E);
  const bf16_t* Ct = (const bf16_t*)(p->ws + WS_A + A_S5C);
  const float* A64 = (const float*)(p->ws + WS_A + A_S5A64);
  for (int task = (int)gridDim.x - 1 - (int)blockIdx.x; task < 128; task += gridDim.x) {
    const int b = task >> 4, g = task & 15;
    const size_t tokb = (size_t)b * 4096;
    for (int i = lt(); i < 128 * 256 / 8; i += NTHR)
      ((u32x4*)Ktab)[i] = (i >= 63 * 32) ? ((const u32x4*)(Kt + (size_t)g * 65 * 256))[i - 63 * 32] : (u32x4){0u, 0u, 0u, 0u};
    bf16x8 ua[32];
#pragma unroll
    for (int jp = 0; jp < 32; ++jp)
      ua[jp] = *(const bf16x8*)(s5u + (tokb + (size_t)(16 * m + l15) * 64 + 2 * jp + (lg >> 1)) * 256 + g * 16 + 8 * (lg & 1));
#pragma unroll 1
    for (int q = 0; q < 4; ++q) {
      const int nt = tpar * 4 + q;
      f32x4 acc = (f32x4){0.f, 0.f, 0.f, 0.f};
      const bf16_t* ep = Et + ((size_t)g * 128 + 16 * nt + l15) * 1024 + 8 * lg;
#pragma unroll
      for (int jp = 0; jp < 32; ++jp) acc = __builtin_amdgcn_mfma_f32_16x16x32_bf16(ua[jp], *(const bf16x8*)(ep + 32 * jp), acc, 0, 0, 0);
#pragma unroll
      for (int r = 0; r < 4; ++r) Eloc[(16 * m + 4 * lg + r) * 132 + 16 * nt + l15] = acc[r];
    }
    __syncthreads();
    if (tid < 64) {
      const float ar = A64[(g * 64 + tid) * 2], ai = A64[(g * 64 + tid) * 2 + 1];
      float sr = 0.f, si = 0.f;
      for (int c = 0; c < 64; ++c) {
        Sprev[c * 136 + tid] = f2bf(sr); Sprev[c * 136 + 64 + tid] = f2bf(si);
        const float er = Eloc[c * 132 + tid], ei = Eloc[c * 132 + 64 + tid];
        const float nsr = ar * sr - ai * si + er, nsi = ar * si + ai * sr + ei;
        sr = nsr; si = nsi;
      }
    }
    __syncthreads();
    bf16x8 sA[4];
#pragma unroll
    for (int kk = 0; kk < 4; ++kk) sA[kk] = *(const bf16x8*)(Sprev + (16 * m + l15) * 136 + 32 * kk + 8 * lg);
    const float dval = p->in[I_S5D][l * 256 + g * 16 + l15];
    bf16x8 cf0[4], cf1[4], cf2[4];
    unsigned short uu0[4], uu1[4], uu2[4];
#define S5_LOAD(cf, uu, ii) do { const int t_ = 2 * ((ii) < 32 ? (ii) : 31) + tpar; \
      const bf16_t* cp_ = Ct + ((size_t)g * 1024 + t_ * 16 + l15) * 128 + 8 * lg; \
      _Pragma("unroll") for (int kk = 0; kk < 4; ++kk) cf[kk] = *(const bf16x8*)(cp_ + 32 * kk); } while (0)
#define S5_STEP(cf, uu, ii) do { if ((ii) < 32) { const int t = 2 * (ii) + tpar; \
      _Pragma("unroll") for (int r = 0; r < 4; ++r) uu[r] = s5u[(tokb + (size_t)(16 * m + 4 * lg + r) * 64 + t) * 256 + g * 16 + l15]; \
      f32x4 acc = (f32x4){0.f, 0.f, 0.f, 0.f}; \
      _Pragma("unroll") for (int kk = 0; kk < 4; ++kk) acc = __builtin_amdgcn_mfma_f32_16x16x32_bf16(sA[kk], cf[kk], acc, 0, 0, 0); \
      const bf16_t* kb = Ktab + (t - (lg >> 1) + 64) * 256 + l15 * 16 + 8 * (lg & 1); \
      _Pragma("unroll") for (int jp = 0; jp < 32; ++jp) acc = __builtin_amdgcn_mfma_f32_16x16x32_bf16(ua[jp], *(const bf16x8*)(kb - jp * 512), acc, 0, 0, 0); \
      _Pragma("unroll") for (int r = 0; r < 4; ++r) { const size_t tok = tokb + (size_t)(16 * m + 4 * lg + r) * 64 + t; \
        zg[tok * 256 + g * 16 + l15] = f2bf(gelu_f(acc[r] + dval * bf2f(uu[r]))); } } } while (0)
    S5_LOAD(cf0, uu0, 0); S5_LOAD(cf1, uu1, 1);
#pragma unroll 1
    for (int i = 0; i < 33; i += 3) {
      S5_LOAD(cf2, uu2, i + 2); S5_STEP(cf0, uu0, i);
      S5_LOAD(cf0, uu0, i + 3); S5_STEP(cf1, uu1, i + 1);
      S5_LOAD(cf1, uu1, i + 4); S5_STEP(cf2, uu2, i + 2);
    }
    __syncthreads();
  }
}

#define D_TU8 0
#define D_TV8 (16 * MiB)
__device__ __forceinline__ void conv_flat8(const int WID, const float* src, unsigned char* dst, size_t n, float scale) {
  const size_t stride = (size_t)gridDim.x * NTHR * 16;
  for (size_t i = ((size_t)blockIdx.x * NTHR + lt()) * 16; i < n; i += stride) {
    u32x4 w;
#pragma unroll
    for (int q = 0; q < 4; ++q) {
      const f32x4 a = *(const f32x4*)(src + i + 4 * q) * scale;
      int x = __builtin_amdgcn_cvt_pk_fp8_f32(a[0], a[1], 0, false);
      x = __builtin_amdgcn_cvt_pk_fp8_f32(a[2], a[3], x, true);
      w[q] = (unsigned)x;
    }
    *(u32x4*)(dst + ((i >> 7) & 7) * (size_t)(16384 * 128) + (i >> 10) * 128 + (i & 127)) = w;
  }
}
#define CE_D(a, b) { const float hi_ = fmaxf(a, b), lo_ = fminf(a, b); a = hi_; b = lo_; }
__device__ __forceinline__ void sort16_desc(float (&x)[16]) {
#pragma unroll
  for (int k = 2; k <= 16; k <<= 1) {
#pragma unroll
    for (int j = k >> 1; j > 0; j >>= 1) {
#pragma unroll
      for (int i = 0; i < 16; ++i) {
        const int l = i ^ j;
        if (l > i) {
          const float a = x[i], b = x[l];
          if ((i & k) == 0) { x[i] = fmaxf(a, b); x[l] = fminf(a, b); } else { x[i] = fminf(a, b); x[l] = fmaxf(a, b); }
        }
      }
    }
  }
}
__device__ __forceinline__ void merge16_desc(float (&a)[16], const float (&b)[16]) {
#pragma unroll
  for (int i = 0; i < 16; ++i) a[i] = fmaxf(a[i], b[15 - i]);
#pragma unroll
  for (int j = 8; j > 0; j >>= 1) {
#pragma unroll
    for (int i = 0; i < 16; ++i) { const int l = i ^ j; if (l > i) CE_D(a[i], a[l]); }
  }
}
__device__ __forceinline__ float h16f(unsigned h) { return (float)__builtin_bit_cast(_Float16, (unsigned short)h); }

__device__ __forceinline__ void peer_fast(const int WID, KP p, int l, unsigned char* lds, const bool dry) {
  const int tid = lt(), hd = WID, lane = tid & 63;
  float* red = (float*)lds;
  unsigned short* rt_e = (unsigned short*)(lds + 32768);
  float* rt_g = (float*)(lds + 40960);
  float* sred = (float*)(lds + 57344);
  float* w8 = (float*)(lds + 58368);
  const bool last = (l == 1);
  const unsigned short* sc = (const unsigned short*)(p->ws + WS_B + B_SCORE);
  bf16_t* h = (bf16_t*)(p->ws + WS_A);
  const unsigned char* tu = p->ws + WS_D + D_TU8;
  const unsigned char* tv = p->ws + WS_D + D_TV8;
  const float* mod = (const float*)(p->ws + WS_MISC + MISC_MOD);
  float* x = p->out;
  float* ba = (float*)(p->ws + WS_B + B_BA);
  if (!last) {
    const float* w_in_n = p->in[I_WIN] + (size_t)(l + 1) * 1024 * IN_COLS;
    for (int i = tid; i < 8192; i += NTHR) w8[i] = w_in_n[(size_t)(i >> 3) * IN_COLS + 2048 + (i & 7)];
  }
  for (int tile = blockIdx.x; tile < TOK / 32; tile += gridDim.x) {
    __syncthreads();
    {
      const int tokl = tid >> 4, list = tid & 15;
      const unsigned short* sp = sc + (size_t)(tile * 32 + tokl) * 2048 + list * 128;
      float best[16];
#pragma unroll 1
      for (int grp = 0; grp < 8; ++grp) {
        const u32x4 r0 = *(const u32x4*)(sp + grp * 16), r1 = *(const u32x4*)(sp + grp * 16 + 8);
        float cur[16];
#pragma unroll
        for (int q = 0; q < 4; ++q) {
          const unsigned w0 = r0[q], w1 = r1[q];
          cur[2 * q] = __uint_as_float(__float_as_uint(h16f(w0 & 0xffffu)) | (unsigned)(grp * 16 + 2 * q));
          cur[2 * q + 1] = __uint_as_float(__float_as_uint(h16f(w0 >> 16)) | (unsigned)(grp * 16 + 2 * q + 1));
          cur[8 + 2 * q] = __uint_as_float(__float_as_uint(h16f(w1 & 0xffffu)) | (unsigned)(grp * 16 + 8 + 2 * q));
          cur[8 + 2 * q + 1] = __uint_as_float(__float_as_uint(h16f(w1 >> 16)) | (unsigned)(grp * 16 + 8 + 2 * q + 1));
        }
        sort16_desc(cur);
        if (grp == 0) {
#pragma unroll
          for (int i = 0; i < 16; ++i) best[i] = cur[i];
        } else merge16_desc(best, cur);
      }
      float v1[16], v2[16];
      const bool ishalf1 = (list & 1) != 0;
#pragma unroll
      for (int i = 0; i < 16; ++i) {
        const float o = shx(best[i], 1, lane);
        v1[i] = ishalf1 ? o : best[i];
        v2[i] = ishalf1 ? best[i] : o;
      }
      float c[4][16];
#pragma unroll
      for (int i = 0; i < 64; ++i) c[i >> 4][i & 15] = -INFINITY;
      {
        int n = 0;
#pragma unroll
        for (int a = 0; a < 16; ++a) {
#pragma unroll
          for (int bq = 0; bq < 16; ++bq) {
            if ((a + 1) * (bq + 1) <= 16) {
              const unsigned ua_ = __float_as_uint(v1[a]), ub_ = __float_as_uint(v2[bq]);
              const float s = __uint_as_float(ua_ & ~0x7fu) + __uint_as_float(ub_ & ~0x7fu);
              c[n >> 4][n & 15] = __uint_as_float((__float_as_uint(s) & ~0x3fffu) | ((ua_ & 0x7fu) << 7) | (ub_ & 0x7fu));
              ++n;
            }
          }
        }
      }
      sort16_desc(c[0]); sort16_desc(c[1]); sort16_desc(c[2]); sort16_desc(c[3]);
      merge16_desc(c[0], c[1]); merge16_desc(c[2], c[3]); merge16_desc(c[0], c[2]);
      const float s0 = __uint_as_float(__float_as_uint(c[0][0]) & ~0x3fffu);
      float e[16], esum = 0.f;
#pragma unroll
      for (int i = 0; i < 16; ++i) { e[i] = __expf(__uint_as_float(__float_as_uint(c[0][i]) & ~0x3fffu) - s0); esum += e[i]; }
      const float inv = 1.f / esum;
      if (!ishalf1) {
        const int o = tokl * 128 + (list >> 1) * 16;
#pragma unroll
        for (int i = 0; i < 16; ++i) { rt_e[o + i] = (unsigned short)(__float_as_uint(c[0][i]) & 0x3fffu); rt_g[o + i] = e[i] * inv; }
      }
    }
    __syncthreads();
    for (int tk = 0; tk < 32; ++tk) {
      const int t = tile * 32 + tk, b = t >> 12;
      float hv[16];
      {
        const u32x4 a = *(const u32x4*)(h + (size_t)t * 1024 + lane * 16), c2 = *(const u32x4*)(h + (size_t)t * 1024 + lane * 16 + 8);
        hv[0] = bflo(a.x); hv[1] = bfhi(a.x); hv[2] = bflo(a.y); hv[3] = bfhi(a.y); hv[4] = bflo(a.z); hv[5] = bfhi(a.z); hv[6] = bflo(a.w); hv[7] = bfhi(a.w);
        hv[8] = bflo(c2.x); hv[9] = bfhi(c2.x); hv[10] = bflo(c2.y); hv[11] = bfhi(c2.y); hv[12] = bflo(c2.z); hv[13] = bfhi(c2.z); hv[14] = bflo(c2.w); hv[15] = bfhi(c2.w);
      }
      u32x4 ur[16], vr[16];
      unsigned eidv = rt_e[tk * 128 + hd * 16 + (lane & 15)];
#pragma unroll
      for (int k = 0; k < 16; ++k) {
        const unsigned e = (unsigned)__builtin_amdgcn_readlane((int)eidv, k);
        ur[k] = *(const u32x4*)(tu + (size_t)e * 1024 + lane * 16);
      }
#pragma unroll
      for (int k = 0; k < 16; ++k) {
        const unsigned e = (unsigned)__builtin_amdgcn_readlane((int)eidv, k);
        vr[k] = *(const u32x4*)(tv + (size_t)e * 1024 + lane * 16);
      }
      float pt[16];
#pragma unroll
      for (int k = 0; k < 16; ++k) {
        float s = 0.f;
#pragma unroll
        for (int q = 0; q < 4; ++q) {
          const f32x2 lo = __builtin_amdgcn_cvt_pk_f32_fp8((int)ur[k][q], false), hi = __builtin_amdgcn_cvt_pk_f32_fp8((int)ur[k][q], true);
          s += hv[4 * q] * lo[0] + hv[4 * q + 1] * lo[1] + hv[4 * q + 2] * hi[0] + hv[4 * q + 3] * hi[1];
        }
        pt[k] = s;
      }
      float r8[8], r4[4], r2[2], r1;
      {
        const bool up = (lane & 32) != 0;
#pragma unroll
        for (int k = 0; k < 8; ++k) { const float snd = up ? pt[k] : pt[k + 8], keep = up ? pt[k + 8] : pt[k]; r8[k] = keep + shx(snd, 32, lane); }
      }
      {
        const bool up = (lane & 16) != 0;
#pragma unroll
        for (int k = 0; k < 4; ++k) { const float snd = up ? r8[k] : r8[k + 4], keep = up ? r8[k + 4] : r8[k]; r4[k] = keep + shx(snd, 16, lane); }
      }
      {
        const bool up = (lane & 8) != 0;
#pragma unroll
        for (int k = 0; k < 2; ++k) { const float snd = up ? r4[k] : r4[k + 2], keep = up ? r4[k + 2] : r4[k]; r2[k] = keep + shx(snd, 8, lane); }
      }
      {
        const bool up = (lane & 4) != 0;
        const float snd = up ? r2[0] : r2[1], keep = up ? r2[1] : r2[0];
        r1 = keep + shx(snd, 4, lane);
      }
      r1 += shx(r1, 2, lane);
      r1 += shx(r1, 1, lane);
      const int myk = ((lane >> 5) & 1) * 8 + ((lane >> 4) & 1) * 4 + ((lane >> 3) & 1) * 2 + ((lane >> 2) & 1);
      const float wmine = rt_g[tk * 128 + hd * 16 + myk] * gelu_f(r1 * (1.f / 64.f)) * 0.25f;
      float acc[16];
#pragma unroll
      for (int j = 0; j < 16; ++j) acc[j] = 0.f;
#pragma unroll
      for (int k = 0; k < 16; ++k) {
        const int owner = ((k >> 3) & 1) * 32 + ((k >> 2) & 1) * 16 + ((k >> 1) & 1) * 8 + (k & 1) * 4;
        const float wk = __int_as_float(__builtin_amdgcn_readlane(__float_as_int(wmine), owner));
#pragma unroll
        for (int q = 0; q < 4; ++q) {
          const f32x2 lo = __builtin_amdgcn_cvt_pk_f32_fp8((int)vr[k][q], false), hi = __builtin_amdgcn_cvt_pk_f32_fp8((int)vr[k][q], true);
          acc[4 * q] += wk * lo[0]; acc[4 * q + 1] += wk * lo[1]; acc[4 * q + 2] += wk * hi[0]; acc[4 * q + 3] += wk * hi[1];
        }
      }
#pragma unroll
      for (int q = 0; q < 4; ++q) *(f32x4*)(red + hd * 1024 + lane * 16 + 4 * q) = (f32x4){acc[4 * q], acc[4 * q + 1], acc[4 * q + 2], acc[4 * q + 3]};
      __syncthreads();
      const int c0 = tid * 2;
      float o0 = 0.f, o1 = 0.f;
#pragma unroll
      for (int j = 0; j < 8; ++j) { const f32x2 rr = *(const f32x2*)(red + j * 1024 + c0); o0 += rr[0]; o1 += rr[1]; }
      const float* g2 = mod + ((size_t)l * 8 + b) * 6144 + 5120;
      float* xr = x + (size_t)t * 1024 + c0;
      const f32x2 xin = *(const f32x2*)xr, g2v = *(const f32x2*)(g2 + c0);
      const float x0 = xin[0] + g2v[0] * o0, x1 = xin[1] + g2v[1] * o1;
      float ss = WSUM(x0 * x0 + x1 * x1);
      if (lane == 0) sred[hd * 9 + 8] = ss;
      __syncthreads();
      ss = 0.f;
#pragma unroll
      for (int j = 0; j < 8; ++j) ss += sred[j * 9 + 8];
      const float r = rsqrtf(ss * (1.f / 1024.f) + 1e-6f);
      if (dry) { if (x0 == 1.2345e30f) xr[0] = x0; __syncthreads(); }
      else if (last) {
        const f32x2 fw = *(const f32x2*)(p->in[I_FNW] + c0);
        *(f32x2*)xr = (f32x2){x0 * r * fw[0], x1 * r * fw[1]};
      } else {
        *(f32x2*)xr = (f32x2){x0, x1};
        const float* nw = p->in[I_N1W] + (l + 1) * 1024;
        const float* mn = mod + ((size_t)(l + 1) * 8 + b) * 6144;
        const float h0 = x0 * r * nw[c0] * (1.f + mn[1024 + c0]) + mn[c0];
        const float h1 = x1 * r * nw[c0 + 1] * (1.f + mn[1024 + c0 + 1]) + mn[c0 + 1];
        *(unsigned*)(h + (size_t)t * 1024 + c0) = pk2bf(h0, h1);
        float a8[8];
#pragma unroll
        for (int j = 0; j < 8; ++j) a8[j] = WSUM(h0 * w8[c0 * 8 + j] + h1 * w8[(c0 + 1) * 8 + j]);
        if (lane == 0) {
#pragma unroll
          for (int j = 0; j < 8; ++j) sred[hd * 9 + j] = a8[j];
        }
        __syncthreads();
        if (tid < 8) { float a = 0.f; for (int j = 0; j < 8; ++j) a += sred[j * 9 + tid]; ba[(size_t)t * 8 + tid] = a; }
      }
    }
  }
}

#define D_EID (32 * MiB)
#define D_GATE (40 * MiB)
#define D_WTS (56 * MiB)
#define C_PD 0
#define B_PO 0

__device__ __forceinline__ void peer_route(const int WID, KP p, unsigned char* lds) {
  const int tid = lt(), lane = tid & 63;
  const unsigned short* sc = (const unsigned short*)(p->ws + WS_B + B_SCORE);
  unsigned short* eidg = (unsigned short*)(p->ws + WS_D + D_EID);
  float* gateg = (float*)(p->ws + WS_D + D_GATE);
  for (int tile = blockIdx.x; tile < TOK / 32; tile += gridDim.x) {
    const int tokl = tid >> 4, list = tid & 15;
    const unsigned short* sp = sc + (size_t)(tile * 32 + tokl) * 2048 + list * 128;
    float best[16];
    u32x4 rr[16];
#pragma unroll
    for (int i = 0; i < 16; ++i) rr[i] = *(const u32x4*)(sp + i * 8);
#pragma unroll
    for (int grp = 0; grp < 8; ++grp) {
      const u32x4 r0 = rr[2 * grp], r1 = rr[2 * grp + 1];
      float cur[16];
#pragma unroll
      for (int q = 0; q < 4; ++q) {
        const unsigned w0 = r0[q], w1 = r1[q];
        cur[2 * q] = __uint_as_float(__float_as_uint(h16f(w0 & 0xffffu)) | (unsigned)(grp * 16 + 2 * q));
        cur[2 * q + 1] = __uint_as_float(__float_as_uint(h16f(w0 >> 16)) | (unsigned)(grp * 16 + 2 * q + 1));
        cur[8 + 2 * q] = __uint_as_float(__float_as_uint(h16f(w1 & 0xffffu)) | (unsigned)(grp * 16 + 8 + 2 * q));
        cur[8 + 2 * q + 1] = __uint_as_float(__float_as_uint(h16f(w1 >> 16)) | (unsigned)(grp * 16 + 8 + 2 * q + 1));
      }
      sort16_desc(cur);
      if (grp == 0) {
#pragma unroll
        for (int i = 0; i < 16; ++i) best[i] = cur[i];
      } else merge16_desc(best, cur);
    }
    float v1[16], v2[16];
    const bool ishalf1 = (list & 1) != 0;
#pragma unroll
    for (int i = 0; i < 16; ++i) {
      const float o = shx(best[i], 1, lane);
      v1[i] = ishalf1 ? o : best[i];
      v2[i] = ishalf1 ? best[i] : o;
    }
    float c[4][16];
#pragma unroll
    for (int i = 0; i < 64; ++i) c[i >> 4][i & 15] = -INFINITY;
    {
      int n = 0;
#pragma unroll
      for (int a = 0; a < 16; ++a) {
#pragma unroll
        for (int bq = 0; bq < 16; ++bq) {
          if ((a + 1) * (bq + 1) <= 16) {
            const unsigned ua_ = __float_as_uint(v1[a]), ub_ = __float_as_uint(v2[bq]);
            const float s = __uint_as_float(ua_ & ~0x7fu) + __uint_as_float(ub_ & ~0x7fu);
            c[n >> 4][n & 15] = __uint_as_float((__float_as_uint(s) & ~0x3fffu) | ((ua_ & 0x7fu) << 7) | (ub_ & 0x7fu));
            ++n;
          }
        }
      }
    }
    sort16_desc(c[0]); sort16_desc(c[1]); sort16_desc(c[2]); sort16_desc(c[3]);
    merge16_desc(c[0], c[1]); merge16_desc(c[2], c[3]); merge16_desc(c[0], c[2]);
    const float s0 = __uint_as_float(__float_as_uint(c[0][0]) & ~0x3fffu);
    float e[16], esum = 0.f;
#pragma unroll
    for (int i = 0; i < 16; ++i) { e[i] = __expf(__uint_as_float(__float_as_uint(c[0][i]) & ~0x3fffu) - s0); esum += e[i]; }
    const float inv = 1.f / esum;
    if (!ishalf1) {
      const int hd = list >> 1;
      const size_t o = (size_t)(tile * 32 + tokl) * 128 + (hd >> 2) * 64 + (hd & 3) * 2;
#pragma unroll
      for (int j = 0; j < 16; ++j) {
        const int kp = (j & 7) * 8 + (j >> 3);
        eidg[o + kp] = (unsigned short)(__float_as_uint(c[0][j]) & 0x3fffu);
        gateg[o + kp] = e[j] * inv;
      }
    }
  }
}

__device__ __forceinline__ u32x4 pz_ld_e(const unsigned short* eidg, int t, int half, int r) { return *(const u32x4*)(eidg + (size_t)t * 128 + 64 * half + 8 * r); }
__device__ __forceinline__ void pz_ld_r8(const unsigned char* tab, const u32x4& ep, int off, u32x4 (&rows)[8]) {
#pragma unroll
  for (int i = 0; i < 8; ++i) {
    const unsigned e = (i & 1) ? (ep[i >> 1] >> 16) : (ep[i >> 1] & 0xffffu);
    rows[i] = *(const u32x4*)(tab + (size_t)e * 128 + off);
  }
}
__device__ __forceinline__ void pz_u_half(const float (&hv)[16], const u32x4 (&rows)[8], int lane, float* pdhalf) {
  float pt[8];
#pragma unroll
  for (int i = 0; i < 8; ++i) {
    float s = 0.f;
#pragma unroll
    for (int q = 0; q < 4; ++q) {
      const f32x2 lo = __builtin_amdgcn_cvt_pk_f32_fp8((int)rows[i][q], false), hi = __builtin_amdgcn_cvt_pk_f32_fp8((int)rows[i][q], true);
      s += hv[4 * q] * lo[0] + hv[4 * q + 1] * lo[1] + hv[4 * q + 2] * hi[0] + hv[4 * q + 3] * hi[1];
    }
    pt[i] = s;
  }
  float r4[4], r2[2], r1;
  {
    const bool up = (lane & 4) != 0;
#pragma unroll
    for (int k = 0; k < 4; ++k) { const float snd = up ? pt[k] : pt[k + 4], keep = up ? pt[k + 4] : pt[k]; r4[k] = keep + shx(snd, 4, lane); }
  }
  {
    const bool up = (lane & 2) != 0;
#pragma unroll
    for (int k = 0; k < 2; ++k) { const float snd = up ? r4[k] : r4[k + 2], keep = up ? r4[k + 2] : r4[k]; r2[k] = keep + shx(snd, 2, lane); }
  }
  {
    const bool up = (lane & 1) != 0;
    const float snd = up ? r2[0] : r2[1], keep = up ? r2[1] : r2[0];
    r1 = keep + shx(snd, 1, lane);
  }
  pdhalf[(lane >> 3) * 8 + 4 * ((lane >> 2) & 1) + 2 * ((lane >> 1) & 1) + (lane & 1)] = r1;
}
__device__ __forceinline__ void pz_hv(const u32x4& ha, const u32x4& hb, float (&hv)[16]) {
  hv[0] = bflo(ha.x); hv[1] = bfhi(ha.x); hv[2] = bflo(ha.y); hv[3] = bfhi(ha.y); hv[4] = bflo(ha.z); hv[5] = bfhi(ha.z); hv[6] = bflo(ha.w); hv[7] = bfhi(ha.w);
  hv[8] = bflo(hb.x); hv[9] = bfhi(hb.x); hv[10] = bflo(hb.y); hv[11] = bfhi(hb.y); hv[12] = bflo(hb.z); hv[13] = bfhi(hb.z); hv[14] = bflo(hb.w); hv[15] = bfhi(hb.w);
}
__device__ __forceinline__ void peer_u(const int WID, KP p) {
  const int lane = lane_l(), r = lane >> 3, c = lane & 7;
  const int s = blockIdx.x & 7, tg = blockIdx.x >> 3, ng = gridDim.x >> 3;
  const unsigned short* eidg = (const unsigned short*)(p->ws + WS_D + D_EID);
  const unsigned char* tu = p->ws + WS_D + D_TU8 + (size_t)(blockIdx.x & 7) * (16384 * 128) - 128 * (blockIdx.x & 7);
  const bf16_t* h = (const bf16_t*)(p->ws + WS_A);
  float* pd = (float*)(p->ws + WS_C + C_PD) + (size_t)s * TOK * 128;
  const int off = 128 * s + 16 * c;
  const int ts = ng * 8;
  const int t0 = tg * 8 + WID;
  if (t0 >= TOK) return;
#define CLT(x) ((x) < TOK ? (x) : t0)
  u32x4 rA0[8], rA1[8], rB0[8], rB1[8];
  u32x4 eA0, eA1, eB0, eB1, hA0, hA1, hB0, hB1;
  {
    const int ta = t0, tb = CLT(t0 + ts);
    eA0 = pz_ld_e(eidg, ta, 0, r); eA1 = pz_ld_e(eidg, ta, 1, r); eB0 = pz_ld_e(eidg, tb, 0, r); eB1 = pz_ld_e(eidg, tb, 1, r);
    hA0 = *(const u32x4*)(h + (size_t)ta * 1024 + off); hA1 = *(const u32x4*)(h + (size_t)ta * 1024 + off + 8);
    hB0 = *(const u32x4*)(h + (size_t)tb * 1024 + off); hB1 = *(const u32x4*)(h + (size_t)tb * 1024 + off + 8);
    pz_ld_r8(tu, eA0, off, rA0); pz_ld_r8(tu, eA1, off, rA1); pz_ld_r8(tu, eB0, off, rB0); pz_ld_r8(tu, eB1, off, rB1);
    const int tc = CLT(t0 + 2 * ts), td = CLT(t0 + 3 * ts);
    eA0 = pz_ld_e(eidg, tc, 0, r); eA1 = pz_ld_e(eidg, tc, 1, r); eB0 = pz_ld_e(eidg, td, 0, r); eB1 = pz_ld_e(eidg, td, 1, r);
  }
  for (int t = t0; t < TOK; t += 2 * ts) {
    const int tb = t + ts, tc = CLT(t + 2 * ts), td = CLT(t + 3 * ts), te = CLT(t + 4 * ts), tf = CLT(t + 5 * ts);
    float hv[16];
    pz_hv(hA0, hA1, hv);
    hA0 = *(const u32x4*)(h + (size_t)tc * 1024 + off); hA1 = *(const u32x4*)(h + (size_t)tc * 1024 + off + 8);
    pz_u_half(hv, rA0, lane, pd + (size_t)t * 128);
    pz_ld_r8(tu, eA0, off, rA0); eA0 = pz_ld_e(eidg, te, 0, r);
    pz_u_half(hv, rA1, lane, pd + (size_t)t * 128 + 64);
    pz_ld_r8(tu, eA1, off, rA1); eA1 = pz_ld_e(eidg, te, 1, r);
    if (tb < TOK) {
      pz_hv(hB0, hB1, hv);
      hB0 = *(const u32x4*)(h + (size_t)td * 1024 + off); hB1 = *(const u32x4*)(h + (size_t)td * 1024 + off + 8);
      pz_u_half(hv, rB0, lane, pd + (size_t)tb * 128);
      pz_ld_r8(tu, eB0, off, rB0); eB0 = pz_ld_e(eidg, tf, 0, r);
      pz_u_half(hv, rB1, lane, pd + (size_t)tb * 128 + 64);
      pz_ld_r8(tu, eB1, off, rB1); eB1 = pz_ld_e(eidg, tf, 1, r);
    }
  }
}
__device__ __forceinline__ void peer_w(const int WID, KP p) {
  const float* pd = (const float*)(p->ws + WS_C + C_PD);
  const float* gateg = (const float*)(p->ws + WS_D + D_GATE);
  unsigned short* wts = (unsigned short*)(p->ws + WS_D + D_WTS);
  const size_t n = (size_t)TOK * 128, stride = (size_t)gridDim.x * NTHR * 4;
  for (size_t i = ((size_t)blockIdx.x * NTHR + lt()) * 4; i < n; i += stride) {
    f32x4 a = *(const f32x4*)(pd + i);
#pragma unroll
    for (int s = 1; s < 8; ++s) a = a + *(const f32x4*)(pd + (size_t)s * n + i);
    const f32x4 g = *(const f32x4*)(gateg + i);
    u32x2 wv;
    wv.x = (unsigned)f2h(g[0] * gelu_f(a[0] * (1.f / 64.f)) * 0.25f) | ((unsigned)f2h(g[1] * gelu_f(a[1] * (1.f / 64.f)) * 0.25f) << 16);
    wv.y = (unsigned)f2h(g[2] * gelu_f(a[2] * (1.f / 64.f)) * 0.25f) | ((unsigned)f2h(g[3] * gelu_f(a[3] * (1.f / 64.f)) * 0.25f) << 16);
    *(u32x2*)(wts + i) = wv;
  }
}
__device__ __forceinline__ void pz_v_half(const u32x4& wp, const u32x4 (&rows)[8], float (&acc)[16]) {
#pragma unroll
  for (int i = 0; i < 8; ++i) {
    const float wv = h2f((unsigned short)((i & 1) ? (wp[i >> 1] >> 16) : (wp[i >> 1] & 0xffffu)));
#pragma unroll
    for (int q = 0; q < 4; ++q) {
      const f32x2 lo = __builtin_amdgcn_cvt_pk_f32_fp8((int)rows[i][q], false), hi = __builtin_amdgcn_cvt_pk_f32_fp8((int)rows[i][q], true);
      acc[4 * q] += wv * lo[0]; acc[4 * q + 1] += wv * lo[1]; acc[4 * q + 2] += wv * hi[0]; acc[4 * q + 3] += wv * hi[1];
    }

  }
}
__device__ __forceinline__ void pz_v_finish(const float (&acc)[16], int lane, bf16_t* porow) {
  float r8[8], r4[4], r2[2];
  {
    const bool up = (lane & 32) != 0;
#pragma unroll
    for (int k = 0; k < 8; ++k) { const float snd = up ? acc[k] : acc[k + 8], keep = up ? acc[k + 8] : acc[k]; r8[k] = keep + shx(snd, 32, lane); }
  }
  {
    const bool up = (lane & 16) != 0;
#pragma unroll
    for (int k = 0; k < 4; ++k) { const float snd = up ? r8[k] : r8[k + 4], keep = up ? r8[k + 4] : r8[k]; r4[k] = keep + shx(snd, 16, lane); }
  }
  {
    const bool up = (lane & 8) != 0;
#pragma unroll
    for (int k = 0; k < 2; ++k) { const float snd = up ? r4[k] : r4[k + 2], keep = up ? r4[k + 2] : r4[k]; r2[k] = keep + shx(snd, 8, lane); }
  }
  const int col = 16 * (lane & 7) + 8 * ((lane >> 5) & 1) + 4 * ((lane >> 4) & 1) + 2 * ((lane >> 3) & 1);
  *(unsigned*)(porow + col) = pk2bf(r2[0], r2[1]);
}
__device__ __forceinline__ u32x4 pz_ld_w(const unsigned short* wts, int t, int half, int r) { return *(const u32x4*)(wts + (size_t)t * 128 + 64 * half + 8 * r); }
__device__ __forceinline__ void peer_v(const int WID, KP p, int l, const bool dry) {
  const int lane = lane_l(), r = lane >> 3, c = lane & 7;
  const int s = blockIdx.x & 7, tg = blockIdx.x >> 3, ng = gridDim.x >> 3;
  const unsigned short* eidg = (const unsigned short*)(p->ws + WS_D + D_EID);
  const unsigned short* wts = (const unsigned short*)(p->ws + WS_D + D_WTS);
  const unsigned char* tv = p->ws + WS_D + D_TV8 + (size_t)(blockIdx.x & 7) * (16384 * 128) - 128 * (blockIdx.x & 7);
  bf16_t* po = (bf16_t*)(p->ws + WS_B + B_PO) + 128 * s;
  const int off = 128 * s + 16 * c;
  const int ts = ng * 8;
  const int t0 = tg * 8 + WID;
  if (t0 >= TOK) return;
  u32x4 rA[8], rB[8], eA, eB, wA, wB, nA, nB, nwA, nwB;
  eA = pz_ld_e(eidg, t0, 0, r); eB = pz_ld_e(eidg, t0, 1, r); wA = pz_ld_w(wts, t0, 0, r); wB = pz_ld_w(wts, t0, 1, r);
  pz_ld_r8(tv, eA, off, rA);
  { const int tn = CLT(t0 + ts); nA = pz_ld_e(eidg, tn, 0, r); nB = pz_ld_e(eidg, tn, 1, r); nwA = pz_ld_w(wts, tn, 0, r); nwB = pz_ld_w(wts, tn, 1, r); }
  for (int t = t0; t < TOK; t += ts) {
    const int tn2 = CLT(t + 2 * ts);
    pz_ld_r8(tv, eB, off, rB);
    float acc[16];
#pragma unroll
    for (int j = 0; j < 16; ++j) acc[j] = 0.f;
    pz_v_half(wA, rA, acc);
    pz_ld_r8(tv, nA, off, rA);
    pz_v_half(wB, rB, acc);
    pz_v_finish(acc, lane, po + (size_t)t * 1024);
    eB = nB; wA = nwA; wB = nwB;
    nA = pz_ld_e(eidg, tn2, 0, r); nB = pz_ld_e(eidg, tn2, 1, r); nwA = pz_ld_w(wts, tn2, 0, r); nwB = pz_ld_w(wts, tn2, 1, r);
  }
}
__device__ __forceinline__ void phase_resnorm(const int WID, KP p, int l, unsigned char* lds) {
  const int tid = lt(), wave = tid >> 6, lane = tid & 63;
  const bool last = (l == 1);
  float* w8 = (float*)lds;
  float* x = p->out;
  const bf16_t* po = (const bf16_t*)(p->ws + WS_B + B_PO);
  const float* mod = (const float*)(p->ws + WS_MISC + MISC_MOD);
  bf16_t* h = (bf16_t*)(p->ws + WS_A);
  float* ba = (float*)(p->ws + WS_B + B_BA);
  if (!last) {
    const float* w_in_n = p->in[I_WIN] + (size_t)(l + 1) * 1024 * IN_COLS;
    for (int i = tid; i < 8192; i += NTHR) w8[i] = w_in_n[(size_t)(i >> 3) * IN_COLS + 2048 + (i & 7)];
    __syncthreads();
  }
  for (int t = blockIdx.x * 8 + wave; t < TOK; t += gridDim.x * 8) {
    const int b = t >> 12;
    const float* g2 = mod + ((size_t)l * 8 + b) * 6144 + 5120;
    f32x4 v[4];
    float ss = 0.f;
#pragma unroll
    for (int i = 0; i < 4; ++i) {
      const int c = i * 256 + lane * 4;
      const u32x2 pv = *(const u32x2*)(po + (size_t)t * 1024 + c);
      const f32x4 gv = *(const f32x4*)(g2 + c);
      const u32x2 xw = *(const u32x2*)((const bf16_t*)x + (size_t)t * 2048 + c);
      v[i] = (f32x4){bflo(xw.x), bfhi(xw.x), bflo(xw.y), bfhi(xw.y)} + gv * (f32x4){bflo(pv.x), bfhi(pv.x), bflo(pv.y), bfhi(pv.y)};
      ss += v[i][0] * v[i][0] + v[i][1] * v[i][1] + v[i][2] * v[i][2] + v[i][3] * v[i][3];
    }
    ss = WSUM(ss);
    const float r = rsqrtf(ss * (1.f / 1024.f) + 1e-6f);
    if (last) {
#pragma unroll
      for (int i = 0; i < 4; ++i) *(f32x4*)(x + (size_t)t * 1024 + i * 256 + lane * 4) = v[i] * r * *(const f32x4*)(p->in[I_FNW] + i * 256 + lane * 4);
    } else {
      const float* nw = p->in[I_N1W] + (l + 1) * 1024;
      const float* mn = mod + ((size_t)(l + 1) * 8 + b) * 6144;
      float a8[8];
#pragma unroll
      for (int j = 0; j < 8; ++j) a8[j] = 0.f;
#pragma unroll
      for (int i = 0; i < 4; ++i) {
        const int c = i * 256 + lane * 4;
        { u32x2 xo; xo.x = pk2bf(v[i][0], v[i][1]); xo.y = pk2bf(v[i][2], v[i][3]); *(u32x2*)((bf16_t*)x + (size_t)t * 2048 + c) = xo; }
        const f32x4 hv = v[i] * r * *(const f32x4*)(nw + c) * (*(const f32x4*)(mn + 1024 + c) + 1.f) + *(const f32x4*)(mn + c);
        u32x2 wv; wv.x = pk2bf(hv[0], hv[1]); wv.y = pk2bf(hv[2], hv[3]);
        *(u32x2*)(h + (size_t)t * 1024 + c) = wv;
        { int q = __builtin_amdgcn_cvt_pk_fp8_f32(hv[0], hv[1], 0, false); q = __builtin_amdgcn_cvt_pk_fp8_f32(hv[2], hv[3], q, true); *(int*)((unsigned char*)x + (size_t)t * 4096 + 2048 + c) = q; }
#pragma unroll
        for (int k = 0; k < 4; ++k)
#pragma unroll
          for (int j = 0; j < 8; ++j) a8[j] += hv[k] * w8[(c + k) * 8 + j];
      }
      const float tot = reduce8(a8, lane);
      if ((lane & 7) == 0) ba[(size_t)t * 8 + ((lane >> 5) & 1) * 4 + ((lane >> 4) & 1) * 2 + ((lane >> 3) & 1)] = tot;
    }
  }
  __syncthreads();
}
__device__ __forceinline__ void phase_final(const int WID, KP p) {
  const int tid = lt(), wave = tid >> 6, lane = tid & 63;
  float* x = p->out;
  const float* fw = p->in[I_FNW];
  for (int t = blockIdx.x * 8 + wave; t < TOK; t += gridDim.x * 8) {
    f32x4 v[4];
    float ss = 0.f;
#pragma unroll
    for (int i = 0; i < 4; ++i) {
      v[i] = *(const f32x4*)(x + (size_t)t * 1024 + i * 256 + lane * 4);
      ss += v[i][0] * v[i][0] + v[i][1] * v[i][1] + v[i][2] * v[i][2] + v[i][3] * v[i][3];
    }
    ss = WSUM(ss);
    const float r = rsqrtf(ss * (1.f / 1024.f) + 1e-6f);
#pragma unroll
    for (int i = 0; i < 4; ++i) *(f32x4*)(x + (size_t)t * 1024 + i * 256 + lane * 4) = v[i] * r * *(const f32x4*)(fw + i * 256 + lane * 4);
  }
}

#define WSP(off) (P->ws + (off))
#define MODP ((float*)(P->ws + WS_MISC + MISC_MOD))
template <int l, int PASSNO>
__device__ __forceinline__ void layer_body(const int WID, unsigned char* lds, const XcdBarrier& bar) {
#define GSYNC() xcd_barrier(bar)

    REPB(2,  KP P = getp(); EpiIn E{WSP(WS_B)}; run_gemm(WID, lds, (const bf16_t*)WSP(WS_A), (const bf16_t*)WSP(WS_W + W_IN), TOK, 3072, 1024, E); )
    GSYNC();
    STAMP(3 + 12 * l);
    REPB(3,
    { KP P = getp(); gdn_prep(WID, P, l, lds); }
    STAMP(40 + 3 * l);
    { KP P = getp(); moba_kmean(WID, P, lds); }
    STAMP(41 + 3 * l);
    { KP P = getp(); s5_tables(WID, P, l, lds); }
    STAMP(42 + 3 * l);
    )
    GSYNC();
    STAMP(4 + 12 * l);
    if constexpr (PROBE_DUP == 40) {
      { KP P = getp(); gdn_scan(WID, P, lds); }
      { KP P = getp(); moba_select(WID, P, l, lds); }
      { KP P = getp(); s5_mfma(WID, P, l, lds); }
      { KP P = getp(); moba_attn2(WID, P, l, l * 2 + 1, lds); }
      GSYNC();
    }
    REPB(41,  KP P = getp(); gdn_scan(WID, P, lds); )
    STAMP(5 + 12 * l);
    { KP P = getp(); moba_select(WID, P, l, lds); }
    REPB(42,  KP P = getp(); s5_mfma(WID, P, l, lds); )
    STAMP(6 + 12 * l);
    REPB(43,  KP P = getp(); moba_attn2(WID, P, l, l * 2 + rep_, lds); )
    STAMP(7 + 12 * l);
    GSYNC();
    STAMP(8 + 12 * l);
    REPB(50, KP P = getp(); moba_combine(WID, P); )
    { KP P = getp(); gdn_outnorm(WID, P, l); }
    REPB(52,  KP P = getp(); EpiGlu E{(bf16_t*)WSP(WS_D + D_S5O), P->in[I_GLUB] + l * 512}; run_gemm(WID, lds, (const bf16_t*)WSP(WS_D + D_ZG), (const bf16_t*)WSP(WS_W + W_GLU), TOK, 512, 256, E); )
    GSYNC();
    STAMP(9 + 12 * l);
    REPB(6,
    { KP P = getp(); EpiGate E{(bf16_t*)WSP(WS_C + C_S)}; run_gemm(WID, lds, (const bf16_t*)((const unsigned char*)P->out + 2048), (const bf16_t*)(WSP(WS_W + W_G) + (size_t)0 * 1024 * 1024), TOK, 1024, 512, E, 2048); }
    { KP P = getp(); EpiMerge<true> E{(const bf16_t*)WSP(WS_C + C_S), (bf16_t*)WSP(WS_C + C_MERGED)}; run_gemm(WID, lds, (const bf16_t*)WSP(WS_D + D_GA), (const bf16_t*)WSP(WS_W + W_A), TOK, 1024, 512, E); }
    { KP P = getp(); EpiGate E{(bf16_t*)WSP(WS_C + C_S)}; run_gemm(WID, lds, (const bf16_t*)((const unsigned char*)P->out + 2048), (const bf16_t*)(WSP(WS_W + W_G) + (size_t)1 * 1024 * 1024), TOK, 1024, 512, E, 2048); }
    { KP P = getp(); EpiMerge<false> E{(const bf16_t*)WSP(WS_C + C_S), (bf16_t*)WSP(WS_C + C_MERGED)}; run_gemm(WID, lds, (const bf16_t*)WSP(WS_D + D_S5O), (const bf16_t*)WSP(WS_W + W_B), TOK, 1024, 256, E); }
    { KP P = getp(); EpiGate E{(bf16_t*)WSP(WS_C + C_S)}; run_gemm(WID, lds, (const bf16_t*)((const unsigned char*)P->out + 2048), (const bf16_t*)(WSP(WS_W + W_G) + (size_t)2 * 1024 * 1024), TOK, 1024, 512, E, 2048); }
    { KP P = getp(); EpiMerge<false> E{(const bf16_t*)WSP(WS_C + C_S), (bf16_t*)WSP(WS_C + C_MERGED)}; run_gemm(WID, lds, (const bf16_t*)WSP(WS_D + D_MO), (const bf16_t*)WSP(WS_W + W_C), TOK, 1024, 256, E); }
    )
    GSYNC();
    STAMP(10 + 12 * l);
    REPB(7, KP P = getp(); EpiOut<(l == 1)> E{l == 0 ? P->in[I_X] : P->out, P->out, MODP + (size_t)l * 8 * 6144 + 2048, dry_}; run_gemm(WID, lds, (const bf16_t*)WSP(WS_C + C_MERGED), (const bf16_t*)WSP(WS_W + W_OUT), TOK, 1024, 1024, E); )
    GSYNC();
    STAMP(11 + 12 * l);
    REPB(8,
    { KP P = getp(); phase_norm<true>(WID, P->out, nullptr, P->in[I_N2W] + l * 1024, MODP + (size_t)l * 8 * 6144, 3072, 4096, (bf16_t*)WSP(WS_A), nullptr, nullptr, lds); }
    { KP P = getp(); conv_flat8(WID, P->in[I_PU] + (size_t)l * 16384 * 1024, WSP(WS_D + D_TU8), (size_t)16384 * 1024, 64.f); }
    { KP P = getp(); conv_flat8(WID, P->in[I_PV] + (size_t)l * 16384 * 1024, WSP(WS_D + D_TV8), (size_t)16384 * 1024, 4.f); }
    if (l == 0) { KP P = getp(); phase_convert_weights(WID, P, 1, lds); }
    )
    GSYNC();
    STAMP(12 + 12 * l);
    REPB(9,  KP P = getp(); EpiScore E{(unsigned short*)WSP(WS_B + B_SCORE)}; run_gemm(WID, lds, (const bf16_t*)WSP(WS_A), (const bf16_t*)WSP(WS_W + W_EFF), TOK, 2048, 1024, E); )
    GSYNC();
    STAMP(13 + 12 * l);
    if (l == 0) { KP P = getp(); phase_weff(WID, P->in[I_WQ] + (size_t)1024 * 2048, P->in[I_K1] + (size_t)8 * 128 * 128, P->in[I_K2] + (size_t)8 * 128 * 128, (bf16_t*)WSP(WS_W + W_EFF), lds); }
    { KP P = getp(); peer_route(WID, P, lds); }
    GSYNC();
    STAMP(30 + 5 * l);
    REPB(101, KP P = getp(); peer_u(WID, P); )
    GSYNC();
    STAMP(31 + 5 * l);
    { KP P = getp(); peer_w(WID, P); }
    GSYNC();
    STAMP(32 + 5 * l);
    REPB(102, KP P = getp(); peer_v(WID, P, l, dry_); )
    GSYNC();
    STAMP(33 + 5 * l);
    { KP P = getp(); phase_resnorm(WID, P, l, lds); }
    GSYNC();
}

template <int PASSNO>
__device__ __forceinline__ void full_pass(const int WID, unsigned char* lds, const XcdBarrier& bar) {
#define GSYNC() xcd_barrier(bar)
  STAMP(0);
  REPB(0,
  { KP P = getp(); phase_mod(WID, P, lds); }
  { KP P = getp(); phase_convert_weights(WID, P, 0, lds); }
  { KP P = getp(); phase_weff(WID, P->in[I_WQ], P->in[I_K1], P->in[I_K2], (bf16_t*)WSP(WS_W + W_EFF), lds); }
  )
  GSYNC();
  STAMP(1);
  REPB(1,  KP P = getp(); phase_norm(WID, P->in[I_X], nullptr, P->in[I_N1W], MODP, 0, 1024, (bf16_t*)WSP(WS_A), P->in[I_WIN], (float*)WSP(WS_B + B_BA), lds, TOK, (unsigned char*)P->out + 2048); )
  GSYNC();
  STAMP(2);
  layer_body<0, PASSNO>(WID, lds, bar);
  STAMP(14);
  layer_body<1, PASSNO>(WID, lds, bar);
  STAMP(26);

}

__global__ void __launch_bounds__(NTHR) fwd_megakernel(Params p_unused) {
  extern __shared__ __attribute__((aligned(16))) unsigned char lds[];
  volatile LAS unsigned* bst = (volatile LAS unsigned*)(lds + LDS_BYTES - 16);
  if (threadIdx.x < 4) bst[threadIdx.x] = 0u;
  __syncthreads();
  const XcdBarrier bar = xcd_barrier_post((unsigned*)(getp()->ws + WS_MISC + MISC_BAR), bst);
#define GSYNC() xcd_barrier(bar)
  const int WID = __builtin_amdgcn_readfirstlane((int)(threadIdx.x >> 6));
#ifdef PROBE_TWICE
  full_pass<0>(WID, lds, bar);
  GSYNC();
  full_pass<1>(WID, lds, bar);
#else
  full_pass<1>(WID, lds, bar);
#endif
#ifdef PROBE_LO
  GSYNC();
  {
    const unsigned long long* ts = (const unsigned long long*)(getp()->ws + WS_MISC + MISC_TS);
    const float us = exp2f(floorf(log2f((float)(ts[PROBE_HI] - ts[PROBE_LO]) * 0.01f) * 4.f + PROBE_OFF) / 4.f);
    float* o = getp()->out;
    for (size_t i = (size_t)blockIdx.x * NTHR + lt(); i < (size_t)TOK * 1024; i += (size_t)gridDim.x * NTHR) o[i] = us;
  }
#endif
}

extern "C" void kernel_launch(void* const* d_in, const int* in_sizes, int n_in, void* d_out, int out_size, void* d_ws, size_t ws_size, hipStream_t stream) {
  static int grid_blocks = 0;
  if (grid_blocks == 0) {
    int dev = 0, cus = 0, per_cu = 0;
    if (ws_size < WS_END || n_in != 31) { fprintf(stderr, "kernel_launch: need %zu bytes of workspace, got %zu (n_in %d)\n", (size_t)WS_END, ws_size, n_in); grid_blocks = -1; return; }
    (void)hipGetDevice(&dev);
    (void)hipDeviceGetAttribute(&cus, hipDeviceAttributeMultiprocessorCount, dev);
    (void)hipFuncSetAttribute((const void*)fwd_megakernel, hipFuncAttributeMaxDynamicSharedMemorySize, LDS_BYTES);
    (void)hipOccupancyMaxActiveBlocksPerMultiprocessor(&per_cu, (const void*)fwd_megakernel, NTHR, LDS_BYTES);
    if (per_cu < 1) { fprintf(stderr, "kernel_launch: occupancy query says %d blocks per CU\n", per_cu); per_cu = 1; }
    grid_blocks = cus;
    fprintf(stderr, "kernel_launch: cus %d per_cu %d grid %d ws %zu\n", cus, per_cu, grid_blocks, ws_size);
  }
  if (grid_blocks < 0) return;
  Params p{};
  for (int i = 0; i < 31; ++i) p.in[i] = (const float*)d_in[i];
  p.out = (float*)d_out; p.ws = (unsigned char*)d_ws;
  (void)hipMemsetAsync((char*)d_ws + WS_MISC + MISC_BAR, 0, XCD_BAR_WORDS * 4, stream);
  void* args[] = {&p};
  hipError_t e = hipLaunchCooperativeKernel((const void*)fwd_megakernel, dim3(grid_blocks), dim3(NTHR), args, LDS_BYTES, stream);
  if (e != hipSuccess) fprintf(stderr, "cooperative launch failed: %s (grid %d)\n", hipGetErrorString(e), grid_blocks);
}
```

```cpp
#include <hip/hip_runtime.h>
#include <hip/hip_cooperative_groups.h>
#include <math.h>
#include <stdio.h>
namespace cg = cooperative_groups;

#define TOK 32768
#define SEQ 4096
#define NBLK_EXPECT 256
#define NTHR 512
#define IN_COLS 6152
#define LDS_BYTES 147456

typedef unsigned short bf16_t;
typedef float f32x4 __attribute__((ext_vector_type(4)));
typedef unsigned u32x4 __attribute__((ext_vector_type(4)));
typedef unsigned u32x2 __attribute__((ext_vector_type(2)));
typedef float f32x2 __attribute__((ext_vector_type(2)));
typedef short s16x4 __attribute__((ext_vector_type(4)));
#define LAS __attribute__((address_space(3)))

#define MiB ((size_t)1048576)
#define WS_MISC 0
#define WS_W (4 * MiB)
#define WS_A (28 * MiB)
#define WS_B (92 * MiB)
#define WS_C (285 * MiB)
#define WS_D (431 * MiB)
#define WS_END (511 * MiB)
#define MISC_MOD 0
#define MISC_KMEAN (512 * 1024)
#define MISC_CTR (1024 * 1024)
#define MISC_BAR (1024 * 1024 + 4096)
#define MISC_TS (2 * 1024 * 1024)
#define W_IN 0
#define W_G (6 * MiB)
#define W_A (12 * MiB)
#define W_B (13 * MiB)
#define W_C (13 * MiB + 512 * 1024)
#define W_OUT (14 * MiB)
#define W_GLU (16 * MiB)
#define W_EFF (17 * MiB)
#define B_GQ 0
#define B_GK (32 * MiB)
#define B_GV (64 * MiB)
#define B_GZ (96 * MiB)
#define B_S5U (128 * MiB)
#define B_MQ (144 * MiB)
#define B_MK (160 * MiB)
#define B_MV (176 * MiB)
#define B_BA (192 * MiB)
#define B_SCORE 0
#define C_QH 0
#define C_KH (32 * MiB)
#define C_VV (64 * MiB)
#define C_BETA (96 * MiB)
#define C_G (97 * MiB)
#define C_S 0
#define C_MERGED (64 * MiB)
#define D_GA 0
#define D_ZG (32 * MiB)
#define D_S5O (48 * MiB)
#define D_MO (64 * MiB)
#define D_TU 0
#define D_TV (32 * MiB)
#define D_EID (64 * MiB)

struct Params {
  const float* in[31];
  float* out;
  unsigned char* ws;
};
enum { I_X = 0, I_C, I_ADAW, I_ADAB, I_N1W, I_WIN, I_CONVW, I_ALOG, I_DTB, I_GNW, I_S5ARE, I_S5AIM, I_S5BRE, I_S5BIM,
       I_S5CRE, I_S5CIM, I_S5D, I_S5LDT, I_GLUW, I_GLUB, I_WBA, I_WBB, I_WBC, I_WOUT, I_N2W, I_WQ, I_K1, I_K2, I_PU, I_PV, I_FNW };

__device__ __forceinline__ float bf2f(bf16_t v) { return __uint_as_float(((unsigned)v) << 16); }
__device__ __forceinline__ bf16_t f2bf(float f) { unsigned u = __float_as_uint(f); u += 0x7fffu + ((u >> 16) & 1u); return (bf16_t)(u >> 16); }
__device__ __forceinline__ unsigned pk2bf(float lo, float hi) { return (unsigned)f2bf(lo) | ((unsigned)f2bf(hi) << 16); }
__device__ __forceinline__ float bflo(unsigned w) { return __uint_as_float(w << 16); }
__device__ __forceinline__ float bfhi(unsigned w) { return __uint_as_float(w & 0xffff0000u); }
__device__ __forceinline__ unsigned short f2h(float f) { _Float16 h = (_Float16)f; return __builtin_bit_cast(unsigned short, h); }
__device__ __forceinline__ float h2f(unsigned short u) { _Float16 h = __builtin_bit_cast(_Float16, u); return (float)h; }
__device__ __forceinline__ float silu_f(float x) { return x / (1.f + __expf(-x)); }
__device__ __forceinline__ float sigmoid_f(float x) { return 1.f / (1.f + __expf(-x)); }
__device__ __forceinline__ float gelu_f(float v) {
  const float t = __builtin_amdgcn_rcpf(fabsf(v) * 0.2316418882f + 1.0f);
  float q = t * 0.5307027145f + (-0.7265760135f); q = q * t + 0.7107068705f; q = q * t + (-0.142248368f); q = q * t + 0.127414796f; q = q * t;
  const float e = __builtin_amdgcn_exp2f((v * v) * (-0.72134752044f));
  const float m = v * (q * e);
  return v < 0.f ? m : v - m;
}
__device__ __forceinline__ float softplus_f(float x) { return fmaxf(x, 0.f) + log1pf(expf(-fabsf(x))); }
__device__ __forceinline__ float shx(float v, int m, int lane) { return __int_as_float(__builtin_amdgcn_ds_bpermute((lane ^ m) << 2, __float_as_int(v))); }
__device__ __forceinline__ int shxi(int v, int m, int lane) { return __builtin_amdgcn_ds_bpermute((lane ^ m) << 2, v); }
__device__ __forceinline__ float shl(float v, int src) { return __int_as_float(__builtin_amdgcn_ds_bpermute(src << 2, __float_as_int(v))); }
__device__ __forceinline__ int shli(int v, int src) { return __builtin_amdgcn_ds_bpermute(src << 2, v); }
__device__ __forceinline__ float wave_sum(float v, int lane) {
#pragma unroll
  for (int o = 32; o > 0; o >>= 1) v += shx(v, o, lane);
  return v;
}
__device__ __forceinline__ float wave_max(float v, int lane) {
#pragma unroll
  for (int o = 32; o > 0; o >>= 1) v = fmaxf(v, shx(v, o, lane));
  return v;
}
__device__ __forceinline__ int lane_l() { int l; asm volatile("v_mbcnt_lo_u32_b32 %0, -1, 0\n\tv_mbcnt_hi_u32_b32 %0, -1, %0" : "=v"(l)); return l; }
#define lt() ((WID << 6) | lane_l())
typedef const __attribute__((address_space(4))) Params* KP;
__device__ __forceinline__ KP getp() {
  auto k = __builtin_amdgcn_kernarg_segment_ptr();
  asm volatile("" : "+s"(k));
  return (KP)k;
}
#define WSUM(x) wave_sum((x), lane)
#define WMAX(x) wave_max((x), lane)

#define XB_TMO      128
#define XB_XCNT(j)  (256  + 64 * (j))
#define XB_XSUB(j)  (1280 + 64 * (j))
#define XB_XGEN(j)  (2304 + 64 * (j))
#define XB_TOP      3328
#define XB_TOPGEN   3392
#define XCD_BAR_WORDS 3456
#define XB_SPIN_CAP (1u << 18)

__device__ __forceinline__ unsigned xb_ld(unsigned* p)              { return __hip_atomic_load(p, __ATOMIC_RELAXED, __HIP_MEMORY_SCOPE_AGENT); }
__device__ __forceinline__ unsigned xb_add(unsigned* p, unsigned v) { return __hip_atomic_fetch_add(p, v, __ATOMIC_RELAXED, __HIP_MEMORY_SCOPE_AGENT); }
__device__ __forceinline__ unsigned xb_xcc_id() { return (unsigned)__builtin_amdgcn_s_getreg((3 << 11) | 20) & 0xFu; }
#define XB_SPIN(cond, bar) do { unsigned _sp = 0; while (cond) { __builtin_amdgcn_s_sleep(1); \
    if ((++_sp & 255u) == 0u) { if (xb_ld(&(bar)[XB_TMO])) break; if (_sp > XB_SPIN_CAP) { atomicAdd(&(bar)[XB_TMO], 1u); break; } } } } while (0)

struct XcdBarrier {
    unsigned* bar; unsigned x;
    volatile LAS unsigned* st;
};

__device__ __forceinline__ XcdBarrier xcd_barrier_post(unsigned* bar, volatile LAS unsigned* st) {
    XcdBarrier b; b.bar = bar; b.x = xb_xcc_id(); b.st = st;
    if (threadIdx.x == 0) (void)xb_add(&bar[XB_XCNT(b.x)], 1u);
    return b;
}
__device__ __forceinline__ void xcd_barrier_complete(unsigned* bar, unsigned x, unsigned& nloc, unsigned& nx) {
    const unsigned G = gridDim.x * gridDim.y * gridDim.z;
    unsigned sum, cnt, mine, sp = 0u;
    for (;;) {
        sum = 0u; cnt = 0u; mine = 0u;
#pragma unroll
        for (unsigned j = 0; j < 16; ++j) { const unsigned c = xb_ld(&bar[XB_XCNT(j)]); sum += c; cnt += (c > 0u) ? 1u : 0u; mine = (j == x) ? c : mine; }
        if (sum == G) break;
        __builtin_amdgcn_s_sleep(1);
        if ((++sp & 255u) == 0u) { if (xb_ld(&bar[XB_TMO])) break; if (sp > XB_SPIN_CAP) { atomicAdd(&bar[XB_TMO], 1u); break; } }
    }
    nloc = mine > 0u ? mine : 1u; nx = cnt > 0u ? cnt : 1u;
}

__device__ __forceinline__ void xcd_barrier(const XcdBarrier& b) {
    asm volatile("s_waitcnt vmcnt(0)" ::: "memory");
    __syncthreads();
    if (threadIdx.x == 0) {
        unsigned* bar = b.bar;
        __builtin_amdgcn_s_waitcnt(0);
        unsigned nloc = b.st[0], nx = b.st[1];
        if (nloc == 0u) { xcd_barrier_complete(bar, b.x, nloc, nx); b.st[0] = nloc; b.st[1] = nx; }
        const unsigned old = xb_add(&bar[XB_XSUB(b.x)], 1u);
        const unsigned gen = old / nloc;
        if (old + 1u == (gen + 1u) * nloc) {
            __builtin_amdgcn_fence(__ATOMIC_RELEASE, "agent");
            asm volatile("s_waitcnt vmcnt(0)" ::: "memory");
            const unsigned og = xb_add(&bar[XB_TOP], 1u);
            const unsigned tg = og / nx;
            if (og + 1u == (tg + 1u) * nx) xb_add(&bar[XB_TOPGEN], 1u);
            else XB_SPIN(xb_ld(&bar[XB_TOPGEN]) == tg, bar);
            __builtin_amdgcn_fence(__ATOMIC_ACQUIRE, "agent");
            xb_add(&bar[XB_XGEN(b.x)], 1u);
            asm volatile("s_waitcnt vmcnt(0)" ::: "memory");
        } else {
            XB_SPIN(xb_ld(&bar[XB_XGEN(b.x)]) == gen, bar);
            __builtin_amdgcn_fence(__ATOMIC_ACQUIRE, "agent");
            asm volatile("s_waitcnt vmcnt(0)" ::: "memory");
        }
    }
    __syncthreads();
}


__device__ __forceinline__ float reduce8(const float (&a)[8], int lane) {
  float r4[4], r2[2], r1;
  { const bool up = (lane & 32) != 0;
#pragma unroll
    for (int k = 0; k < 4; ++k) { const float snd = up ? a[k] : a[k + 4], keep = up ? a[k + 4] : a[k]; r4[k] = keep + shx(snd, 32, lane); } }
  { const bool up = (lane & 16) != 0;
#pragma unroll
    for (int k = 0; k < 2; ++k) { const float snd = up ? r4[k] : r4[k + 2], keep = up ? r4[k + 2] : r4[k]; r2[k] = keep + shx(snd, 16, lane); } }
  { const bool up = (lane & 8) != 0; const float snd = up ? r2[0] : r2[1], keep = up ? r2[1] : r2[0]; r1 = keep + shx(snd, 8, lane); }
  r1 += shx(r1, 4, lane); r1 += shx(r1, 2, lane); r1 += shx(r1, 1, lane);
  return r1;
}

static constexpr int PASSNO = 1;
#ifndef PROBE_DUP
#define PROBE_DUP -1
#endif
#define REPB(k, ...) { const int rep_ = 0; (void)rep_; const bool dry_ = (PROBE_DUP == (k)); (void)dry_; __VA_ARGS__ } if constexpr (PROBE_DUP == (k)) { const int rep_ = 1; (void)rep_; const bool dry_ = false; (void)dry_; __VA_ARGS__ }
#ifdef PROBE_LO
#define STAMP(i) do { if (blockIdx.x == PROBE_BLK && lane_l() == 0 && WID == 0 && PASSNO == 1) ((unsigned long long*)(getp()->ws + WS_MISC + MISC_TS))[i] = __builtin_amdgcn_s_memrealtime(); } while (0)
#else
#define STAMP(i) do { } while (0)
#endif
namespace pg8 {
#define PG8_LAS __attribute__((address_space(3)))
typedef unsigned short bf16_t;
typedef short bf16x8 __attribute__((ext_vector_type(8)));
typedef float f32x4 __attribute__((ext_vector_type(4)));
typedef unsigned u32x4 __attribute__((ext_vector_type(4)));
typedef int v8i_t __attribute__((ext_vector_type(8)));
typedef int v4i_t __attribute__((ext_vector_type(4)));
constexpr int BM = 256, BK = 64, HALF = 128, HTB = HALF * BK * 2  , STAGE_BYTES = 8 * HTB, NXCD = 8, WGM = 8;

__host__ __device__ __forceinline__ int lds_byte(int r, int c) { const int st = (r >> 4) * 2 + (c >> 5), rr = r & 15, cc = c & 31, ob = rr * 64 + cc * 2; return st * 1024 + (ob ^ (((ob >> 9) & 1) << 5)); }
__host__ __device__ __forceinline__ void stage_rc(int b, int& R, int& C) { const int st = b / 1024, sb = b % 1024, swz = sb ^ (((sb >> 9) & 1) << 5); R = (st >> 1) * 16 + swz / 64; C = (st & 1) * 32 + (swz % 64) / 2; }
__host__ __device__ __forceinline__ int perm32(int rho) { const int n = rho >> 4, i = rho & 15; return 8 * (i >> 2) + 4 * n + (i & 3); }

struct Unit { int pm, pn; };
struct Gemm { const bf16_t* A; const bf16_t* Bt; int M, N, K; int lda; };

struct StaticOrder {
    int nM, nN, nwg, G, c;
    __host__ __device__ void init(int M, int N, int G_, int c_) { nM = M / BM; nN = N / BM; nwg = nM * nN; G = G_; c = c_; }
    __host__ __device__ bool next(int i, Unit& u) const {
        const long L = (long)i * G + c; if (L >= nwg) return false;
        int wgid = (int)L; { const int q = nwg / NXCD, r = nwg % NXCD, xcd = wgid % NXCD, off = wgid / NXCD; wgid = (xcd < r ? xcd * (q + 1) : r * (q + 1) + (xcd - r) * q) + off; }
        const int nig = WGM * nN, gid = wgid / nig, fm = gid * WGM, gsz = (nM - fm) < WGM ? (nM - fm) : WGM;
        u.pm = fm + ((wgid % nig) % gsz); u.pn = (wgid % nig) / gsz; return true;
    }
    __device__ __forceinline__ void a_ready(const Unit&) const {}
    __device__ __forceinline__ void done(const Unit&) const {}
};
__device__ __forceinline__ unsigned cvt_pk_bf16(float lo, float hi) { unsigned r; asm volatile("v_cvt_pk_bf16_f32 %0, %1, %2" : "=v"(r) : "v"(lo), "v"(hi)); return r; }
typedef float f32x2 __attribute__((ext_vector_type(2)));
template <class Epi, class Sched, bool STAMP = false>
__device__ __forceinline__ void gemm_phase(const int WID, PG8_LAS unsigned char* lds, const Gemm g, const Sched& S, const Epi& E, unsigned long long* stamps) {
    const int tid = lt(), wid = __builtin_amdgcn_readfirstlane(tid >> 6), lane = tid & 63, wr = wid >> 2, wc = wid & 3, fr = lane & 15, fq = lane >> 4;
    const int K = g.K, nt = K / BK, lda = Epi::FP8 ? g.lda : K;
    int ts_lo = 0, ts_hi = 0, nts = 0; const unsigned long long rt_entry = STAMP ? (unsigned long long)wall_clock64() : 0ull;
#define PG8_STAMP() do { if (STAMP && wid == 0 && nts < 64) { const unsigned long long _c = (unsigned long long)clock64(); \
        ts_lo = (lane == nts) ? (int)(unsigned)_c : ts_lo; ts_hi = (lane == nts) ? (int)(unsigned)(_c >> 32) : ts_hi; ++nts; } } while (0)
    PG8_STAMP();
    unsigned voffA[2], voffB[2];
#pragma unroll
    for (int i = 0; i < 2; ++i) { int R, C; stage_rc(tid * 16 + i * 8192, R, C); const int Rb = Epi::PERM ? ((R & ~31) + perm32(R & 31)) : R;
        voffA[i] = (unsigned)(R * lda + C) * 2u; voffB[i] = (unsigned)(Rb * K + C) * 2u; }
    const size_t kstep = (size_t)(BK * 2);
    const size_t hstep = (size_t)HALF * K * 2;
    const size_t tstep = 2 * hstep;
    const size_t hstepA = (size_t)HALF * lda * 2, tstepA = 2 * hstepA;
    const unsigned ldsw = (unsigned)wid * 1024u;
    const int aoff = lds_byte(wr * 64 + fr, fq * 8), boff = lds_byte(wc * 32 + fr, fq * 8);
#define PG8_SA(b, h) (((b) * 2 + (h)) * HTB)
#define PG8_SB(b, h) ((4 + (b) * 2 + (h)) * HTB)
#define PG8_STAGE(bufoff, gbase, voff) do { _Pragma("unroll") for (int _i = 0; _i < 2; ++_i) \
        __builtin_amdgcn_global_load_lds((const unsigned*)(Epi::FP8 ? (const char*)(gbase) + (size_t)_i * ((voff) == voffA ? 128 * lda : 128 * K) + (voff)[0] : (const char*)(gbase) + (voff)[_i]), (PG8_LAS unsigned*)(lds + (bufoff) + ldsw + _i * 8192), 16, 0, 0); } while (0)
#define PG8_LDA(dst, b, h) do { if constexpr (Epi::FP8) { _Pragma("unroll") for (int m = 0; m < 4; ++m) dst##8[m] = __builtin_shufflevector(*(const PG8_LAS v4i_t*)(lds + PG8_SA(b, h) + aoff + m * 2048), *(const PG8_LAS v4i_t*)(lds + PG8_SA(b, h) + aoff + m * 2048 + 1024), 0, 1, 2, 3, 4, 5, 6, 7); } \
        else { _Pragma("unroll") for (int m = 0; m < 4; ++m) _Pragma("unroll") for (int k = 0; k < 2; ++k) dst[m][k] = *(const PG8_LAS bf16x8*)(lds + PG8_SA(b, h) + aoff + m * 2048 + k * 1024); } } while (0)
#define PG8_LDB(dst, b, h) do { if constexpr (Epi::FP8) { _Pragma("unroll") for (int n = 0; n < 2; ++n) dst##8[n] = __builtin_shufflevector(*(const PG8_LAS v4i_t*)(lds + PG8_SB(b, h) + boff + n * 2048), *(const PG8_LAS v4i_t*)(lds + PG8_SB(b, h) + boff + n * 2048 + 1024), 0, 1, 2, 3, 4, 5, 6, 7); } \
        else { _Pragma("unroll") for (int n = 0; n < 2; ++n) _Pragma("unroll") for (int k = 0; k < 2; ++k) dst[n][k] = *(const PG8_LAS bf16x8*)(lds + PG8_SB(b, h) + boff + n * 2048 + k * 1024); } } while (0)
#define PG8_MMA(ai, bj, At, Bt) do { __builtin_amdgcn_s_setprio(1); _Pragma("unroll") for (int m = 0; m < 4; ++m) _Pragma("unroll") for (int n = 0; n < 2; ++n) { \
        if constexpr (Epi::FP8) {   \
            acc[ai][bj][m][n] = __builtin_amdgcn_mfma_scale_f32_16x16x128_f8f6f4(Bt##8[n], At##8[m], acc[ai][bj][m][n], 0, 0, 0, 0, 0, 0); \
        } else { _Pragma("unroll") for (int k = 0; k < 2; ++k) acc[ai][bj][m][n] = __builtin_amdgcn_mfma_f32_16x16x32_bf16(Bt[n][k], At[m][k], acc[ai][bj][m][n], 0, 0, 0); } \
        } __builtin_amdgcn_s_setprio(0); } while (0)
#define PG8_WAIT_V(n) asm volatile("s_waitcnt vmcnt(" #n ")" ::: "memory")
#define PG8_WAIT_L(n) asm volatile("s_waitcnt lgkmcnt(" #n ")" ::: "memory")
#define PG8_BAR __builtin_amdgcn_s_barrier()
#define PG8_SCHED __builtin_amdgcn_sched_barrier(0)
    Unit cur, nxt; int ui = 0;
    if (!S.next(0, cur)) return;
    f32x4 acc[2][2][4][2];
#pragma unroll
    for (int a = 0; a < 2; ++a)
#pragma unroll
        for (int b = 0; b < 2; ++b)
#pragma unroll
            for (int m = 0; m < 4; ++m)
#pragma unroll
                for (int n = 0; n < 2; ++n) acc[a][b][m][n] = (f32x4){0.f, 0.f, 0.f, 0.f};
    bf16x8 At[4][2], B0[2][2], B1[2][2];
    v8i_t At8[4], B08[2], B18[2];
    const char* cA = (const char*)g.A + (size_t)cur.pm * tstepA; const char* cB = (const char*)g.Bt + (size_t)cur.pn * tstep;
    S.a_ready(cur);
    PG8_STAGE(PG8_SB(0, 0), cB, voffB); PG8_STAGE(PG8_SA(0, 0), cA, voffA); PG8_STAGE(PG8_SB(0, 1), cB + hstep, voffB); PG8_STAGE(PG8_SA(0, 1), cA + hstepA, voffA);
    if (wr == 1) PG8_BAR;
    PG8_WAIT_V(4); PG8_BAR;
    PG8_STAGE(PG8_SB(1, 0), cB + kstep, voffB); PG8_STAGE(PG8_SA(1, 0), cA + kstep, voffA); PG8_STAGE(PG8_SB(1, 1), cB + hstep + kstep, voffB);
    PG8_WAIT_V(6); PG8_BAR;
    PG8_STAMP();
    for (;;) {
        const bool has_next = S.next(ui + 1, nxt);
        const char* nA = has_next ? (const char*)g.A + (size_t)nxt.pm * tstepA : cA; const char* nB = has_next ? (const char*)g.Bt + (size_t)nxt.pn * tstep : cB;
        for (int t = 0; t < nt; t += 2) {
            const bool last = (t == nt - 2);
            const char* a1 = cA + (size_t)(t + 1) * kstep;
            const char* a2 = last ? nA : cA + (size_t)(t + 2) * kstep; const char* b2 = last ? nB : cB + (size_t)(t + 2) * kstep;
            const char* a3 = a2 + kstep; const char* b3 = b2 + kstep;
            if (last && has_next) S.a_ready(nxt);
            PG8_LDB(B0, 0, 0); PG8_SCHED; PG8_LDA(At, 0, 0); PG8_STAGE(PG8_SA(1, 1), a1 + hstepA, voffA);
            PG8_WAIT_L(8); PG8_BAR; PG8_WAIT_L(0); PG8_MMA(0, 0, At, B0); PG8_BAR; PG8_SCHED;
            PG8_LDB(B1, 0, 1); PG8_STAGE(PG8_SB(0, 0), b2, voffB);
            PG8_BAR; PG8_WAIT_L(0); PG8_MMA(0, 1, At, B1); PG8_BAR;
            PG8_LDA(At, 0, 1); PG8_STAGE(PG8_SA(0, 0), a2, voffA);
            PG8_BAR; PG8_WAIT_L(0); PG8_MMA(1, 0, At, B0); PG8_BAR; PG8_SCHED;
            PG8_STAGE(PG8_SB(0, 1), b2 + hstep, voffB);
            PG8_WAIT_V(6); PG8_BAR; PG8_MMA(1, 1, At, B1); PG8_BAR;
            PG8_LDB(B0, 1, 0); PG8_SCHED; PG8_LDA(At, 1, 0); PG8_STAGE(PG8_SA(0, 1), a2 + hstepA, voffA);
            PG8_WAIT_L(8); PG8_BAR; PG8_WAIT_L(0); PG8_MMA(0, 0, At, B0); PG8_BAR; PG8_SCHED;
            PG8_LDB(B1, 1, 1); PG8_STAGE(PG8_SB(1, 0), b3, voffB);
            PG8_BAR; PG8_WAIT_L(0); PG8_MMA(0, 1, At, B1); PG8_BAR;
            PG8_LDA(At, 1, 1); PG8_STAGE(PG8_SA(1, 0), a3, voffA);
            PG8_BAR; PG8_WAIT_L(0); PG8_MMA(1, 0, At, B0); PG8_BAR; PG8_SCHED;
            PG8_STAGE(PG8_SB(1, 1), b3 + hstep, voffB);
            PG8_WAIT_V(6); PG8_BAR; PG8_MMA(1, 1, At, B1); PG8_BAR;
        }
        PG8_STAMP();
        if constexpr (!Epi::AFTER_DRAIN) { E(acc, cur, wr, wc, fr, fq); S.done(cur); }
        PG8_STAMP();
        if (!has_next) break;
#pragma unroll
        for (int a = 0; a < 2; ++a)
#pragma unroll
            for (int b = 0; b < 2; ++b)
#pragma unroll
                for (int m = 0; m < 4; ++m)
#pragma unroll
                    for (int n = 0; n < 2; ++n) acc[a][b][m][n] = (f32x4){0.f, 0.f, 0.f, 0.f};
        cur = nxt; cA = nA; cB = nB; ++ui;
    }
    PG8_WAIT_V(0);
    if (wr == 0) PG8_BAR;
    PG8_BAR;
    if constexpr (Epi::AFTER_DRAIN) { E.fused(acc, cur, wr, wc, fr, fq, lds, wid, lane); S.done(cur); }
    PG8_STAMP();
    if (STAMP && wid == 0) { stamps[lane] = lane < nts ? (((unsigned long long)(unsigned)ts_hi << 32) | (unsigned)ts_lo) : 0ull;
        if (lane == 62) stamps[62] = rt_entry; if (lane == 63) stamps[63] = (unsigned long long)wall_clock64(); }
#undef PG8_STAMP
#undef PG8_SA
#undef PG8_SB
#undef PG8_STAGE
#undef PG8_LDA
#undef PG8_LDB
#undef PG8_MMA
#undef PG8_WAIT_V
#undef PG8_WAIT_L
#undef PG8_BAR
#undef PG8_SCHED
}
}

using pg8::Unit;
using pg8::cvt_pk_bf16;

template <int PART> struct EpiIn {
  static constexpr bool PERM = true, AFTER_DRAIN = false, FP8 = true;
  unsigned char* rb;
  __device__ __forceinline__ void operator()(const f32x4 (&acc)[2][2][4][2], const Unit& u, int wr, int wc, int fr, int fq) const {
    constexpr int ldc = PART == 0 ? 512 : 256;
    bf16_t* base = PART == 0 ? (bf16_t*)(rb + (size_t)(u.pn >> 1) * 32 * MiB) + (u.pn & 1) * 256 : (bf16_t*)(rb + B_S5U + (size_t)u.pn * 16 * MiB);
    const int row0 = u.pm * 256 + wr * 64 + fr, col0 = wc * 32 + 8 * fq;
#pragma unroll
    for (int ai = 0; ai < 2; ++ai)
#pragma unroll
      for (int m = 0; m < 4; ++m) {
        bf16_t* rowp = base + (size_t)(row0 + ai * 128 + m * 16) * ldc + col0;
#pragma unroll
        for (int bj = 0; bj < 2; ++bj) {
          const f32x4 v0 = acc[ai][bj][m][0], v1 = acc[ai][bj][m][1];
          u32x4 w; w.x = cvt_pk_bf16(v0[0], v0[1]); w.y = cvt_pk_bf16(v0[2], v0[3]); w.z = cvt_pk_bf16(v1[0], v1[1]); w.w = cvt_pk_bf16(v1[2], v1[3]);
          *(u32x4*)(rowp + bj * 128) = w;
        }
      }
  }
};
struct EpiGlu {
  static constexpr bool PERM = false, AFTER_DRAIN = false, FP8 = false;
  bf16_t* out; const float* bias;
  __device__ __forceinline__ void operator()(const f32x4 (&acc)[2][2][4][2], const Unit& u, int wr, int wc, int fr, int fq) const {
    const int row0 = u.pm * 256 + wr * 64 + fr, J0 = 128 * u.pn + 16 * wc + 4 * fq;
#pragma unroll
    for (int ai = 0; ai < 2; ++ai)
#pragma unroll
      for (int m = 0; m < 4; ++m) {
        const int row = row0 + ai * 128 + m * 16;
#pragma unroll
        for (int bj = 0; bj < 2; ++bj) {
          const int J = J0 + 64 * bj;
          const f32x4 a = acc[ai][bj][m][0] + *(const f32x4*)(bias + J);
          const f32x4 b = acc[ai][bj][m][1] + *(const f32x4*)(bias + 256 + J);
          u32x2 w; w.x = cvt_pk_bf16(a[0] * sigmoid_f(b[0]), a[1] * sigmoid_f(b[1])); w.y = cvt_pk_bf16(a[2] * sigmoid_f(b[2]), a[3] * sigmoid_f(b[3]));
          *(u32x2*)(out + (size_t)row * 256 + J) = w;
        }
      }
  }
};
__device__ __forceinline__ unsigned pk4u8(float a, float b, float c, float d) {
  const unsigned ua = __float_as_uint(__builtin_fmaf(a, 255.f, 8388608.f)), ub = __float_as_uint(__builtin_fmaf(b, 255.f, 8388608.f));
  const unsigned uc = __float_as_uint(__builtin_fmaf(c, 255.f, 8388608.f)), ud = __float_as_uint(__builtin_fmaf(d, 255.f, 8388608.f));
  return __builtin_amdgcn_perm(ub, ua, 0x0c0c0400u) | __builtin_amdgcn_perm(ud, uc, 0x04000c0cu);
}
__device__ __forceinline__ float ub8(unsigned w, int k) { return (float)((w >> (8 * k)) & 0xffu); }
__device__ __forceinline__ float sig64_f(float x) { return __builtin_amdgcn_rcpf(1.f + __builtin_amdgcn_exp2f(x * -0.09016844f)); }
struct EpiGate {
  static constexpr bool PERM = true, AFTER_DRAIN = false, FP8 = true;
  bf16_t* S;
  __device__ __forceinline__ void operator()(const f32x4 (&acc)[2][2][4][2], const Unit& u, int wr, int wc, int fr, int fq) const {
    u32x4* base = (u32x4*)S + (size_t)(u.pm * 4 + u.pn) * 4096 + (((wr * 4 + wc) << 6) | (fq << 4) | fr);
#pragma unroll
    for (int ai = 0; ai < 2; ++ai)
#pragma unroll
      for (int m = 0; m < 4; ++m) {
        u32x4 w;
#pragma unroll
        for (int bj = 0; bj < 2; ++bj) {
          const f32x4 v0 = acc[ai][bj][m][0], v1 = acc[ai][bj][m][1];
          int q0 = __builtin_amdgcn_cvt_pk_fp8_f32(v0[0], v0[1], 0, false); q0 = __builtin_amdgcn_cvt_pk_fp8_f32(v0[2], v0[3], q0, true);
          int q1 = __builtin_amdgcn_cvt_pk_fp8_f32(v1[0], v1[1], 0, false); q1 = __builtin_amdgcn_cvt_pk_fp8_f32(v1[2], v1[3], q1, true);
          w[2 * bj] = (unsigned)q0; w[2 * bj + 1] = (unsigned)q1;
        }
        base[(ai * 4 + m) * 512] = w;
      }
  }
};
template <bool FIRST> struct EpiMerge {
  static constexpr bool PERM = true, AFTER_DRAIN = false, FP8 = false;
  const bf16_t* S; bf16_t* Mg;
  __device__ __forceinline__ void operator()(const f32x4 (&acc)[2][2][4][2], const Unit& u, int wr, int wc, int fr, int fq) const {
    const int row0 = u.pm * 256 + wr * 64 + fr, col0 = u.pn * 256 + wc * 32 + 8 * fq;
#pragma unroll
    for (int ai = 0; ai < 2; ++ai) {
      u32x4 sv[4], qv[4][2];
      const u32x4* sbase = (const u32x4*)S + (size_t)(u.pm * 4 + u.pn) * 4096 + (((wr * 4 + wc) << 6) | (fq << 4) | fr);
#pragma unroll
      for (int m = 0; m < 4; ++m) {
        sv[m] = sbase[(ai * 4 + m) * 512];
#pragma unroll
        for (int bj = 0; bj < 2; ++bj) {
          const size_t off = (size_t)(row0 + ai * 128 + m * 16) * 1024 + col0 + bj * 128;
          if (!FIRST) qv[m][bj] = *(const u32x4*)(Mg + off);
        }
      }
      __builtin_amdgcn_sched_barrier(0);
#pragma unroll
      for (int m = 0; m < 4; ++m)
#pragma unroll
        for (int bj = 0; bj < 2; ++bj) {
          const size_t off = (size_t)(row0 + ai * 128 + m * 16) * 1024 + col0 + bj * 128;
          const f32x4 v0 = acc[ai][bj][m][0], v1 = acc[ai][bj][m][1];
          const int za = (int)(bj ? sv[m].z : sv[m].x), zb = (int)(bj ? sv[m].w : sv[m].y);
          const f32x2 z0 = __builtin_amdgcn_cvt_pk_f32_fp8(za, false), z1 = __builtin_amdgcn_cvt_pk_f32_fp8(za, true), z2 = __builtin_amdgcn_cvt_pk_f32_fp8(zb, false), z3 = __builtin_amdgcn_cvt_pk_f32_fp8(zb, true);
          float r[8];
          r[0] = sig64_f(z0[0]) * v0[0]; r[1] = sig64_f(z0[1]) * v0[1]; r[2] = sig64_f(z1[0]) * v0[2]; r[3] = sig64_f(z1[1]) * v0[3];
          r[4] = sig64_f(z2[0]) * v1[0]; r[5] = sig64_f(z2[1]) * v1[1]; r[6] = sig64_f(z3[0]) * v1[2]; r[7] = sig64_f(z3[1]) * v1[3];
          if (!FIRST) {
            const u32x4 q = qv[m][bj];
            r[0] += bflo(q.x); r[1] += bfhi(q.x); r[2] += bflo(q.y); r[3] += bfhi(q.y); r[4] += bflo(q.z); r[5] += bfhi(q.z); r[6] += bflo(q.w); r[7] += bfhi(q.w);
          }
          u32x4 w; w.x = cvt_pk_bf16(r[0], r[1]); w.y = cvt_pk_bf16(r[2], r[3]); w.z = cvt_pk_bf16(r[4], r[5]); w.w = cvt_pk_bf16(r[6], r[7]);
          *(u32x4*)(Mg + off) = w;
        }
      __builtin_amdgcn_sched_barrier(0);
    }
  }
};
template <bool XB_IN> struct EpiOut {
  static constexpr bool PERM = true, AFTER_DRAIN = false, FP8 = false;
  const float* xs; float* x; const float* g; bool dry;
  __device__ __forceinline__ void operator()(const f32x4 (&acc)[2][2][4][2], const Unit& u, int wr, int wc, int fr, int fq) const {
    const int row0 = u.pm * 256 + wr * 64 + fr, col0 = u.pn * 256 + wc * 32 + 8 * fq;
    const float* gb = g + (size_t)((u.pm * 256) >> 12) * 6144;
    bf16_t* xb = (bf16_t*)x;
    const bf16_t* xsb = (const bf16_t*)xs;
    f32x4 gv[2][2];
#pragma unroll
    for (int bj = 0; bj < 2; ++bj)
#pragma unroll
      for (int n = 0; n < 2; ++n) gv[bj][n] = *(const f32x4*)(gb + col0 + bj * 128 + n * 4);
#pragma unroll
    for (int ai = 0; ai < 2; ++ai)
#pragma unroll
      for (int mh = 0; mh < 2; ++mh) {
        f32x4 xv[2][2][2];
        u32x4 xw[2][2];
#pragma unroll
        for (int mm = 0; mm < 2; ++mm)
#pragma unroll
          for (int bj = 0; bj < 2; ++bj) {
            const size_t row = (size_t)(row0 + ai * 128 + (mh * 2 + mm) * 16);
            if (XB_IN) xw[mm][bj] = *(const u32x4*)(xsb + row * 2048 + col0 + bj * 128);
            else {
#pragma unroll
              for (int n = 0; n < 2; ++n) xv[mm][bj][n] = *(const f32x4*)(xs + row * 1024 + col0 + bj * 128 + n * 4);
            }
          }
        __builtin_amdgcn_sched_barrier(0);
#pragma unroll
        for (int mm = 0; mm < 2; ++mm)
#pragma unroll
          for (int bj = 0; bj < 2; ++bj) {
            const size_t row = (size_t)(row0 + ai * 128 + (mh * 2 + mm) * 16);
            f32x4 x0, x1;
            if (XB_IN) { const u32x4 q = xw[mm][bj]; x0 = (f32x4){bflo(q.x), bfhi(q.x), bflo(q.y), bfhi(q.y)}; x1 = (f32x4){bflo(q.z), bfhi(q.z), bflo(q.w), bfhi(q.w)}; }
            else { x0 = xv[mm][bj][0]; x1 = xv[mm][bj][1]; }
            const f32x4 n0 = x0 + gv[bj][0] * acc[ai][bj][mh * 2 + mm][0], n1 = x1 + gv[bj][1] * acc[ai][bj][mh * 2 + mm][1];
            u32x4 w; w.x = cvt_pk_bf16(n0[0], n0[1]); w.y = cvt_pk_bf16(n0[2], n0[3]); w.z = cvt_pk_bf16(n1[0], n1[1]); w.w = cvt_pk_bf16(n1[2], n1[3]);
            u32x4* pp = (u32x4*)(xb + row * 2048 + col0 + bj * 128);
            if (!dry) *pp = w; else if (n0[0] == 1.2345e30f) *pp = w;
          }
        __builtin_amdgcn_sched_barrier(0);
      }
  }
};
struct EpiScore {
  static constexpr bool PERM = true, AFTER_DRAIN = false, FP8 = false;
  unsigned short* sc;
  __device__ __forceinline__ void operator()(const f32x4 (&acc)[2][2][4][2], const Unit& u, int wr, int wc, int fr, int fq) const {
    const int row0 = u.pm * 256 + wr * 64 + fr, col0 = u.pn * 256 + wc * 32 + 8 * fq;
#pragma unroll
    for (int ai = 0; ai < 2; ++ai)
#pragma unroll
      for (int m = 0; m < 4; ++m) {
        unsigned short* rowp = sc + (size_t)(row0 + ai * 128 + m * 16) * 2048 + col0;
#pragma unroll
        for (int bj = 0; bj < 2; ++bj) {
          const f32x4 v0 = acc[ai][bj][m][0], v1 = acc[ai][bj][m][1];
          u32x4 w;
          w.x = (unsigned)f2h(v0[0]) | ((unsigned)f2h(v0[1]) << 16); w.y = (unsigned)f2h(v0[2]) | ((unsigned)f2h(v0[3]) << 16);
          w.z = (unsigned)f2h(v1[0]) | ((unsigned)f2h(v1[1]) << 16); w.w = (unsigned)f2h(v1[2]) | ((unsigned)f2h(v1[3]) << 16);
          *(u32x4*)(rowp + bj * 128) = w;
        }
      }
  }
};

template <class Epi>
__device__ __forceinline__ void run_gemm(const int WID, unsigned char* lds, const bf16_t* A, const bf16_t* Bt, int M, int N, int K, const Epi& E, int lda = 0) {
  pg8::Gemm g{A, Bt, M, N, K, lda};
  pg8::StaticOrder S; S.init(M, N, (int)gridDim.x, (int)blockIdx.x);
  pg8::gemm_phase<Epi, pg8::StaticOrder>(WID, (PG8_LAS unsigned char*)lds, g, S, E, nullptr);
  __syncthreads();
}

__device__ __forceinline__ void phase_mod(const int WID, KP p, unsigned char* lds) {
  const int tid = lt();
  float* sc = (float*)lds;
  float* red = sc + 8192;
  const float* c = p->in[I_C];
  for (int i = tid; i < 8192; i += NTHR) sc[i] = silu_f(c[i]);
  __syncthreads();
  float* mod = (float*)(p->ws + WS_MISC + MISC_MOD);
  for (int task = blockIdx.x; task < 192; task += gridDim.x) {
    const int l = task / 96, j0 = (task % 96) * 64, col = tid & 63, ip = tid >> 6;
    const float* w = p->in[I_ADAW] + (size_t)l * 1024 * 6144 + j0 + col;
    float acc[8];
#pragma unroll
    for (int b = 0; b < 8; ++b) acc[b] = 0.f;
#pragma unroll 16
    for (int i = ip * 128; i < ip * 128 + 128; ++i) {
      const float wv = w[(size_t)i * 6144];
#pragma unroll
      for (int b = 0; b < 8; ++b) acc[b] += sc[b * 1024 + i] * wv;
    }
#pragma unroll
    for (int b = 0; b < 8; ++b) red[(ip * 8 + b) * 64 + col] = acc[b];
    __syncthreads();
    {
      const int b = ip; float s = 0.f;
#pragma unroll
      for (int q = 0; q < 8; ++q) s += red[(q * 8 + b) * 64 + col];
      mod[((size_t)l * 8 + b) * 6144 + j0 + col] = s + p->in[I_ADAB][l * 6144 + j0 + col];
    }
    __syncthreads();
  }
  if (blockIdx.x == 0 && tid < 64) ((unsigned*)(p->ws + WS_MISC + MISC_CTR))[tid] = 0u;
}

template <bool XB = false>
__device__ __forceinline__ void phase_norm(const int WID, const float* xsrc, float* xcopy, const float* nw, const float* modl, int sh_off, int sc_off,
                           bf16_t* h, const float* w_in_l, float* ba, unsigned char* lds, const int ntok = TOK, unsigned char* h8 = nullptr) {
  const int tid = lt(), wave = tid >> 6, lane = tid & 63;
  float* w8 = (float*)lds;
  if (ba) {
    for (int i = tid; i < 8192; i += NTHR) w8[i] = w_in_l[(size_t)(i >> 3) * IN_COLS + 2048 + (i & 7)];
    __syncthreads();
  }
  for (int t = blockIdx.x * 8 + wave; t < ntok; t += gridDim.x * 8) {
    const int b = t >> 12;
    f32x4 v[4];
    float ss = 0.f;
#pragma unroll
    for (int i = 0; i < 4; ++i) {
      if (XB) { const u32x2 xw = *(const u32x2*)((const bf16_t*)xsrc + (size_t)t * 2048 + i * 256 + lane * 4); v[i] = (f32x4){bflo(xw.x), bfhi(xw.x), bflo(xw.y), bfhi(xw.y)}; }
      else v[i] = *(const f32x4*)(xsrc + (size_t)t * 1024 + i * 256 + lane * 4);
      ss += v[i][0] * v[i][0] + v[i][1] * v[i][1] + v[i][2] * v[i][2] + v[i][3] * v[i][3];
      if (xcopy) *(f32x4*)(xcopy + (size_t)t * 1024 + i * 256 + lane * 4) = v[i];
    }
    ss = WSUM(ss);
    const float r = rsqrtf(ss * (1.f / 1024.f) + 1e-6f);
    float a8[8];
#pragma unroll
    for (int j = 0; j < 8; ++j) a8[j] = 0.f;
#pragma unroll
    for (int i = 0; i < 4; ++i) {
      const int c = i * 256 + lane * 4;
      const f32x4 w4 = *(const f32x4*)(nw + c);
      const f32x4 sc4 = *(const f32x4*)(modl + (size_t)b * 6144 + sc_off + c);
      const f32x4 sh4 = *(const f32x4*)(modl + (size_t)b * 6144 + sh_off + c);
      const f32x4 hv = v[i] * r * w4 * (sc4 + 1.f) + sh4;
      u32x2 w; w.x = pk2bf(hv[0], hv[1]); w.y = pk2bf(hv[2], hv[3]);
      *(u32x2*)(h + (size_t)t * 1024 + c) = w;
      if (h8) { int q = __builtin_amdgcn_cvt_pk_fp8_f32(hv[0], hv[1], 0, false); q = __builtin_amdgcn_cvt_pk_fp8_f32(hv[2], hv[3], q, true); *(int*)(h8 + (size_t)t * 4096 + c) = q; }
      if (ba) {
#pragma unroll
        for (int k = 0; k < 4; ++k)
#pragma unroll
          for (int j = 0; j < 8; ++j) a8[j] += hv[k] * w8[(c + k) * 8 + j];
      }
    }
    if (ba) {
      const float tot = reduce8(a8, lane);
      if ((lane & 7) == 0) ba[(size_t)t * 8 + ((lane >> 5) & 1) * 4 + ((lane >> 4) & 1) * 2 + ((lane >> 3) & 1)] = tot;
    }
  }
  __syncthreads();
}

__device__ __forceinline__ int wsrc_col(int kind, int r) {
  if (kind == 0) return r < 2048 ? r : r + 8;
  if (kind == 1) return 3080 + r;
  if (kind == 3) { const int n = (r >> 4) & 1; const int J = ((r >> 8) << 7) | (((r >> 7) & 1) << 6) | (((r >> 5) & 3) << 4) | (((r >> 2) & 3) << 2) | (r & 3); return n * 256 + J; }
  return r;
}
__device__ __forceinline__ void conv_T(const int WID, const float* src, int ld, int K, int N, bf16_t* dst, int kind, unsigned char* lds) {
  const int tid = lt();
  float* tile = (float*)lds;
  const int ntk = K / 64, nt = (N / 64) * ntk;
  for (int tl = blockIdx.x; tl < nt; tl += gridDim.x) {
    const int n0 = (tl / ntk) * 64, k0 = (tl % ntk) * 64;
#pragma unroll
    for (int i = 0; i < 8; ++i) {
      const int idx = tid + NTHR * i, kk = idx >> 6, nn = idx & 63;
      tile[kk * 65 + nn] = src[(size_t)(k0 + kk) * ld + wsrc_col(kind, n0 + nn)];
    }
    __syncthreads();
#pragma unroll
    for (int i = 0; i < 4; ++i) {
      const int idx = tid + NTHR * i, nn = idx >> 5, k2 = (idx & 31) * 2;
      *(unsigned*)(dst + (size_t)(n0 + nn) * K + k0 + k2) = pk2bf(tile[k2 * 65 + nn], tile[(k2 + 1) * 65 + nn]);
    }
    __syncthreads();
  }
}
__device__ __forceinline__ void conv_T8(const int WID, const float* src, int ld, int K, int N, unsigned char* dst, int kind, float scale, unsigned char* lds) {
  const int tid = lt();
  float* tile = (float*)lds;
  const int ntk = K / 64, nt = (N / 64) * ntk;
  for (int tl = blockIdx.x; tl < nt; tl += gridDim.x) {
    const int n0 = (tl / ntk) * 64, k0 = (tl % ntk) * 64;
#pragma unroll
    for (int i = 0; i < 8; ++i) {
      const int idx = tid + NTHR * i, kk = idx >> 6, nn = idx & 63;
      tile[kk * 65 + nn] = src[(size_t)(k0 + kk) * ld + wsrc_col(kind, n0 + nn)] * scale;
    }
    __syncthreads();
#pragma unroll
    for (int i = 0; i < 2; ++i) {
      const int idx = tid + NTHR * i, nn = idx >> 4, k4 = (idx & 15) * 4;
      int w = __builtin_amdgcn_cvt_pk_fp8_f32(tile[k4 * 65 + nn], tile[(k4 + 1) * 65 + nn], 0, false);
      w = __builtin_amdgcn_cvt_pk_fp8_f32(tile[(k4 + 2) * 65 + nn], tile[(k4 + 3) * 65 + nn], w, true);
      *(int*)(dst + (size_t)(n0 + nn) * K + k0 + k4) = w;
    }
    __syncthreads();
  }
}
__device__ __forceinline__ void phase_weff(const int WID, const float* wq, const float* k1, const float* k2, bf16_t* WeffT, unsigned char* lds) {
  const int tid = lt();
  float* wt = (float*)lds;
  float* kt = wt + 64 * 129;
  for (int task = blockIdx.x; task < 256; task += gridDim.x) {
    const int hh = task >> 4, it = task & 15, hd = hh >> 1, half = hh & 1, i0 = it * 64;
    const float* kp = (half ? k2 : k1) + (size_t)hd * 128 * 128;
    for (int idx = tid; idx < 64 * 128; idx += NTHR) { const int i = idx >> 7, d = idx & 127; wt[i * 129 + d] = wq[(size_t)(i0 + i) * 2048 + hd * 256 + half * 128 + d]; }
    for (int idx = tid; idx < 128 * 128; idx += NTHR) { const int n = idx >> 7, d = idx & 127; kt[n * 129 + d] = kp[n * 128 + d]; }
    __syncthreads();
    const int i = tid & 63, ng = tid >> 6;
    float acc[16];
#pragma unroll
    for (int j = 0; j < 16; ++j) acc[j] = 0.f;
    for (int d = 0; d < 128; ++d) {
      const float wv = wt[i * 129 + d];
#pragma unroll
      for (int j = 0; j < 16; ++j) acc[j] += wv * kt[(ng * 16 + j) * 129 + d];
    }
#pragma unroll
    for (int j = 0; j < 16; ++j) WeffT[(size_t)(hh * 128 + ng * 16 + j) * 1024 + i0 + i] = f2bf(acc[j]);
    __syncthreads();
  }
}
__device__ __forceinline__ void phase_convert_weights(const int WID, KP p, int l, unsigned char* lds) {
  unsigned char* W = p->ws + WS_W;
  const float* w_in = p->in[I_WIN] + (size_t)l * 1024 * IN_COLS;
  conv_T8(WID, w_in, IN_COLS, 1024, 3072, W + W_IN, 0, 1.f, lds);
  conv_T8(WID, w_in, IN_COLS, 1024, 3072, W + W_G, 1, 16.f, lds);
  conv_T(WID, p->in[I_WBA] + (size_t)l * 512 * 1024, 1024, 512, 1024, (bf16_t*)(W + W_A), 2, lds);
  conv_T(WID, p->in[I_WBB] + (size_t)l * 256 * 1024, 1024, 256, 1024, (bf16_t*)(W + W_B), 2, lds);
  conv_T(WID, p->in[I_WBC] + (size_t)l * 256 * 1024, 1024, 256, 1024, (bf16_t*)(W + W_C), 2, lds);
  conv_T(WID, p->in[I_WOUT] + (size_t)l * 1024 * 1024, 1024, 1024, 1024, (bf16_t*)(W + W_OUT), 2, lds);
  conv_T(WID, p->in[I_GLUW] + (size_t)l * 256 * 512, 512, 256, 512, (bf16_t*)(W + W_GLU), 3, lds);
}
__device__ __forceinline__ void conv_flat(const int WID, const float* src, bf16_t* dst, size_t n) {
  const size_t stride = (size_t)gridDim.x * NTHR * 8;
  for (size_t i = ((size_t)blockIdx.x * NTHR + lt()) * 8; i < n; i += stride) {
    const f32x4 a = *(const f32x4*)(src + i), b = *(const f32x4*)(src + i + 4);
    u32x4 w; w.x = pk2bf(a[0], a[1]); w.y = pk2bf(a[2], a[3]); w.z = pk2bf(b[0], b[1]); w.w = pk2bf(b[2], b[3]);
    *(u32x4*)(dst + i) = w;
  }
}

__device__ __forceinline__ void gdn_prep_naive(const int WID, KP p, int l) {
  const int tid = lt(), wave = tid >> 6, lane = tid & 63;
  const bf16_t* gsrc[3] = {(const bf16_t*)(p->ws + WS_B + B_GQ), (const bf16_t*)(p->ws + WS_B + B_GK), (const bf16_t*)(p->ws + WS_B + B_GV)};
  bf16_t* gdst[3] = {(bf16_t*)(p->ws + WS_C + C_QH), (bf16_t*)(p->ws + WS_C + C_KH), (bf16_t*)(p->ws + WS_C + C_VV)};
  const float* ba = (const float*)(p->ws + WS_B + B_BA);
  float* beta = (float*)(p->ws + WS_C + C_BETA);
  float* gg = (float*)(p->ws + WS_C + C_G);
  const float* convw = p->in[I_CONVW] + (size_t)l * 4 * 1536;
  for (int item = blockIdx.x * 8 + wave; item < TOK * 4; item += gridDim.x * 8) {
    const int t = item >> 2, hd = item & 3, tl = t & 4095;
    const int c = hd * 128 + lane * 2;
    float val[3][2];
#pragma unroll
    for (int part = 0; part < 3; ++part) {
      float a0 = 0.f, a1 = 0.f;
#pragma unroll
      for (int j = 0; j < 4; ++j) {
        if (tl - 3 + j >= 0) {
          const unsigned w = *(const unsigned*)(gsrc[part] + (size_t)(t - 3 + j) * 512 + c);
          a0 += convw[j * 1536 + part * 512 + c] * bflo(w);
          a1 += convw[j * 1536 + part * 512 + c + 1] * bfhi(w);
        }
      }
      val[part][0] = silu_f(a0); val[part][1] = silu_f(a1);
    }
    const float sq = WSUM(val[0][0] * val[0][0] + val[0][1] * val[0][1]);
    const float sk = WSUM(val[1][0] * val[1][0] + val[1][1] * val[1][1]);
    const float rq = rsqrtf(sq + 1e-6f) * 0.08838834764831845f, rk = rsqrtf(sk + 1e-6f);
    *(unsigned*)(gdst[0] + (size_t)t * 512 + c) = pk2bf(val[0][0] * rq, val[0][1] * rq);
    *(unsigned*)(gdst[1] + (size_t)t * 512 + c) = pk2bf(val[1][0] * rk, val[1][1] * rk);
    *(unsigned*)(gdst[2] + (size_t)t * 512 + c) = pk2bf(val[2][0], val[2][1]);
    if (lane == 0) {
      beta[(size_t)t * 4 + hd] = sigmoid_f(ba[(size_t)t * 8 + hd]);
      gg[(size_t)t * 4 + hd] = -expf(p->in[I_ALOG][l * 4 + hd]) * softplus_f(ba[(size_t)t * 8 + 4 + hd] + p->in[I_DTB][l * 4 + hd]);
    }
  }
}
__device__ __forceinline__ void moba_kmean(const int WID, KP p, unsigned char* lds) {
  const int tid = lt();
  float* red = (float*)lds;
  const bf16_t* mk = (const bf16_t*)(p->ws + WS_B + B_MK);
  float* kmean = (float*)(p->ws + WS_MISC + MISC_KMEAN);
  for (int task = blockIdx.x; task < 512; task += gridDim.x) {
    const int b = task >> 6, hd = (task >> 4) & 3, blk = task & 15;
    const int d = tid & 63, part = tid >> 6;
    float s = 0.f;
#pragma unroll 16
    for (int j = part * 32; j < part * 32 + 32; ++j) s += bf2f(mk[(size_t)(b * 4096 + blk * 256 + j) * 256 + hd * 64 + d]);
    red[part * 64 + d] = s;
    __syncthreads();
    if (tid < 64) { float a = 0.f; for (int q = 0; q < 8; ++q) a += red[q * 64 + tid]; kmean[(size_t)task * 64 + tid] = a * (1.f / 256.f); }
    __syncthreads();
  }
}
__device__ __forceinline__ void gdn_scan_naive(const int WID, KP p, unsigned char* lds) {
  const int tid = lt();
  float* part = (float*)lds;
  float* kq = part + 2 * 3 * 16 * 32;
  const bf16_t* qh = (const bf16_t*)(p->ws + WS_C + C_QH);
  const bf16_t* kh = (const bf16_t*)(p->ws + WS_C + C_KH);
  const bf16_t* vv = (const bf16_t*)(p->ws + WS_C + C_VV);
  const float* beta = (const float*)(p->ws + WS_C + C_BETA);
  const float* gg = (const float*)(p->ws + WS_C + C_G);
  bf16_t* go = (bf16_t*)(p->ws + WS_D + D_GA);
  const int v = tid & 31, kg = tid >> 5;
  for (int task = blockIdx.x; task < 128; task += gridDim.x) {
    const int b = task >> 4, hd = (task >> 2) & 3, vs = task & 3;
    float S[8];
#pragma unroll
    for (int i = 0; i < 8; ++i) S[i] = 0.f;
    for (int t = 0; t < SEQ; ++t) {
      const size_t tok = (size_t)b * 4096 + t;
      const int pb = t & 1;
      if (tid < 128) kq[(pb * 2 + 0) * 128 + tid] = bf2f(kh[tok * 512 + hd * 128 + tid]);
      else if (tid < 256) kq[(pb * 2 + 1) * 128 + tid - 128] = bf2f(qh[tok * 512 + hd * 128 + tid - 128]);
      __syncthreads();
      float ks = 0.f, qs = 0.f, qk = 0.f;
#pragma unroll
      for (int i = 0; i < 8; ++i) {
        const float kk = kq[(pb * 2 + 0) * 128 + kg * 8 + i], qq = kq[(pb * 2 + 1) * 128 + kg * 8 + i];
        ks += kk * S[i]; qs += qq * S[i]; qk += kk * qq;
      }
      part[((pb * 3 + 0) * 16 + kg) * 32 + v] = ks;
      part[((pb * 3 + 1) * 16 + kg) * 32 + v] = qs;
      part[((pb * 3 + 2) * 16 + kg) * 32 + v] = qk;
      __syncthreads();
      float kS = 0.f, qS = 0.f, qK = 0.f;
#pragma unroll
      for (int j = 0; j < 16; ++j) { kS += part[((pb * 3 + 0) * 16 + j) * 32 + v]; qS += part[((pb * 3 + 1) * 16 + j) * 32 + v]; qK += part[((pb * 3 + 2) * 16 + j) * 32 + v]; }
      const float eg = __expf(gg[tok * 4 + hd]);
      const float bt = beta[tok * 4 + hd];
      const float vt = bf2f(vv[tok * 512 + hd * 128 + vs * 32 + v]);
      const float vnew = bt * (vt - eg * kS);
#pragma unroll
      for (int i = 0; i < 8; ++i) S[i] = eg * S[i] + kq[(pb * 2 + 0) * 128 + kg * 8 + i] * vnew;
      if (kg == 0) go[tok * 512 + hd * 128 + vs * 32 + v] = f2bf(eg * qS + qK * vnew);
    }
    __syncthreads();
  }
}
__device__ __forceinline__ void gdn_outnorm(const int WID, KP p, int l) {
  const int tid = lt(), wave = tid >> 6, lane = tid & 63;
  bf16_t* go = (bf16_t*)(p->ws + WS_D + D_GA);
  const bf16_t* gz = (const bf16_t*)(p->ws + WS_B + B_GZ);
  const float* nw = p->in[I_GNW] + l * 128 + (lane & 15) * 8;
  const f32x4 na = *(const f32x4*)nw, nb = *(const f32x4*)(nw + 4);
  const int stride = gridDim.x * 8;
  for (int item = blockIdx.x * 8 + wave; item < TOK; item += 4 * stride) {
    u32x4 w[4], z[4];
#pragma unroll
    for (int k = 0; k < 4; ++k) {
      const int it = item + k * stride;
      const size_t off = (size_t)(it < TOK ? it : item) * 512 + lane * 8;
      w[k] = *(const u32x4*)(go + off); z[k] = *(const u32x4*)(gz + off);
    }
#pragma unroll
    for (int k = 0; k < 4; ++k) {
      const int it = item + k * stride;
      if (it < TOK) {
        const size_t off = (size_t)it * 512 + lane * 8;
        float o[8], zz[8];
        o[0] = bflo(w[k].x); o[1] = bfhi(w[k].x); o[2] = bflo(w[k].y); o[3] = bfhi(w[k].y); o[4] = bflo(w[k].z); o[5] = bfhi(w[k].z); o[6] = bflo(w[k].w); o[7] = bfhi(w[k].w);
        zz[0] = bflo(z[k].x); zz[1] = bfhi(z[k].x); zz[2] = bflo(z[k].y); zz[3] = bfhi(z[k].y); zz[4] = bflo(z[k].z); zz[5] = bfhi(z[k].z); zz[6] = bflo(z[k].w); zz[7] = bfhi(z[k].w);
        float ss = 0.f;
#pragma unroll
        for (int e = 0; e < 8; ++e) ss += o[e] * o[e];
        ss += shx(ss, 1, lane); ss += shx(ss, 2, lane); ss += shx(ss, 4, lane); ss += shx(ss, 8, lane);
        const float r = rsqrtf(ss * (1.f / 128.f) + 1e-6f);
        u32x4 ov;
        ov.x = pk2bf(o[0] * r * na[0] * silu_f(zz[0]), o[1] * r * na[1] * silu_f(zz[1])); ov.y = pk2bf(o[2] * r * na[2] * silu_f(zz[2]), o[3] * r * na[3] * silu_f(zz[3]));
        ov.z = pk2bf(o[4] * r * nb[0] * silu_f(zz[4]), o[5] * r * nb[1] * silu_f(zz[5])); ov.w = pk2bf(o[6] * r * nb[2] * silu_f(zz[6]), o[7] * r * nb[3] * silu_f(zz[7]));
        *(u32x4*)(go + off) = ov;
      }
    }
  }
}
__device__ __forceinline__ void s5_naive(const int WID, KP p, int l) {
  const int tid = lt();
  if (tid >= 64) return;
  const int pp = tid;
  const bf16_t* s5u = (const bf16_t*)(p->ws + WS_B + B_S5U);
  bf16_t* zg = (bf16_t*)(p->ws + WS_D + D_ZG);
  for (int task = (int)gridDim.x - 1 - (int)blockIdx.x; task < 128; task += gridDim.x) {
    const int b = task >> 4, g = task & 15;
    const float dt = expf(p->in[I_S5LDT][l * 16 + g]);
    const float lr = p->in[I_S5ARE][l * 1024 + g * 64 + pp], li = p->in[I_S5AIM][l * 1024 + g * 64 + pp];
    const float er = expf(lr * dt);
    const float ar = er * cosf(li * dt), ai = er * sinf(li * dt);
    const float nr = ar - 1.f, ni = ai, den = lr * lr + li * li;
    const float fr = (nr * lr + ni * li) / den, fi = (ni * lr - nr * li) / den;
    float bbr[16], bbi[16];
#pragma unroll
    for (int h = 0; h < 16; ++h) {
      const float br = p->in[I_S5BRE][(size_t)l * 16384 + (g * 64 + pp) * 16 + h], bi = p->in[I_S5BIM][(size_t)l * 16384 + (g * 64 + pp) * 16 + h];
      bbr[h] = fr * br - fi * bi; bbi[h] = fr * bi + fi * br;
    }
    const int oh = pp & 15, opg = pp >> 4;
    float cr[16], ci[16];
#pragma unroll
    for (int i = 0; i < 16; ++i) {
      cr[i] = p->in[I_S5CRE][(size_t)l * 16384 + (g * 16 + oh) * 64 + opg * 16 + i];
      ci[i] = p->in[I_S5CIM][(size_t)l * 16384 + (g * 16 + oh) * 64 + opg * 16 + i];
    }
    const float dval = p->in[I_S5D][l * 256 + g * 16 + oh];
    float sr = 0.f, si = 0.f;
    for (int t = 0; t < SEQ; ++t) {
      const size_t tok = (size_t)b * 4096 + t;
      const float uv = bf2f(s5u[tok * 256 + g * 16 + (pp & 15)]);
      float bur = 0.f, bui = 0.f;
#pragma unroll
      for (int h = 0; h < 16; ++h) { const float uh = shl(uv, h); bur += bbr[h] * uh; bui += bbi[h] * uh; }
      const float nsr = ar * sr - ai * si + bur, nsi = ar * si + ai * sr + bui;
      sr = nsr; si = nsi;
      float y = 0.f;
#pragma unroll
      for (int i = 0; i < 16; ++i) y += cr[i] * shl(sr, opg * 16 + i) - ci[i] * shl(si, opg * 16 + i);
      y += shx(y, 16, pp);
      y += shx(y, 32, pp);
      if (opg == 0) zg[tok * 256 + g * 16 + oh] = f2bf(gelu_f(y + dval * uv));
    }
  }
}
__device__ __forceinline__ void moba_one(KP p, int t, int hd, int lane) {
  const bf16_t* mq = (const bf16_t*)(p->ws + WS_B + B_MQ);
  const bf16_t* mk = (const bf16_t*)(p->ws + WS_B + B_MK);
  const bf16_t* mv = (const bf16_t*)(p->ws + WS_B + B_MV);
  const float* kmean = (const float*)(p->ws + WS_MISC + MISC_KMEAN);
  bf16_t* mo = (bf16_t*)(p->ws + WS_D + D_MO);
  const int b = t >> 12, tl = t & 4095, own = tl >> 8;
  float q[64];
#pragma unroll
  for (int i = 0; i < 8; ++i) {
    const u32x4 w = *(const u32x4*)(mq + (size_t)t * 256 + hd * 64 + i * 8);
    q[i * 8 + 0] = bflo(w.x); q[i * 8 + 1] = bfhi(w.x); q[i * 8 + 2] = bflo(w.y); q[i * 8 + 3] = bfhi(w.y);
    q[i * 8 + 4] = bflo(w.z); q[i * 8 + 5] = bfhi(w.z); q[i * 8 + 6] = bflo(w.w); q[i * 8 + 7] = bfhi(w.w);
  }
  float g0 = -3e38f, g1 = -3e38f, g2 = -3e38f;
  int i0 = -1, i1 = -1, i2 = -1;
  for (int n = 0; n < own; ++n) {
    const float* km = kmean + ((size_t)(b * 4 + hd) * 16 + n) * 64;
    float gsum = 0.f;
#pragma unroll
    for (int d = 0; d < 64; ++d) gsum += q[d] * km[d];
    if (gsum > g0) { g2 = g1; i2 = i1; g1 = g0; i1 = i0; g0 = gsum; i0 = n; }
    else if (gsum > g1) { g2 = g1; i2 = i1; g1 = gsum; i1 = n; }
    else if (gsum > g2) { g2 = gsum; i2 = n; }
  }
  float s[16];
  const int blks[4] = {i0, i1, i2, own};
  float mx = -3e38f;
#pragma unroll
  for (int bi = 0; bi < 4; ++bi) {
    const int blk = blks[bi];
#pragma unroll
    for (int kk = 0; kk < 4; ++kk) {
      float sc = -1e30f;
      if (blk >= 0) {
        const int key = blk * 256 + kk * 64 + lane;
        if (key <= tl) {
          const bf16_t* kp = mk + (size_t)(b * 4096 + key) * 256 + hd * 64;
          float a = 0.f;
#pragma unroll
          for (int i = 0; i < 8; ++i) {
            const u32x4 w = *(const u32x4*)(kp + i * 8);
            a += q[i * 8 + 0] * bflo(w.x) + q[i * 8 + 1] * bfhi(w.x) + q[i * 8 + 2] * bflo(w.y) + q[i * 8 + 3] * bfhi(w.y)
               + q[i * 8 + 4] * bflo(w.z) + q[i * 8 + 5] * bfhi(w.z) + q[i * 8 + 6] * bflo(w.w) + q[i * 8 + 7] * bfhi(w.w);
          }
          sc = a * 0.125f;
        }
      }
      s[bi * 4 + kk] = sc;
      mx = fmaxf(mx, sc);
    }
  }
  mx = WMAX(mx);
  float lsum = 0.f;
#pragma unroll
  for (int i = 0; i < 16; ++i) { s[i] = (s[i] > -1e29f) ? __expf(s[i] - mx) : 0.f; lsum += s[i]; }
  lsum = WSUM(lsum);
  const float inv = 1.f / lsum;
  float acc = 0.f;
#pragma unroll
  for (int bi = 0; bi < 4; ++bi) {
    const int blk = blks[bi];
    if (blk < 0) continue;
#pragma unroll
    for (int kk = 0; kk < 4; ++kk) {
      const float pv = s[bi * 4 + kk];
      for (int ll = 0; ll < 64; ++ll) {
        const int key = blk * 256 + kk * 64 + ll;
        if (key > tl) break;
        const float pj = shl(pv, ll);
        acc += pj * bf2f(mv[(size_t)(b * 4096 + key) * 256 + hd * 64 + lane]);
      }
    }
  }
  mo[(size_t)t * 256 + hd * 64 + lane] = f2bf(acc * inv);
}
__device__ __forceinline__ void moba_naive(const int WID, KP p, int l, unsigned char* lds) {
  const int tid = lt(), wave = tid >> 6, lane = tid & 63;
  int* nxt = (int*)(lds + 16384);
  unsigned* ctr = (unsigned*)(p->ws + WS_MISC + MISC_CTR) + l;
  for (;;) {
    __syncthreads();
    if (tid == 0) *nxt = (int)atomicAdd(ctr, 1u);
    __syncthreads();
    const int chunk = *nxt;
    if (chunk >= TOK / 16) break;
    for (int it = 0; it < 8; ++it) moba_one(p, chunk * 16 + it * 2 + (wave >> 2), wave & 3, lane);
  }
}

__device__ __forceinline__ void peer_naive(const int WID, KP p, int l, unsigned char* lds) {
  const int tid = lt(), hd = tid >> 6, lane = tid & 63;
  float* red = (float*)lds;
  unsigned* eids = (unsigned*)(lds + 32768);
  float* egs = (float*)(lds + 32768 + 512);
  float* sred = (float*)(lds + 32768 + 1024);
  float* w8 = (float*)(lds + 36864);
  const bool last = (l == 1);
  const unsigned short* sc = (const unsigned short*)(p->ws + WS_B + B_SCORE);
  bf16_t* h = (bf16_t*)(p->ws + WS_A);
  const bf16_t* tu = (const bf16_t*)(p->ws + WS_D + D_TU);
  const bf16_t* tv = (const bf16_t*)(p->ws + WS_D + D_TV);
  const float* mod = (const float*)(p->ws + WS_MISC + MISC_MOD);
  float* x = p->out;
  float* ba = (float*)(p->ws + WS_B + B_BA);
  if (!last) {
    const float* w_in_n = p->in[I_WIN] + (size_t)(l + 1) * 1024 * IN_COLS;
    for (int i = tid; i < 8192; i += NTHR) w8[i] = w_in_n[(size_t)(i >> 3) * IN_COLS + 2048 + (i & 7)];
  }
  __syncthreads();
  for (int t = blockIdx.x; t < TOK; t += gridDim.x) {
    const int b = t >> 12;
    const unsigned short* sp = sc + (size_t)t * 2048 + hd * 256;
    float sA[2] = {h2f(sp[lane]), h2f(sp[64 + lane])};
    float sB[2] = {h2f(sp[128 + lane]), h2f(sp[192 + lane])};
    float v1 = 0.f, v2 = 0.f; int i1 = 0, i2 = 0;
    for (int r = 0; r < 16; ++r) {
      {
        const float wm = WMAX(fmaxf(sA[0], sA[1]));
        unsigned long long bal = __ballot(sA[0] == wm);
        int idx;
        if (bal) { idx = __ffsll((long long)bal) - 1; if (lane == idx) sA[0] = -3e38f; }
        else { bal = __ballot(sA[1] == wm); idx = __ffsll((long long)bal) - 1; if (lane == idx) sA[1] = -3e38f; idx += 64; }
        if (lane == r) { v1 = wm; i1 = idx; }
      }
      {
        const float wm = WMAX(fmaxf(sB[0], sB[1]));
        unsigned long long bal = __ballot(sB[0] == wm);
        int idx;
        if (bal) { idx = __ffsll((long long)bal) - 1; if (lane == idx) sB[0] = -3e38f; }
        else { bal = __ballot(sB[1] == wm); idx = __ffsll((long long)bal) - 1; if (lane == idx) sB[1] = -3e38f; idx += 64; }
        if (lane == r) { v2 = wm; i2 = idx; }
      }
    }
    float cs[4];
    {
      const float va = shl(v1, lane >> 2);
#pragma unroll
      for (int j = 0; j < 4; ++j) cs[j] = va + shl(v2, (lane & 3) * 4 + j);
    }
    float tvv = 0.f; int tc = 0;
    for (int r = 0; r < 16; ++r) {
      const float wm = WMAX(fmaxf(fmaxf(cs[0], cs[1]), fmaxf(cs[2], cs[3])));
      int mine = 1 << 30;
#pragma unroll
      for (int j = 3; j >= 0; --j) if (cs[j] == wm) mine = lane * 4 + j;
      int best = mine;
#pragma unroll
      for (int o = 32; o > 0; o >>= 1) best = min(best, shxi(best, o, lane));
      if ((best >> 2) == lane) {
#pragma unroll
        for (int j = 0; j < 4; ++j) if (j == (best & 3)) cs[j] = -3e38f;
      }
      if (lane == r) { tvv = wm; tc = best; }
    }
    {
      const float mx = shl(tvv, 0);
      const float e = (lane < 16) ? __expf(tvv - mx) : 0.f;
      const float sum = WSUM(e);
      const int ea = shli(i1, tc >> 4), eb = shli(i2, tc & 15);
      if (lane < 16) { eids[hd * 16 + lane] = (unsigned)(ea * 128 + eb); egs[hd * 16 + lane] = e / sum; }
    }
    float hv[16];
    {
      const u32x4 a = *(const u32x4*)(h + (size_t)t * 1024 + lane * 16), c = *(const u32x4*)(h + (size_t)t * 1024 + lane * 16 + 8);
      hv[0] = bflo(a.x); hv[1] = bfhi(a.x); hv[2] = bflo(a.y); hv[3] = bfhi(a.y); hv[4] = bflo(a.z); hv[5] = bfhi(a.z); hv[6] = bflo(a.w); hv[7] = bfhi(a.w);
      hv[8] = bflo(c.x); hv[9] = bfhi(c.x); hv[10] = bflo(c.y); hv[11] = bfhi(c.y); hv[12] = bflo(c.z); hv[13] = bfhi(c.z); hv[14] = bflo(c.w); hv[15] = bfhi(c.w);
    }
    float acc[16];
#pragma unroll
    for (int j = 0; j < 16; ++j) acc[j] = 0.f;
    __syncthreads();
    for (int k = 0; k < 16; ++k) {
      const unsigned e = eids[hd * 16 + k];
      const float gt = egs[hd * 16 + k];
      const u32x4 a = *(const u32x4*)(tu + (size_t)e * 1024 + lane * 16), c = *(const u32x4*)(tu + (size_t)e * 1024 + lane * 16 + 8);
      float d = hv[0] * bflo(a.x) + hv[1] * bfhi(a.x) + hv[2] * bflo(a.y) + hv[3] * bfhi(a.y) + hv[4] * bflo(a.z) + hv[5] * bfhi(a.z) + hv[6] * bflo(a.w) + hv[7] * bfhi(a.w)
              + hv[8] * bflo(c.x) + hv[9] * bfhi(c.x) + hv[10] * bflo(c.y) + hv[11] * bfhi(c.y) + hv[12] * bflo(c.z) + hv[13] * bfhi(c.z) + hv[14] * bflo(c.w) + hv[15] * bfhi(c.w);
      d = WSUM(d);
      const float w = gt * gelu_f(d);
      const u32x4 va = *(const u32x4*)(tv + (size_t)e * 1024 + lane * 16), vc = *(const u32x4*)(tv + (size_t)e * 1024 + lane * 16 + 8);
      acc[0] += w * bflo(va.x); acc[1] += w * bfhi(va.x); acc[2] += w * bflo(va.y); acc[3] += w * bfhi(va.y);
      acc[4] += w * bflo(va.z); acc[5] += w * bfhi(va.z); acc[6] += w * bflo(va.w); acc[7] += w * bfhi(va.w);
      acc[8] += w * bflo(vc.x); acc[9] += w * bfhi(vc.x); acc[10] += w * bflo(vc.y); acc[11] += w * bfhi(vc.y);
      acc[12] += w * bflo(vc.z); acc[13] += w * bfhi(vc.z); acc[14] += w * bflo(vc.w); acc[15] += w * bfhi(vc.w);
    }
#pragma unroll
    for (int j = 0; j < 16; ++j) red[hd * 1024 + lane * 16 + j] = acc[j];
    __syncthreads();
    const int c0 = tid * 2;
    float o0 = 0.f, o1 = 0.f;
#pragma unroll
    for (int j = 0; j < 8; ++j) { o0 += red[j * 1024 + c0]; o1 += red[j * 1024 + c0 + 1]; }
    const float* g2 = mod + ((size_t)l * 8 + b) * 6144 + 5120;
    float* xr = x + (size_t)t * 1024 + c0;
    const float x0 = xr[0] + g2[c0] * o0, x1 = xr[1] + g2[c0 + 1] * o1;
    float ss = WSUM(x0 * x0 + x1 * x1);
    if (lane == 0) sred[hd * 9 + 8] = ss;
    __syncthreads();
    ss = 0.f;
#pragma unroll
    for (int j = 0; j < 8; ++j) ss += sred[j * 9 + 8];
    const float r = rsqrtf(ss * (1.f / 1024.f) + 1e-6f);
    if (last) {
      const float* fw = p->in[I_FNW];
      xr[0] = x0 * r * fw[c0]; xr[1] = x1 * r * fw[c0 + 1];
      __syncthreads();
    } else {
      xr[0] = x0; xr[1] = x1;
      const float* nw = p->in[I_N1W] + (l + 1) * 1024;
      const float* mn = mod + ((size_t)(l + 1) * 8 + b) * 6144;
      const float h0 = x0 * r * nw[c0] * (1.f + mn[1024 + c0]) + mn[c0];
      const float h1 = x1 * r * nw[c0 + 1] * (1.f + mn[1024 + c0 + 1]) + mn[c0 + 1];
      *(unsigned*)(h + (size_t)t * 1024 + c0) = pk2bf(h0, h1);
      float a8[8];
#pragma unroll
      for (int j = 0; j < 8; ++j) a8[j] = WSUM(h0 * w8[c0 * 8 + j] + h1 * w8[(c0 + 1) * 8 + j]);
      __syncthreads();
      if (lane == 0) {
#pragma unroll
        for (int j = 0; j < 8; ++j) sred[hd * 9 + j] = a8[j];
      }
      __syncthreads();
      if (tid < 8) { float a = 0.f; for (int j = 0; j < 8; ++j) a += sred[j * 9 + tid]; ba[(size_t)t * 8 + tid] = a; }
      __syncthreads();
    }
  }
}

#define C_W 0
#define C_QG (32 * MiB)
#define C_KDT (64 * MiB)
#define C_U (96 * MiB)
#define C_QK (128 * MiB)
#define C_EGL (144 * MiB)
typedef short bf16x8 __attribute__((ext_vector_type(8)));

__device__ __forceinline__ bf16x8 frag_row(const bf16_t* X, int stride, int row, int col8) { return *(const bf16x8*)(X + row * stride + col8); }
__device__ __forceinline__ bf16x8 frag_tr(const bf16_t* X, int stride, int row0, int colbase, int l15) {
  const bf16_t* a0 = X + (row0 + (l15 >> 2)) * stride + colbase + 4 * (l15 & 3);
  const s16x4 t0 = __builtin_amdgcn_ds_read_tr16_b64_v4i16((LAS s16x4*)a0);
  const s16x4 t1 = __builtin_amdgcn_ds_read_tr16_b64_v4i16((LAS s16x4*)(a0 + 4 * stride));
  bf16x8 v; v[0] = t0[0]; v[1] = t0[1]; v[2] = t0[2]; v[3] = t0[3]; v[4] = t1[0]; v[5] = t1[1]; v[6] = t1[2]; v[7] = t1[3];
  return v;
}
#define LBAR() do { asm volatile("s_waitcnt lgkmcnt(0)" ::: "memory"); __builtin_amdgcn_s_barrier(); asm volatile("" ::: "memory"); } while (0)

__device__ __forceinline__ void gdn_prep(const int WID, KP p, int l, unsigned char* lds) {
  const int tid = lt(), lane = tid & 63, l15 = lane & 15, lg = lane >> 4, w = WID;
  bf16_t* Kb = (bf16_t*)lds;
  bf16_t* Qb = Kb + 64 * 136;
  bf16_t* Vb = Qb + 64 * 136;
  bf16_t* Kw = Vb + 64 * 136;
  bf16_t* PT = Kw + 64 * 136;
  bf16_t* P2 = PT + 64 * 72;
  bf16_t* TT = P2 + 64 * 72;
  bf16_t* T2 = TT + 64 * 72;
  float* Gs = (float*)(T2 + 64 * 72);
  const bf16_t* gsrc[3] = {(const bf16_t*)(p->ws + WS_B + B_GQ), (const bf16_t*)(p->ws + WS_B + B_GK), (const bf16_t*)(p->ws + WS_B + B_GV)};
  const float* ba = (const float*)(p->ws + WS_B + B_BA);
  const float* convw = p->in[I_CONVW] + (size_t)l * 4 * 1536;
  bf16_t* Wg = (bf16_t*)(p->ws + WS_C + C_W);
  bf16_t* QGg = (bf16_t*)(p->ws + WS_C + C_QG);
  bf16_t* KDTg = (bf16_t*)(p->ws + WS_C + C_KDT);
  bf16_t* Ug = (bf16_t*)(p->ws + WS_C + C_U);
  bf16_t* QKg = (bf16_t*)(p->ws + WS_C + C_QK);
  float* EGL = (float*)(p->ws + WS_C + C_EGL);
  for (int item = blockIdx.x; item < 2048; item += gridDim.x) {
    const int b = item >> 8, h = (item >> 6) & 3, c = item & 63;
    const int tok0 = b * 4096 + c * 64;
    if (item == (int)blockIdx.x) STAMP(50);
    if (tid < 64) {
      const size_t t = (size_t)tok0 + tid;
      const float g = -expf(p->in[I_ALOG][l * 4 + h]) * softplus_f(ba[t * 8 + 4 + h] + p->in[I_DTB][l * 4 + h]);
      const float bt = sigmoid_f(ba[t * 8 + h]);
      float G = g;
#pragma unroll
      for (int o = 1; o < 64; o <<= 1) { const float v = shl(G, lane - o); if (lane >= o) G += v; }
      const float Glast = shl(G, 63);
      Gs[tid] = G; Gs[64 + tid] = bt; Gs[128 + tid] = __expf(G); Gs[192 + tid] = __expf(Glast - G);
      if (tid == 0) EGL[item] = __expf(Glast);
    }
    LBAR();
    if (item == (int)blockIdx.x) STAMP(51);
    {
      const int tok = tid >> 3, dg = tid & 7, t = tok0 + tok, tl = c * 64 + tok;
      const float bt = Gs[64 + tok], eg = Gs[128 + tok];
#pragma unroll
      for (int part = 0; part < 3; ++part) {
        float acc[16];
#pragma unroll
        for (int i = 0; i < 16; ++i) acc[i] = 0.f;
        u32x4 raw[4][2];
#pragma unroll
        for (int j = 0; j < 4; ++j) {
          const bf16_t* src = gsrc[part] + (size_t)(tl - 3 + j >= 0 ? t - 3 + j : t) * 512 + h * 128 + dg * 8;
          raw[j][0] = *(const u32x4*)src; raw[j][1] = *(const u32x4*)(src + 64);
        }
#pragma unroll
        for (int j = 0; j < 4; ++j) {
          const float on = (tl - 3 + j >= 0) ? 1.f : 0.f;
          const u32x4 r0 = raw[j][0], r1 = raw[j][1];
          const float* wp = convw + j * 1536 + part * 512 + h * 128 + dg * 8;
          const f32x4 w0 = *(const f32x4*)wp * on, w1 = *(const f32x4*)(wp + 4) * on, w2 = *(const f32x4*)(wp + 64) * on, w3 = *(const f32x4*)(wp + 68) * on;
          acc[0] += w0[0] * bflo(r0.x); acc[1] += w0[1] * bfhi(r0.x); acc[2] += w0[2] * bflo(r0.y); acc[3] += w0[3] * bfhi(r0.y);
          acc[4] += w1[0] * bflo(r0.z); acc[5] += w1[1] * bfhi(r0.z); acc[6] += w1[2] * bflo(r0.w); acc[7] += w1[3] * bfhi(r0.w);
          acc[8] += w2[0] * bflo(r1.x); acc[9] += w2[1] * bfhi(r1.x); acc[10] += w2[2] * bflo(r1.y); acc[11] += w2[3] * bfhi(r1.y);
          acc[12] += w3[0] * bflo(r1.z); acc[13] += w3[1] * bfhi(r1.z); acc[14] += w3[2] * bflo(r1.w); acc[15] += w3[3] * bfhi(r1.w);
        }
        float ss = 0.f;
#pragma unroll
        for (int i = 0; i < 16; ++i) { acc[i] = silu_f(acc[i]); ss += acc[i] * acc[i]; }
        float r = bt;
        if (part < 2) {
          ss += shx(ss, 1, lane); ss += shx(ss, 2, lane); ss += shx(ss, 4, lane);
          r = rsqrtf(ss + 1e-6f) * (part == 0 ? 0.08838834764831845f : 1.f);
        }
        bf16_t* d = (part == 0 ? Qb : part == 1 ? Kb : Vb) + tok * 136 + dg * 8;
        u32x4 o0, o1;
        o0.x = pk2bf(acc[0] * r, acc[1] * r); o0.y = pk2bf(acc[2] * r, acc[3] * r); o0.z = pk2bf(acc[4] * r, acc[5] * r); o0.w = pk2bf(acc[6] * r, acc[7] * r);
        o1.x = pk2bf(acc[8] * r, acc[9] * r); o1.y = pk2bf(acc[10] * r, acc[11] * r); o1.z = pk2bf(acc[12] * r, acc[13] * r); o1.w = pk2bf(acc[14] * r, acc[15] * r);
        *(u32x4*)d = o0; *(u32x4*)(d + 64) = o1;
        if (part == 1) {
          const float r2 = r * bt * eg;
          bf16_t* d2 = Kw + tok * 136 + dg * 8;
          o0.x = pk2bf(acc[0] * r2, acc[1] * r2); o0.y = pk2bf(acc[2] * r2, acc[3] * r2); o0.z = pk2bf(acc[4] * r2, acc[5] * r2); o0.w = pk2bf(acc[6] * r2, acc[7] * r2);
          o1.x = pk2bf(acc[8] * r2, acc[9] * r2); o1.y = pk2bf(acc[10] * r2, acc[11] * r2); o1.z = pk2bf(acc[12] * r2, acc[13] * r2); o1.w = pk2bf(acc[14] * r2, acc[15] * r2);
          *(u32x4*)d2 = o0; *(u32x4*)(d2 + 64) = o1;
        }
      }
    }
    LBAR();
    if (item == (int)blockIdx.x) STAMP(52);
    f32x4 tacc[2];
    if (w < 4) {
      const int ti = w;
#pragma unroll 1
      for (int tj = 0; tj < 4; ++tj) {
        f32x4 a = (f32x4){0.f, 0.f, 0.f, 0.f};
        if (tj <= ti) {
#pragma unroll
          for (int ks = 0; ks < 4; ++ks)
            a = __builtin_amdgcn_mfma_f32_16x16x32_bf16(frag_row(Kb, 136, 16 * ti + l15, 32 * ks + 8 * lg), frag_row(Kb, 136, 16 * tj + l15, 32 * ks + 8 * lg), a, 0, 0, 0);
        }
        const int j = 16 * tj + l15;
        const float Gj = Gs[j];
        float nv[4];
#pragma unroll
        for (int r = 0; r < 4; ++r) {
          const int i = 16 * ti + 4 * lg + r;
          nv[r] = (j < i) ? -Gs[64 + i] * a[r] * __expf(Gs[i] - Gj) : 0.f;
        }
        u32x2 wv; wv.x = pk2bf(nv[0], nv[1]); wv.y = pk2bf(nv[2], nv[3]);
        *(u32x2*)(PT + j * 72 + 16 * ti + 4 * lg) = wv;
#pragma unroll
        for (int r = 0; r < 4; ++r) nv[r] += (j == 16 * ti + 4 * lg + r) ? 1.f : 0.f;
        wv.x = pk2bf(nv[0], nv[1]); wv.y = pk2bf(nv[2], nv[3]);
        *(u32x2*)(TT + j * 72 + 16 * ti + 4 * lg) = wv;
      }
    } else {
      const int ti = w - 4;
      bf16_t* qkp = QKg + (size_t)item * 4096;
#pragma unroll 1
      for (int tj = 0; tj < 4; ++tj) {
        f32x4 a = (f32x4){0.f, 0.f, 0.f, 0.f};
        if (tj <= ti) {
#pragma unroll
          for (int ks = 0; ks < 4; ++ks)
            a = __builtin_amdgcn_mfma_f32_16x16x32_bf16(frag_row(Kb, 136, 16 * tj + l15, 32 * ks + 8 * lg), frag_row(Qb, 136, 16 * ti + l15, 32 * ks + 8 * lg), a, 0, 0, 0);
        }
        const int i = 16 * ti + l15;
        const float Gi = Gs[i];
        float qv[4];
#pragma unroll
        for (int r = 0; r < 4; ++r) {
          const int j = 16 * tj + 4 * lg + r;
          qv[r] = (j <= i) ? a[r] * __expf(Gi - Gs[j]) : 0.f;
        }
        u32x2 wv; wv.x = pk2bf(qv[0], qv[1]); wv.y = pk2bf(qv[2], qv[3]);
        *(u32x2*)(qkp + i * 64 + 16 * tj + 4 * lg) = wv;
      }
    }
    LBAR();
#pragma unroll
    for (int q = 0; q < 2; ++q) {
      const int id = 2 * w + q, ti = id >> 2, tj = id & 3;
      const u32x2 tv = *(const u32x2*)(TT + (16 * tj + l15) * 72 + 16 * ti + 4 * lg);
      tacc[q] = (f32x4){bflo(tv.x), bfhi(tv.x), bflo(tv.y), bfhi(tv.y)};
    }
    if (item == (int)blockIdx.x) STAMP(53);
    bf16_t* Pc = P2; bf16_t* Pn = PT; bf16_t* Tc = TT; bf16_t* Tn = T2;
    {
#pragma unroll
      for (int q = 0; q < 2; ++q) {
        const int id = 2 * w + q, ti = id >> 2, tj = id & 3;
        f32x4 pacc = (f32x4){0.f, 0.f, 0.f, 0.f};
#pragma unroll
        for (int ks = 0; ks < 2; ++ks)
          pacc = __builtin_amdgcn_mfma_f32_16x16x32_bf16(frag_tr(PT, 72, 32 * ks + 8 * lg, 16 * ti, l15), frag_row(PT, 72, 16 * tj + l15, 32 * ks + 8 * lg), pacc, 0, 0, 0);
        u32x2 wv; wv.x = pk2bf(pacc[0], pacc[1]); wv.y = pk2bf(pacc[2], pacc[3]);
        *(u32x2*)(P2 + (16 * tj + l15) * 72 + 16 * ti + 4 * lg) = wv;
      }
    }
    LBAR();
#pragma unroll 1
    for (int it = 0; it < 5; ++it) {
#pragma unroll
      for (int q = 0; q < 2; ++q) {
        const int id = 2 * w + q, ti = id >> 2, tj = id & 3;
        f32x4 pacc = (f32x4){0.f, 0.f, 0.f, 0.f};
#pragma unroll
        for (int ks = 0; ks < 2; ++ks) {
          const bf16x8 bP = frag_row(Pc, 72, 16 * tj + l15, 32 * ks + 8 * lg);
          tacc[q] = __builtin_amdgcn_mfma_f32_16x16x32_bf16(frag_tr(Tc, 72, 32 * ks + 8 * lg, 16 * ti, l15), bP, tacc[q], 0, 0, 0);
          pacc = __builtin_amdgcn_mfma_f32_16x16x32_bf16(frag_tr(Pc, 72, 32 * ks + 8 * lg, 16 * ti, l15), bP, pacc, 0, 0, 0);
        }
        u32x2 wv; wv.x = pk2bf(tacc[q][0], tacc[q][1]); wv.y = pk2bf(tacc[q][2], tacc[q][3]);
        *(u32x2*)(Tn + (16 * tj + l15) * 72 + 16 * ti + 4 * lg) = wv;
        wv.x = pk2bf(pacc[0], pacc[1]); wv.y = pk2bf(pacc[2], pacc[3]);
        *(u32x2*)(Pn + (16 * tj + l15) * 72 + 16 * ti + 4 * lg) = wv;
      }
      LBAR();
      bf16_t* sw = Pc; Pc = Pn; Pn = sw; sw = Tc; Tc = Tn; Tn = sw;
    }
    const bf16_t* TF = Tc;
    if (item == (int)blockIdx.x) STAMP(54);
    {
      bf16_t* up = Ug + (size_t)item * 8192;
      bf16_t* wp = Wg + (size_t)item * 8192;
#pragma unroll 1
      for (int q = 0; q < 2; ++q) {
        const int ct = 2 * w + q;
        const bf16_t* R = (ct < 8) ? Vb : Kw;
        bf16_t* outp = (ct < 8) ? up : wp;
        const int cb = 16 * (ct & 7);
        bf16x8 af[2];
#pragma unroll
        for (int ks = 0; ks < 2; ++ks) af[ks] = frag_tr(R, 136, 32 * ks + 8 * lg, cb, l15);
#pragma unroll
        for (int tt = 0; tt < 4; ++tt) {
          f32x4 a = (f32x4){0.f, 0.f, 0.f, 0.f};
#pragma unroll
          for (int ks = 0; ks < 2; ++ks)
            a = __builtin_amdgcn_mfma_f32_16x16x32_bf16(af[ks], frag_tr(TF, 72, 32 * ks + 8 * lg, 16 * tt, l15), a, 0, 0, 0);
          u32x2 wv; wv.x = pk2bf(a[0], a[1]); wv.y = pk2bf(a[2], a[3]);
          *(u32x2*)(outp + (16 * tt + l15) * 128 + cb + 4 * lg) = wv;
        }
      }
    }
    if (item == (int)blockIdx.x) STAMP(55);
    {
      bf16_t* qgp = QGg + (size_t)item * 8192;
      bf16_t* kdp = KDTg + (size_t)item * 8192;
#pragma unroll
      for (int n = 0; n < 2; ++n) {
        const int idx = tid + 512 * n, tok = idx >> 4, c8 = (idx & 15) * 8;
        const float e = Gs[128 + tok];
        const u32x4 v = *(const u32x4*)(Qb + tok * 136 + c8);
        u32x4 o; o.x = pk2bf(bflo(v.x) * e, bfhi(v.x) * e); o.y = pk2bf(bflo(v.y) * e, bfhi(v.y) * e); o.z = pk2bf(bflo(v.z) * e, bfhi(v.z) * e); o.w = pk2bf(bflo(v.w) * e, bfhi(v.w) * e);
        *(u32x4*)(qgp + tok * 128 + c8) = o;
      }
      {
        const int k = tid & 127, tg = tid >> 7;
        unsigned o[8];
#pragma unroll
        for (int i = 0; i < 8; ++i) {
          const int t0 = tg * 16 + 2 * i;
          o[i] = pk2bf(bf2f(Kb[t0 * 136 + k]) * Gs[192 + t0], bf2f(Kb[(t0 + 1) * 136 + k]) * Gs[192 + t0 + 1]);
        }
        *(u32x4*)(kdp + k * 64 + tg * 16) = (u32x4){o[0], o[1], o[2], o[3]};
        *(u32x4*)(kdp + k * 64 + tg * 16 + 8) = (u32x4){o[4], o[5], o[6], o[7]};
      }
    }
    LBAR();
    if (item == (int)blockIdx.x) STAMP(56);
  }
}

#define SCB_W 0
#define SCB_Q 16384
#define SCB_D 32768
#define SCB_K 49152
#define SCB_U 57344
#define SCB_BYTES 61952
__device__ __forceinline__ void gdn_scan(const int WID, KP p, unsigned char* lds) {
  const int tid = lt(), lane = tid & 63, l15 = lane & 15, lg = lane >> 4;
  const int w = WID, rt = w >> 1, ct = w & 1;
  bf16_t* ST = (bf16_t*)lds;
  bf16_t* VT = ST + 32 * 136;
  unsigned char* BUF = lds + 13312;
  bf16_t* OL = (bf16_t*)(lds + 13312 + 2 * SCB_BYTES);
  const unsigned char* Wg = p->ws + WS_C + C_W;
  const unsigned char* QGg = p->ws + WS_C + C_QG;
  const unsigned char* KDTg = p->ws + WS_C + C_KDT;
  const unsigned char* Ug = p->ws + WS_C + C_U;
  const unsigned char* QKg = p->ws + WS_C + C_QK;
  const float* EGL = (const float*)(p->ws + WS_C + C_EGL);
  bf16_t* go = (bf16_t*)(p->ws + WS_D + D_GA);
  const int p0 = tid, p1 = tid + 512;
  const int dW0 = (p0 >> 4) * 256 + (((p0 & 15) ^ ((p0 >> 4) & 15)) << 4), dW1 = (p1 >> 4) * 256 + (((p1 & 15) ^ ((p1 >> 4) & 15)) << 4);
  const int dD0 = (p0 >> 3) * 128 + (((p0 & 7) ^ ((p0 >> 3) & 7)) << 4), dD1 = (p1 >> 3) * 128 + (((p1 & 7) ^ ((p1 >> 3) & 7)) << 4);
  const int dK0 = dD0;
  const int dU0 = (tid >> 2) * 72 + ((tid & 3) << 4);
  for (int task = blockIdx.x; task < 128; task += gridDim.x) {
    const int xq = task & 7, yq = task >> 3;
    const int bh = (yq >> 2) * 8 + xq, vs = yq & 3, b = bh >> 2, h = bh & 3;
    for (int i = tid; i < 32 * 136 / 2; i += NTHR) ((unsigned*)ST)[i] = 0u;
    f32x4 Sacc[2] = {(f32x4){0.f, 0.f, 0.f, 0.f}, (f32x4){0.f, 0.f, 0.f, 0.f}};
    u32x4 rA[8], rB[8];
    float eA, eB;
#define SG_LOAD(rr, ee, cc) do { const size_t ch_ = (size_t)bh * 64 + ((cc) < 64 ? (cc) : 63); \
      rr[0] = *(const u32x4*)(Wg + ch_ * 16384 + (size_t)p0 * 16); rr[1] = *(const u32x4*)(Wg + ch_ * 16384 + (size_t)p1 * 16); \
      rr[2] = *(const u32x4*)(QGg + ch_ * 16384 + (size_t)p0 * 16); rr[3] = *(const u32x4*)(QGg + ch_ * 16384 + (size_t)p1 * 16); \
      rr[4] = *(const u32x4*)(KDTg + ch_ * 16384 + (size_t)p0 * 16); rr[5] = *(const u32x4*)(KDTg + ch_ * 16384 + (size_t)p1 * 16); \
      rr[6] = *(const u32x4*)(QKg + ch_ * 8192 + (size_t)p0 * 16); \
      if (tid < 256) rr[7] = *(const u32x4*)(Ug + ch_ * 16384 + (size_t)(tid >> 2) * 256 + vs * 64 + (tid & 3) * 16); \
      ee = EGL[ch_]; } while (0)
#define SG_STORE(rr, bufi) do { unsigned char* B_ = BUF + (bufi) * SCB_BYTES; \
      *(u32x4*)(B_ + SCB_W + dW0) = rr[0]; *(u32x4*)(B_ + SCB_W + dW1) = rr[1]; *(u32x4*)(B_ + SCB_Q + dW0) = rr[2]; *(u32x4*)(B_ + SCB_Q + dW1) = rr[3]; \
      *(u32x4*)(B_ + SCB_D + dD0) = rr[4]; *(u32x4*)(B_ + SCB_D + dD1) = rr[5]; *(u32x4*)(B_ + SCB_K + dK0) = rr[6]; \
      if (tid < 256) *(u32x4*)(B_ + SCB_U + dU0) = rr[7]; } while (0)
#define SG_FLUSH(cp) do { if (tid < 256) { const u32x4 ov_ = *(const u32x4*)(OL + (tid >> 2) * 40 + (tid & 3) * 8); \
      *(u32x4*)(go + ((size_t)b * 4096 + (cp) * 64 + (tid >> 2)) * 512 + h * 128 + vs * 32 + (tid & 3) * 8) = ov_; } } while (0)
#define SG_STEP(bufi, egl, c) do { if ((c) < 64) { const unsigned char* B_ = BUF + (bufi) * SCB_BYTES; \
      f32x4 P = (f32x4){0.f, 0.f, 0.f, 0.f}, O = (f32x4){0.f, 0.f, 0.f, 0.f}; \
      _Pragma("unroll") for (int k = 0; k < 4; ++k) { const bf16x8 bS = *(const bf16x8*)(ST + (ct * 16 + l15) * 136 + 32 * k + 8 * lg); \
        const int fo = (16 * rt + l15) * 256 + (((4 * k + lg) ^ l15) << 4); \
        P = __builtin_amdgcn_mfma_f32_16x16x32_bf16(*(const bf16x8*)(B_ + SCB_W + fo), bS, P, 0, 0, 0); \
        O = __builtin_amdgcn_mfma_f32_16x16x32_bf16(*(const bf16x8*)(B_ + SCB_Q + fo), bS, O, 0, 0, 0); } \
      { const bf16_t* up_ = (const bf16_t*)(B_ + SCB_U) + (16 * rt + 4 * lg) * 36 + ct * 16 + l15; \
        u32x2 wv; wv.x = pk2bf(bf2f(up_[0]) - P[0], bf2f(up_[36]) - P[1]); wv.y = pk2bf(bf2f(up_[72]) - P[2], bf2f(up_[108]) - P[3]); \
        *(u32x2*)(VT + (ct * 16 + l15) * 72 + 16 * rt + 4 * lg) = wv; } \
      LBAR(); \
      bf16x8 bV[2]; \
      _Pragma("unroll") for (int s = 0; s < 2; ++s) bV[s] = *(const bf16x8*)(VT + (ct * 16 + l15) * 72 + 32 * s + 8 * lg); \
      _Pragma("unroll") for (int s = 0; s < 2; ++s) O = __builtin_amdgcn_mfma_f32_16x16x32_bf16(*(const bf16x8*)(B_ + SCB_K + (16 * rt + l15) * 128 + (((4 * s + lg) ^ (l15 & 7)) << 4)), bV[s], O, 0, 0, 0); \
      { bf16_t* ol_ = OL + (16 * rt + 4 * lg) * 40 + ct * 16 + l15; \
        _Pragma("unroll") for (int r = 0; r < 4; ++r) ol_[r * 40] = f2bf(O[r]); } \
      _Pragma("unroll") for (int kt = 0; kt < 2; ++kt) { Sacc[kt] = Sacc[kt] * egl; \
        _Pragma("unroll") for (int s = 0; s < 2; ++s) Sacc[kt] = __builtin_amdgcn_mfma_f32_16x16x32_bf16(*(const bf16x8*)(B_ + SCB_D + (16 * (2 * (w >> 1) + kt) + l15) * 128 + (((4 * s + lg) ^ (l15 & 7)) << 4)), bV[s], Sacc[kt], 0, 0, 0); \
        u32x2 wv; wv.x = pk2bf(Sacc[kt][0], Sacc[kt][1]); wv.y = pk2bf(Sacc[kt][2], Sacc[kt][3]); \
        *(u32x2*)(ST + (ct * 16 + l15) * 136 + 16 * (2 * (w >> 1) + kt) + 4 * lg) = wv; } } } while (0)
    SG_LOAD(rA, eA, 0);
    SG_STORE(rA, 0);
    float e0 = eA;
    SG_LOAD(rB, eB, 1);
    __syncthreads();
#pragma unroll 1
    for (int c = 0; c < 64; c += 2) {
      SG_LOAD(rA, eA, c + 2);
      if (c > 0) SG_FLUSH(c - 1);
      SG_STEP(0, e0, c);
      SG_STORE(rB, 1); const float e1 = eB;
      LBAR();
      SG_LOAD(rB, eB, c + 3);
      SG_FLUSH(c);
      SG_STEP(1, e1, c + 1);
      SG_STORE(rA, 0); e0 = eA;
      LBAR();
    }
    SG_FLUSH(63);
    __syncthreads();
  }
}

#define MB_STRIDE 72
__device__ __forceinline__ void moba_attn(const int WID, KP p, int ctr_idx, unsigned char* lds) {
  const int tid = lt(), lane = tid & 63, l15 = lane & 15, lg = lane >> 4, w = WID;
  bf16_t* Ks = (bf16_t*)lds;
  bf16_t* Vs = Ks + 2 * 128 * MB_STRIDE;
  int* nxt = (int*)(lds + 4 * 128 * MB_STRIDE * 2);
  const bf16_t* mq = (const bf16_t*)(p->ws + WS_B + B_MQ);
  const bf16_t* mk = (const bf16_t*)(p->ws + WS_B + B_MK);
  const bf16_t* mv = (const bf16_t*)(p->ws + WS_B + B_MV);
  const float* kmean = (const float*)(p->ws + WS_MISC + MISC_KMEAN);
  bf16_t* mo = (bf16_t*)(p->ws + WS_D + D_MO);
  unsigned* ctr = (unsigned*)(p->ws + WS_MISC + MISC_CTR) + ctr_idx;
  const int skey = tid >> 3, sd = (tid & 7) * 8;
  for (;;) {
    __syncthreads();
    if (tid == 0) *nxt = (int)atomicAdd(ctr, 1u);
    __syncthreads();
    const int task = *nxt;
    if (task >= 1024) break;
    const int qt = 31 - (task >> 5), b = (task & 31) >> 2, h = task & 3;
    const int own = qt >> 1;
    const int NT = 4 * own + 2 + 2 * (qt & 1);
    const size_t tokb = (size_t)b * 4096;
    const int tl = qt * 128 + w * 16 + l15;
    bf16x8 qf[2];
    {
      const bf16_t* qp = mq + (tokb + tl) * 256 + h * 64 + 8 * lg;
      qf[0] = *(const bf16x8*)qp; qf[1] = *(const bf16x8*)(qp + 32);
    }
    unsigned sel = 1u << own;
    if (own > 0) {
      f32x4 g4 = (f32x4){0.f, 0.f, 0.f, 0.f};
#pragma unroll
      for (int ks = 0; ks < 2; ++ks) {
        const float* kmp = kmean + ((size_t)(b * 4 + h) * 16 + l15) * 64 + 32 * ks + 8 * lg;
        const f32x4 a0 = *(const f32x4*)kmp, a1 = *(const f32x4*)(kmp + 4);
        u32x4 pk; pk.x = pk2bf(a0[0], a0[1]); pk.y = pk2bf(a0[2], a0[3]); pk.z = pk2bf(a1[0], a1[1]); pk.w = pk2bf(a1[2], a1[3]);
        g4 = __builtin_amdgcn_mfma_f32_16x16x32_bf16(__builtin_bit_cast(bf16x8, pk), qf[ks], g4, 0, 0, 0);
      }
      float gv[16];
#pragma unroll
      for (int s = 0; s < 4; ++s)
#pragma unroll
        for (int r = 0; r < 4; ++r) gv[s * 4 + r] = shl(g4[r], s * 16 + l15);
      float g0 = -3e38f, g1 = -3e38f, g2 = -3e38f; int i0 = -1, i1 = -1, i2 = -1;
#pragma unroll
      for (int n = 0; n < 15; ++n) {
        const float gs = (n < own) ? gv[n] : -3e38f;
        if (n < own) {
          if (gs > g0) { g2 = g1; i2 = i1; g1 = g0; i1 = i0; g0 = gs; i0 = n; }
          else if (gs > g1) { g2 = g1; i2 = i1; g1 = gs; i1 = n; }
          else if (gs > g2) { g2 = gs; i2 = n; }
        }
      }
      if (i0 >= 0) sel |= 1u << i0;
      if (i1 >= 0) sel |= 1u << i1;
      if (i2 >= 0) sel |= 1u << i2;
    }
    f32x4 OT[4];
#pragma unroll
    for (int dt = 0; dt < 4; ++dt) OT[dt] = (f32x4){0.f, 0.f, 0.f, 0.f};
    float m_run = -1e30f, l_run = 0.f;
    const int NI = NT >> 1;
    u32x4 kA[2], vA[2], kB[2], vB[2], kC[2], vC[2];
#define MB_LD(kk, vv, pair) do { const int pr_ = (pair) < NI ? (pair) : NI - 1; _Pragma("unroll") for (int q2 = 0; q2 < 2; ++q2) { \
      const size_t g_ = (tokb + (size_t)pr_ * 128 + q2 * 64 + skey) * 256 + h * 64 + sd; kk[q2] = *(const u32x4*)(mk + g_); vv[q2] = *(const u32x4*)(mv + g_); } } while (0)
#define MB_ST(kk, vv, bufi) do { _Pragma("unroll") for (int q2 = 0; q2 < 2; ++q2) { \
      *(u32x4*)(Ks + ((bufi) * 128 + q2 * 64 + skey) * MB_STRIDE + sd) = kk[q2]; *(u32x4*)(Vs + ((bufi) * 128 + q2 * 64 + skey) * MB_STRIDE + sd) = vv[q2]; } } while (0)
    MB_LD(kA, vA, 0);
    MB_LD(kB, vB, 1);
    MB_LD(kC, vC, 2);
    MB_ST(kA, vA, 0);
    asm volatile("s_waitcnt lgkmcnt(0)" ::: "memory"); __builtin_amdgcn_s_barrier(); asm volatile("" ::: "memory");
    const float SC = 0.18033688011112042f;
#define MB_ITER(itx, LK, LV, SK, SV) do { const int it = (itx); if (it < NI) { \
      const int cur = it & 1; \
      MB_LD(LK, LV, it + 3); \
      const int kb = it * 128, blk = it >> 1; \
      const bool mine = (sel >> blk) & 1u; \
      if (__ballot(mine) != 0ull) { \
        const bf16_t* Kc = Ks + cur * 128 * MB_STRIDE + l15 * MB_STRIDE + 8 * lg; \
        const bf16_t* Vc = Vs + cur * 128 * MB_STRIDE + (4 * lg + (l15 >> 2)) * MB_STRIDE + 4 * (l15 & 3); \
        f32x4 sT[8]; \
      _Pragma("unroll") \
        for (int kt = 0; kt < 8; ++kt) { \
          sT[kt] = (f32x4){0.f, 0.f, 0.f, 0.f}; \
      _Pragma("unroll") \
          for (int ks = 0; ks < 2; ++ks) { \
            const bf16x8 ka = *(const bf16x8*)(Kc + (16 * kt) * MB_STRIDE + 32 * ks); \
            sT[kt] = __builtin_amdgcn_mfma_f32_16x16x32_bf16(ka, qf[ks], sT[kt], 0, 0, 0); \
          } \
        } \
        if (__builtin_expect(__builtin_amdgcn_readfirstlane((int)(kb + 127 > qt * 128 + w * 16)) != 0, 0)) { asm volatile("; diag tile" ::: "memory"); \
      _Pragma("unroll") \
          for (int kt = 0; kt < 8; ++kt) \
      _Pragma("unroll") \
            for (int r = 0; r < 4; ++r) sT[kt][r] = (kb + 16 * kt + 4 * lg + r <= tl) ? sT[kt][r] : -INFINITY; \
        } \
        float lmax = fmaxf(fmaxf(sT[0][0], sT[0][1]), fmaxf(sT[0][2], sT[0][3])); \
      _Pragma("unroll") \
        for (int kt = 1; kt < 8; ++kt) lmax = fmaxf(lmax, fmaxf(fmaxf(sT[kt][0], sT[kt][1]), fmaxf(sT[kt][2], sT[kt][3]))); \
        lmax *= SC; \
        if (__ballot(mine && lmax > m_run + 16.f) != 0ull) { \
          float tmax = fmaxf(lmax, shx(lmax, 16, lane)); \
          tmax = fmaxf(tmax, shx(tmax, 32, lane)); \
          const float m_new = mine ? fmaxf(m_run, tmax) : m_run; \
          const float alpha = __builtin_amdgcn_exp2f(m_run - m_new); \
          l_run *= alpha; \
      _Pragma("unroll") \
          for (int dt = 0; dt < 4; ++dt) OT[dt] = OT[dt] * alpha; \
          m_run = m_new; \
        } \
        const float nb = mine ? -m_run : -INFINITY; \
        float psum = 0.f; \
        unsigned pp[16]; \
      _Pragma("unroll") \
        for (int kt = 0; kt < 8; ++kt) { \
          const float p0 = __builtin_amdgcn_exp2f(fmaf(sT[kt][0], SC, nb)), p1 = __builtin_amdgcn_exp2f(fmaf(sT[kt][1], SC, nb)); \
          const float p2 = __builtin_amdgcn_exp2f(fmaf(sT[kt][2], SC, nb)), p3 = __builtin_amdgcn_exp2f(fmaf(sT[kt][3], SC, nb)); \
          psum += (p0 + p1) + (p2 + p3); \
          pp[kt * 2] = cvt_pk_bf16(p0, p1); pp[kt * 2 + 1] = cvt_pk_bf16(p2, p3); \
        } \
        l_run += psum; \
      _Pragma("unroll") \
        for (int ks2 = 0; ks2 < 4; ++ks2) { \
          u32x4 pb; pb.x = pp[ks2 * 4]; pb.y = pp[ks2 * 4 + 1]; pb.z = pp[ks2 * 4 + 2]; pb.w = pp[ks2 * 4 + 3]; \
          const bf16x8 pf = __builtin_bit_cast(bf16x8, pb); \
      _Pragma("unroll") \
          for (int dt = 0; dt < 4; ++dt) { \
            const bf16_t* a0 = Vc + (32 * ks2) * MB_STRIDE + 16 * dt; \
            const s16x4 t0 = __builtin_amdgcn_ds_read_tr16_b64_v4i16((LAS s16x4*)a0); \
            const s16x4 t1 = __builtin_amdgcn_ds_read_tr16_b64_v4i16((LAS s16x4*)(a0 + 16 * MB_STRIDE)); \
            bf16x8 va; va[0] = t0[0]; va[1] = t0[1]; va[2] = t0[2]; va[3] = t0[3]; va[4] = t1[0]; va[5] = t1[1]; va[6] = t1[2]; va[7] = t1[3]; \
            OT[dt] = __builtin_amdgcn_mfma_f32_16x16x32_bf16(va, pf, OT[dt], 0, 0, 0); \
          } \
        } \
      } \
      MB_ST(SK, SV, cur ^ 1); \
      asm volatile("s_waitcnt lgkmcnt(0)" ::: "memory"); __builtin_amdgcn_s_barrier(); asm volatile("" ::: "memory"); \
    } } while (0)
#pragma unroll 1
    for (int it3 = 0; it3 < NI; it3 += 3) {
      MB_ITER(it3, kA, vA, kB, vB);
      MB_ITER(it3 + 1, kB, vB, kC, vC);
      MB_ITER(it3 + 2, kC, vC, kA, vA);
    }
    l_run += shx(l_run, 16, lane);
    l_run += shx(l_run, 32, lane);
    {
      const float inv = 1.f / l_run;
      bf16_t* op = mo + (tokb + tl) * 256 + h * 64 + 4 * lg;
#pragma unroll
      for (int dt = 0; dt < 4; ++dt) {
        u32x2 wv; wv.x = cvt_pk_bf16(OT[dt][0] * inv, OT[dt][1] * inv); wv.y = cvt_pk_bf16(OT[dt][2] * inv, OT[dt][3] * inv);
        *(u32x2*)(op + 16 * dt) = wv;
      }
    }
  }
}

#define MB_PART 0
#define MB_ML (64 * MiB)
#define MB_LIST (68 * MiB)
#define MB_CNT (72 * MiB)
__device__ __forceinline__ void moba_select(const int WID, KP p, int l, unsigned char* lds) {
  const int tid = lt(), lane = tid & 63, l15 = lane & 15, lg = lane >> 4, w = WID;
  int* cnt = (int*)lds;
  const bf16_t* mq = (const bf16_t*)(p->ws + WS_B + B_MQ);
  const float* kmean = (const float*)(p->ws + WS_MISC + MISC_KMEAN);
  unsigned short* list = (unsigned short*)(p->ws + WS_B + MB_LIST);
  unsigned* CNT = (unsigned*)(p->ws + WS_B + MB_CNT);
  unsigned* done = (unsigned*)(p->ws + WS_MISC + MISC_CTR) + 16 + l;
  for (int bh = (int)gridDim.x - 1 - (int)blockIdx.x; bh < 32; bh += gridDim.x) {
    const int b = bh >> 2, h = bh & 3;
    if (tid < 16) cnt[tid] = 0;
    __syncthreads();
    bf16x8 kmf[2];
#pragma unroll
    for (int ks = 0; ks < 2; ++ks) {
      const float* kmp = kmean + ((size_t)bh * 16 + l15) * 64 + 32 * ks + 8 * lg;
      const f32x4 a0 = *(const f32x4*)kmp, a1 = *(const f32x4*)(kmp + 4);
      u32x4 pk; pk.x = pk2bf(a0[0], a0[1]); pk.y = pk2bf(a0[2], a0[3]); pk.z = pk2bf(a1[0], a1[1]); pk.w = pk2bf(a1[2], a1[3]);
      kmf[ks] = __builtin_bit_cast(bf16x8, pk);
    }
    bf16x8 nq0, nq1;
    {
      const bf16_t* qp = mq + ((size_t)b * 4096 + (16 + w) * 16 + l15) * 256 + h * 64 + 8 * lg;
      nq0 = *(const bf16x8*)qp; nq1 = *(const bf16x8*)(qp + 32);
    }
    for (int qg = 16 + w; qg < 256; qg += 8) {
      const int own = qg >> 4, t = qg * 16 + l15;
      const bf16x8 q0 = nq0, q1 = nq1;
      {
        const int qn = qg + 8 < 256 ? qg + 8 : qg;
        const bf16_t* qp = mq + ((size_t)b * 4096 + qn * 16 + l15) * 256 + h * 64 + 8 * lg;
        nq0 = *(const bf16x8*)qp; nq1 = *(const bf16x8*)(qp + 32);
      }
      f32x4 g4 = (f32x4){0.f, 0.f, 0.f, 0.f};
      g4 = __builtin_amdgcn_mfma_f32_16x16x32_bf16(kmf[0], q0, g4, 0, 0, 0);
      g4 = __builtin_amdgcn_mfma_f32_16x16x32_bf16(kmf[1], q1, g4, 0, 0, 0);
      float gv[16];
#pragma unroll
      for (int s = 0; s < 4; ++s)
#pragma unroll
        for (int r = 0; r < 4; ++r) gv[s * 4 + r] = shl(g4[r], s * 16 + l15);
      float g0 = -3e38f, g1 = -3e38f, g2 = -3e38f; int i0 = -1, i1 = -1, i2 = -1;
#pragma unroll
      for (int n = 0; n < 15; ++n) {
        if (n < own) {
          const float gs = gv[n];
          if (gs > g0) { g2 = g1; i2 = i1; g1 = g0; i1 = i0; g0 = gs; i0 = n; }
          else if (gs > g1) { g2 = g1; i2 = i1; g1 = gs; i1 = n; }
          else if (gs > g2) { g2 = gs; i2 = n; }
        }
      }
      if (lg == 0) {
        if (i0 >= 0) { const int pos = atomicAdd(&cnt[i0], 1); list[((size_t)bh * 16 + i0) * 4096 + pos] = (unsigned short)(t | (0 << 12)); }
        if (i1 >= 0) { const int pos = atomicAdd(&cnt[i1], 1); list[((size_t)bh * 16 + i1) * 4096 + pos] = (unsigned short)(t | (1 << 12)); }
        if (i2 >= 0) { const int pos = atomicAdd(&cnt[i2], 1); list[((size_t)bh * 16 + i2) * 4096 + pos] = (unsigned short)(t | (2 << 12)); }
      }
    }
    __syncthreads();
    if (tid < 16) CNT[bh * 16 + tid] = (unsigned)cnt[tid];
    __syncthreads();
    if (tid == 0) { __threadfence(); atomicAdd(done, 1u); }
  }
}
__device__ __forceinline__ void moba_combine(const int WID, KP p) {
  const int tid = lt(), wave = tid >> 6, lane = tid & 63;
  const bf16_t* part = (const bf16_t*)(p->ws + WS_B + MB_PART);
  const float* mlp = (const float*)(p->ws + WS_B + MB_ML);
  bf16_t* mo = (bf16_t*)(p->ws + WS_D + D_MO);
  const int stride = gridDim.x * 8;
  for (int item0 = blockIdx.x * 8 + wave; item0 < 32 * 4096; item0 += 4 * stride) {
    f32x4 ma[4], mb[4];
    bf16_t pv[4][4];
#pragma unroll
    for (int k = 0; k < 4; ++k) {
      const int item = item0 + k * stride;
      const size_t it = (size_t)(item < 32 * 4096 ? item : item0);
      ma[k] = *(const f32x4*)(mlp + it * 8); mb[k] = *(const f32x4*)(mlp + it * 8 + 4);
#pragma unroll
      for (int r = 0; r < 4; ++r) pv[k][r] = part[(it * 4 + r) * 64 + lane];
    }
#pragma unroll
    for (int k = 0; k < 4; ++k) {
      const int item = item0 + k * stride;
      if (item < 32 * 4096) {
        const int bh = item >> 12, t = item & 4095, own = t >> 8, nv = own < 3 ? own : 3;
        const float m[4] = {ma[k][0], ma[k][2], mb[k][0], mb[k][2]}, ls[4] = {ma[k][1], ma[k][3], mb[k][1], mb[k][3]};
        float M = m[3];
#pragma unroll
        for (int r = 0; r < 3; ++r) M = (r < nv) ? fmaxf(M, m[r]) : M;
        float L = 0.f, O = 0.f;
#pragma unroll
        for (int r = 0; r < 4; ++r) {
          const bool ok = (r < nv) || (r == 3);
          const float wg = ok ? __builtin_amdgcn_exp2f(m[r] - M) : 0.f;
          L += ok ? wg * ls[r] : 0.f;
          O += ok ? wg * bf2f(pv[k][r]) : 0.f;
        }
        mo[((size_t)(bh >> 2) * 4096 + t) * 256 + (bh & 3) * 64 + lane] = f2bf(O / L);
      }
    }
  }
}
__device__ __forceinline__ void moba_attn2(const int WID, KP p, int l, int ctr_idx, unsigned char* lds) {
  const int tid = lt(), lane = tid & 63, l15 = lane & 15, lg = lane >> 4, w = WID;
  bf16_t* Ks = (bf16_t*)lds;
  bf16_t* Vs = Ks + 2 * 128 * MB_STRIDE;
  int* nxt = (int*)(lds + 4 * 128 * MB_STRIDE * 2);
  const bf16_t* mq = (const bf16_t*)(p->ws + WS_B + B_MQ);
  const bf16_t* mk = (const bf16_t*)(p->ws + WS_B + B_MK);
  const bf16_t* mv = (const bf16_t*)(p->ws + WS_B + B_MV);
  const float* kmean = (const float*)(p->ws + WS_MISC + MISC_KMEAN);
  bf16_t* mo = (bf16_t*)(p->ws + WS_D + D_MO);
  unsigned* ctr = (unsigned*)(p->ws + WS_MISC + MISC_CTR) + ctr_idx;
  const int skey = tid >> 3, sd = (tid & 7) * 8;
  int* found = nxt + 1;
  int* pre = nxt + 2;
  int* cl = pre + 516;
  int* bhs = cl + 512;
  const unsigned short* list = (const unsigned short*)(p->ws + WS_B + MB_LIST);
  const unsigned* CNT = (const unsigned*)(p->ws + WS_B + MB_CNT);
  bf16_t* part = (bf16_t*)(p->ws + WS_B + MB_PART);
  float* mlp = (float*)(p->ws + WS_B + MB_ML);
  if (tid == 0) {
    unsigned* done = (unsigned*)(p->ws + WS_MISC + MISC_CTR) + 16 + l;
    while (__hip_atomic_load(done, __ATOMIC_RELAXED, __HIP_MEMORY_SCOPE_AGENT) < 32u) __builtin_amdgcn_s_sleep(4);
    __threadfence();
  }
  __syncthreads();
  cl[tid] = (int)CNT[tid];
  __syncthreads();
  if (tid < 32) { int s_ = 0; for (int k = 0; k < 16; ++k) s_ += (cl[tid * 16 + k] + 511) >> 9; bhs[tid + 1] = s_; }
  __syncthreads();
  if (tid == 0) { bhs[0] = 0; for (int k = 1; k <= 32; ++k) bhs[k] += bhs[k - 1]; }
  __syncthreads();
  { int s_ = bhs[tid >> 4]; for (int k = 0; k < (tid & 15); ++k) s_ += (cl[(tid & ~15) + k] + 511) >> 9; pre[tid] = s_; if (tid == 511) pre[512] = s_ + ((cl[511] + 511) >> 9); }
  __syncthreads();
  const int totalA = pre[512];
  for (;;) {
    __syncthreads();
    if (tid == 0) *nxt = (int)atomicAdd(ctr, 1u);
    __syncthreads();
    const int task = *nxt;
    if (task >= totalA + 1024) break;
    const bool kindA = task < totalA;
    int bh, kbase0, NT, qt, idx = 0, c0 = 0, c1 = 1;
    if (kindA) {
      if (pre[tid] <= task && task < pre[tid + 1]) *found = tid;
      __syncthreads();
      idx = *found;
      bh = idx >> 4;
      c0 = (task - pre[idx]) * 4;
      const int nch = (cl[idx] + 127) >> 7;
      c1 = c0 + 4 < nch ? c0 + 4 : nch;
      kbase0 = (idx & 15) * 256; NT = 4; qt = 1 << 20;
    } else {
      const int tk = task - totalA;
      qt = 31 - (tk >> 5); bh = tk & 31;
      kbase0 = (qt >> 1) * 256; NT = 2 + 2 * (qt & 1);
    }
    const int b = bh >> 2, h = bh & 3;
    const size_t tokb = (size_t)b * 4096 + kbase0;
    const int NI = NT >> 1;
    {
      u32x4 k0[2], v0[2], k1[2], v1[2];
#pragma unroll
      for (int q2 = 0; q2 < 2; ++q2) {
        const size_t g0_ = (tokb + q2 * 64 + skey) * 256 + h * 64 + sd;
        k0[q2] = *(const u32x4*)(mk + g0_); v0[q2] = *(const u32x4*)(mv + g0_);
        const size_t g1_ = (tokb + (NI > 1 ? 128 : 0) + q2 * 64 + skey) * 256 + h * 64 + sd;
        k1[q2] = *(const u32x4*)(mk + g1_); v1[q2] = *(const u32x4*)(mv + g1_);
      }
#pragma unroll
      for (int q2 = 0; q2 < 2; ++q2) {
        *(u32x4*)(Ks + (q2 * 64 + skey) * MB_STRIDE + sd) = k0[q2]; *(u32x4*)(Vs + (q2 * 64 + skey) * MB_STRIDE + sd) = v0[q2];
        *(u32x4*)(Ks + (128 + q2 * 64 + skey) * MB_STRIDE + sd) = k1[q2]; *(u32x4*)(Vs + (128 + q2 * 64 + skey) * MB_STRIDE + sd) = v1[q2];
      }
    }
    asm volatile("s_waitcnt lgkmcnt(0)" ::: "memory"); __builtin_amdgcn_s_barrier(); asm volatile("" ::: "memory");
    for (int ch = c0; ch < c1; ++ch) {
    int tl, slot; bool mine;
    if (kindA) {
      const int eidx = ch * 128 + w * 16 + l15;
      mine = eidx < cl[idx];
      const unsigned ent = mine ? (unsigned)list[(size_t)idx * 4096 + eidx] : 0u;
      tl = mine ? (int)(ent & 0xfffu) : ((idx & 15) + 1) * 256;
      slot = (int)(ent >> 12);
    } else { tl = qt * 128 + w * 16 + l15; mine = true; slot = 3; }
    bf16x8 qf[2];
    {
      const bf16_t* qp = mq + ((size_t)b * 4096 + tl) * 256 + h * 64 + 8 * lg;
      qf[0] = *(const bf16x8*)qp; qf[1] = *(const bf16x8*)(qp + 32);
    }
    const int tlr = tl - kbase0;
    f32x4 OT[4];
#pragma unroll
    for (int dt = 0; dt < 4; ++dt) OT[dt] = (f32x4){0.f, 0.f, 0.f, 0.f};
    float m_run = -1e30f, l_run = 0.f;
#undef MB_ITER
    const float SC = 0.18033688011112042f;
#define MB_ITER(itx, LK, LV, SK, SV) do { const int it = (itx); if (it < NI) { \
      const int cur = it & 1; \
      const int kb = it * 128; \
      if (__ballot(mine) != 0ull) { \
        const bf16_t* Kc = Ks + cur * 128 * MB_STRIDE + l15 * MB_STRIDE + 8 * lg; \
        const bf16_t* Vc = Vs + cur * 128 * MB_STRIDE + (4 * lg + (l15 >> 2)) * MB_STRIDE + 4 * (l15 & 3); \
        f32x4 sT[8]; \
      _Pragma("unroll") \
        for (int kt = 0; kt < 8; ++kt) { \
          sT[kt] = (f32x4){0.f, 0.f, 0.f, 0.f}; \
      _Pragma("unroll") \
          for (int ks = 0; ks < 2; ++ks) { \
            const bf16x8 ka = *(const bf16x8*)(Kc + (16 * kt) * MB_STRIDE + 32 * ks); \
            sT[kt] = __builtin_amdgcn_mfma_f32_16x16x32_bf16(ka, qf[ks], sT[kt], 0, 0, 0); \
          } \
        } \
        if (__builtin_expect(__builtin_amdgcn_readfirstlane((int)(!kindA && kbase0 + kb + 127 > qt * 128 + w * 16)) != 0, 0)) { asm volatile("; diag tile" ::: "memory"); \
      _Pragma("unroll") \
          for (int kt = 0; kt < 8; ++kt) \
      _Pragma("unroll") \
            for (int r = 0; r < 4; ++r) sT[kt][r] = (kb + 16 * kt + 4 * lg + r <= tlr) ? sT[kt][r] : -INFINITY; \
        } \
        float lmax = fmaxf(fmaxf(sT[0][0], sT[0][1]), fmaxf(sT[0][2], sT[0][3])); \
      _Pragma("unroll") \
        for (int kt = 1; kt < 8; ++kt) lmax = fmaxf(lmax, fmaxf(fmaxf(sT[kt][0], sT[kt][1]), fmaxf(sT[kt][2], sT[kt][3]))); \
        lmax *= SC; \
        if (__ballot(mine && lmax > m_run + 16.f) != 0ull) { \
          float tmax = fmaxf(lmax, shx(lmax, 16, lane)); \
          tmax = fmaxf(tmax, shx(tmax, 32, lane)); \
          const float m_new = mine ? fmaxf(m_run, tmax) : m_run; \
          const float alpha = __builtin_amdgcn_exp2f(m_run - m_new); \
          l_run *= alpha; \
      _Pragma("unroll") \
          for (int dt = 0; dt < 4; ++dt) OT[dt] = OT[dt] * alpha; \
          m_run = m_new; \
        } \
        const float nb = mine ? -m_run : -INFINITY; \
        float psum = 0.f; \
        unsigned pp[16]; \
      _Pragma("unroll") \
        for (int kt = 0; kt < 8; ++kt) { \
          const float p0 = __builtin_amdgcn_exp2f(fmaf(sT[kt][0], SC, nb)), p1 = __builtin_amdgcn_exp2f(fmaf(sT[kt][1], SC, nb)); \
          const float p2 = __builtin_amdgcn_exp2f(fmaf(sT[kt][2], SC, nb)), p3 = __builtin_amdgcn_exp2f(fmaf(sT[kt][3], SC, nb)); \
          psum += (p0 + p1) + (p2 + p3); \
          pp[kt * 2] = cvt_pk_bf16(p0, p1); pp[kt * 2 + 1] = cvt_pk_bf16(p2, p3); \
        } \
        l_run += psum; \
      _Pragma("unroll") \
        for (int ks2 = 0; ks2 < 4; ++ks2) { \
          u32x4 pb; pb.x = pp[ks2 * 4]; pb.y = pp[ks2 * 4 + 1]; pb.z = pp[ks2 * 4 + 2]; pb.w = pp[ks2 * 4 + 3]; \
          const bf16x8 pf = __builtin_bit_cast(bf16x8, pb); \
      _Pragma("unroll") \
          for (int dt = 0; dt < 4; ++dt) { \
            const bf16_t* a0 = Vc + (32 * ks2) * MB_STRIDE + 16 * dt; \
            const s16x4 t0 = __builtin_amdgcn_ds_read_tr16_b64_v4i16((LAS s16x4*)a0); \
            const s16x4 t1 = __builtin_amdgcn_ds_read_tr16_b64_v4i16((LAS s16x4*)(a0 + 16 * MB_STRIDE)); \
            bf16x8 va; va[0] = t0[0]; va[1] = t0[1]; va[2] = t0[2]; va[3] = t0[3]; va[4] = t1[0]; va[5] = t1[1]; va[6] = t1[2]; va[7] = t1[3]; \
            OT[dt] = __builtin_amdgcn_mfma_f32_16x16x32_bf16(va, pf, OT[dt], 0, 0, 0); \
          } \
        } \
      } \
    } } while (0)
    MB_ITER(0, kA, vA, kB, vB);
    MB_ITER(1, kA, vA, kB, vB);
    l_run += shx(l_run, 16, lane);
    l_run += shx(l_run, 32, lane);
    if (mine) {
      const size_t pi = ((size_t)bh * 4096 + tl) * 4 + slot;
      bf16_t* op = part + pi * 64 + 4 * lg;
#pragma unroll
      for (int dt = 0; dt < 4; ++dt) {
        u32x2 wv; wv.x = cvt_pk_bf16(OT[dt][0], OT[dt][1]); wv.y = cvt_pk_bf16(OT[dt][2], OT[dt][3]);
        *(u32x2*)(op + 16 * dt) = wv;
      }
      if (lg == 0) *(f32x2*)(mlp + pi * 2) = (f32x2){m_run, l_run};
    }
    }
  }
}

#define A_S5K 0
#define A_S5E (1 * MiB)
#define A_S5C (5 * MiB)
#define A_S5A64 (9 * MiB)
__device__ __forceinline__ void s5_tables(const int WID, KP p, int l, unsigned char* lds) {
  const int tid = lt();
  float* apr = (float*)lds;
  float* api = apr + 64 * 66;
  float* bbr = api + 64 * 66;
  float* bbi = bbr + 1024;
  float* crs = bbi + 1024;
  float* cis = crs + 1024;
  float* zz = cis + 1024;
  bf16_t* Kt = (bf16_t*)(p->ws + WS_A + A_S5K);
  bf16_t* Et = (bf16_t*)(p->ws + WS_A + A_S5E);
  bf16_t* Ct = (bf16_t*)(p->ws + WS_A + A_S5C);
  float* A64 = (float*)(p->ws + WS_A + A_S5A64);
  for (int task = (int)gridDim.x - 1 - (int)blockIdx.x; task < 256; task += gridDim.x) {
    const int g = task >> 4, part = task & 15;
    if (tid < 64) {
      const int pp = tid;
      const float dt = expf(p->in[I_S5LDT][l * 16 + g]);
      const float lr = p->in[I_S5ARE][l * 1024 + g * 64 + pp], li = p->in[I_S5AIM][l * 1024 + g * 64 + pp];
      const float er = expf(lr * dt);
      const float ar = er * cosf(li * dt), ai = er * sinf(li * dt);
      const float nr = ar - 1.f, ni = ai, den = lr * lr + li * li;
      const float fr = (nr * lr + ni * li) / den, fi = (ni * lr - nr * li) / den;
      zz[pp] = lr * dt; zz[64 + pp] = li * dt;
#pragma unroll
      for (int h = 0; h < 16; ++h) {
        const float br = p->in[I_S5BRE][(size_t)l * 16384 + (g * 64 + pp) * 16 + h], bi = p->in[I_S5BIM][(size_t)l * 16384 + (g * 64 + pp) * 16 + h];
        bbr[pp * 16 + h] = fr * br - fi * bi; bbi[pp * 16 + h] = fr * bi + fi * br;
      }
    }
    for (int i = tid; i < 1024; i += NTHR) { crs[i] = p->in[I_S5CRE][(size_t)l * 16384 + g * 1024 + i]; cis[i] = p->in[I_S5CIM][(size_t)l * 16384 + g * 1024 + i]; }
    __syncthreads();
    for (int idx = tid; idx < 64 * 65; idx += NTHR) {
      const int pp = idx / 65, tau = idx - pp * 65;
      const float er = expf(zz[pp] * (float)tau);
      float sn, cs; sincosf(zz[64 + pp] * (float)tau, &sn, &cs);
      apr[pp * 66 + tau] = er * cs; api[pp * 66 + tau] = er * sn;
    }
    __syncthreads();
    for (int e = tid; e < 1024; e += NTHR) {
      const int tau = part * 4 + (e >> 8), h = (e >> 4) & 15, hp = e & 15;
      float s = 0.f;
      for (int pp = 0; pp < 64; ++pp) {
        const float ar = apr[pp * 66 + tau], ai = api[pp * 66 + tau], cr = crs[h * 64 + pp], ci = cis[h * 64 + pp];
        const float mr = cr * ar - ci * ai, mi = cr * ai + ci * ar;
        s += mr * bbr[pp * 16 + hp] - mi * bbi[pp * 16 + hp];
      }
      Kt[((size_t)g * 65 + tau + 1) * 256 + h * 16 + hp] = f2bf(s);
    }
    if (part == 0 && tid < 256) Kt[(size_t)g * 65 * 256 + tid] = 0;
    for (int e = tid; e < 8192; e += NTHR) {
      const int pq = part * 8 + (e >> 10), k = e & 1023, j = k >> 4, hp = k & 15;
      const int pp = pq & 63;
      const float ar = apr[pp * 66 + 63 - j], ai = api[pp * 66 + 63 - j], br = bbr[pp * 16 + hp], bi = bbi[pp * 16 + hp];
      const float v = (pq < 64) ? (ar * br - ai * bi) : (ar * bi + ai * br);
      Et[((size_t)g * 128 + pq) * 1024 + k] = f2bf(v);
    }
    for (int e = tid; e < 8192; e += NTHR) {
      const int row = part * 64 + (e >> 7), pq = e & 127, t = row >> 4, h = row & 15, pp = pq & 63;
      const float ar = apr[pp * 66 + t + 1], ai = api[pp * 66 + t + 1], cr = crs[h * 64 + pp], ci = cis[h * 64 + pp];
      const float v = (pq < 64) ? (cr * ar - ci * ai) : -(cr * ai + ci * ar);
      Ct[((size_t)g * 1024 + row) * 128 + pq] = f2bf(v);
    }
    if (part == 0 && tid < 64) { A64[(g * 64 + tid) * 2] = apr[tid * 66 + 64]; A64[(g * 64 + tid) * 2 + 1] = api[tid * 66 + 64]; }
    __syncthreads();
  }
}

__device__ __forceinline__ void s5_mfma(const int WID, KP p, int l, unsigned char* lds) {
  const int tid = lt(), lane = tid & 63, l15 = lane & 15, lg = lane >> 4, w = WID, m = w & 3, tpar = w >> 2;
  bf16_t* Ktab = (bf16_t*)lds;
  float* Eloc = (float*)(lds + 65536);
  bf16_t* Sprev = (bf16_t*)(lds + 65536 + 33792);
  const bf16_t* s5u = (const bf16_t*)(p->ws + WS_B + B_S5U);
  bf16_t* zg = (bf16_t*)(p->ws + WS_D + D_ZG);
  const bf16_t* Kt = (const bf16_t*)(p->ws + WS_A + A_S5K);
  const bf16_t* Et = (const bf16_t*)(p->ws + WS_A + A_S5E);
  const bf16_t* Ct = (const bf16_t*)(p->ws + WS_A + A_S5C);
  const float* A64 = (const float*)(p->ws + WS_A + A_S5A64);
  for (int task = (int)gridDim.x - 1 - (int)blockIdx.x; task < 128; task += gridDim.x) {
    const int b = task >> 4, g = task & 15;
    const size_t tokb = (size_t)b * 4096;
    for (int i = lt(); i < 128 * 256 / 8; i += NTHR)
      ((u32x4*)Ktab)[i] = (i >= 63 * 32) ? ((const u32x4*)(Kt + (size_t)g * 65 * 256))[i - 63 * 32] : (u32x4){0u, 0u, 0u, 0u};
    bf16x8 ua[32];
#pragma unroll
    for (int jp = 0; jp < 32; ++jp)
      ua[jp] = *(const bf16x8*)(s5u + (tokb + (size_t)(16 * m + l15) * 64 + 2 * jp + (lg >> 1)) * 256 + g * 16 + 8 * (lg & 1));
#pragma unroll 1
    for (int q = 0; q < 4; ++q) {
      const int nt = tpar * 4 + q;
      f32x4 acc = (f32x4){0.f, 0.f, 0.f, 0.f};
      const bf16_t* ep = Et + ((size_t)g * 128 + 16 * nt + l15) * 1024 + 8 * lg;
#pragma unroll
      for (int jp = 0; jp < 32; ++jp) acc = __builtin_amdgcn_mfma_f32_16x16x32_bf16(ua[jp], *(const bf16x8*)(ep + 32 * jp), acc, 0, 0, 0);
#pragma unroll
      for (int r = 0; r < 4; ++r) Eloc[(16 * m + 4 * lg + r) * 132 + 16 * nt + l15] = acc[r];
    }
    __syncthreads();
    if (tid < 64) {
      const float ar = A64[(g * 64 + tid) * 2], ai = A64[(g * 64 + tid) * 2 + 1];
      float sr = 0.f, si = 0.f;
      for (int c = 0; c < 64; ++c) {
        Sprev[c * 136 + tid] = f2bf(sr); Sprev[c * 136 + 64 + tid] = f2bf(si);
        const float er = Eloc[c * 132 + tid], ei = Eloc[c * 132 + 64 + tid];
        const float nsr = ar * sr - ai * si + er, nsi = ar * si + ai * sr + ei;
        sr = nsr; si = nsi;
      }
    }
    __syncthreads();
    bf16x8 sA[4];
#pragma unroll
    for (int kk = 0; kk < 4; ++kk) sA[kk] = *(const bf16x8*)(Sprev + (16 * m + l15) * 136 + 32 * kk + 8 * lg);
    const float dval = p->in[I_S5D][l * 256 + g * 16 + l15];
    bf16x8 cf0[4], cf1[4], cf2[4];
    unsigned short uu0[4], uu1[4], uu2[4];
#define S5_LOAD(cf, uu, ii) do { const int t_ = 2 * ((ii) < 32 ? (ii) : 31) + tpar; \
      const bf16_t* cp_ = Ct + ((size_t)g * 1024 + t_ * 16 + l15) * 128 + 8 * lg; \
      _Pragma("unroll") for (int kk = 0; kk < 4; ++kk) cf[kk] = *(const bf16x8*)(cp_ + 32 * kk); } while (0)
#define S5_STEP(cf, uu, ii) do { if ((ii) < 32) { const int t = 2 * (ii) + tpar; \
      _Pragma("unroll") for (int r = 0; r < 4; ++r) uu[r] = s5u[(tokb + (size_t)(16 * m + 4 * lg + r) * 64 + t) * 256 + g * 16 + l15]; \
      f32x4 acc = (f32x4){0.f, 0.f, 0.f, 0.f}; \
      _Pragma("unroll") for (int kk = 0; kk < 4; ++kk) acc = __builtin_amdgcn_mfma_f32_16x16x32_bf16(sA[kk], cf[kk], acc, 0, 0, 0); \
      const bf16_t* kb = Ktab + (t - (lg >> 1) + 64) * 256 + l15 * 16 + 8 * (lg & 1); \
      _Pragma("unroll") for (int jp = 0; jp < 32; ++jp) acc = __builtin_amdgcn_mfma_f32_16x16x32_bf16(ua[jp], *(const bf16x8*)(kb - jp * 512), acc, 0, 0, 0); \
      _Pragma("unroll") for (int r = 0; r < 4; ++r) { const size_t tok = tokb + (size_t)(16 * m + 4 * lg + r) * 64 + t; \
        zg[tok * 256 + g * 16 + l15] = f2bf(gelu_f(acc[r] + dval * bf2f(uu[r]))); } } } while (0)
    S5_LOAD(cf0, uu0, 0); S5_LOAD(cf1, uu1, 1);
#pragma unroll 1
    for (int i = 0; i < 33; i += 3) {
      S5_LOAD(cf2, uu2, i + 2); S5_STEP(cf0, uu0, i);
      S5_LOAD(cf0, uu0, i + 3); S5_STEP(cf1, uu1, i + 1);
      S5_LOAD(cf1, uu1, i + 4); S5_STEP(cf2, uu2, i + 2);
    }
    __syncthreads();
  }
}

#define D_TU8 0
#define D_TV8 (16 * MiB)
__device__ __forceinline__ void conv_flat8(const int WID, const float* src, unsigned char* dst, size_t n, float scale) {
  const size_t stride = (size_t)gridDim.x * NTHR * 16;
  for (size_t i = ((size_t)blockIdx.x * NTHR + lt()) * 16; i < n; i += stride) {
    u32x4 w;
#pragma unroll
    for (int q = 0; q < 4; ++q) {
      const f32x4 a = *(const f32x4*)(src + i + 4 * q) * scale;
      int x = __builtin_amdgcn_cvt_pk_fp8_f32(a[0], a[1], 0, false);
      x = __builtin_amdgcn_cvt_pk_fp8_f32(a[2], a[3], x, true);
      w[q] = (unsigned)x;
    }
    *(u32x4*)(dst + ((i >> 7) & 7) * (size_t)(16384 * 128) + (i >> 10) * 128 + (i & 127)) = w;
  }
}
#define CE_D(a, b) { const float hi_ = fmaxf(a, b), lo_ = fminf(a, b); a = hi_; b = lo_; }
__device__ __forceinline__ void sort16_desc(float (&x)[16]) {
#pragma unroll
  for (int k = 2; k <= 16; k <<= 1) {
#pragma unroll
    for (int j = k >> 1; j > 0; j >>= 1) {
#pragma unroll
      for (int i = 0; i < 16; ++i) {
        const int l = i ^ j;
        if (l > i) {
          const float a = x[i], b = x[l];
          if ((i & k) == 0) { x[i] = fmaxf(a, b); x[l] = fminf(a, b); } else { x[i] = fminf(a, b); x[l] = fmaxf(a, b); }
        }
      }
    }
  }
}
__device__ __forceinline__ void merge16_desc(float (&a)[16], const float (&b)[16]) {
#pragma unroll
  for (int i = 0; i < 16; ++i) a[i] = fmaxf(a[i], b[15 - i]);
#pragma unroll
  for (int j = 8; j > 0; j >>= 1) {
#pragma unroll
    for (int i = 0; i < 16; ++i) { const int l = i ^ j; if (l > i) CE_D(a[i], a[l]); }
  }
}
__device__ __forceinline__ float h16f(unsigned h) { return (float)__builtin_bit_cast(_Float16, (unsigned short)h); }

__device__ __forceinline__ void peer_fast(const int WID, KP p, int l, unsigned char* lds, const bool dry) {
  const int tid = lt(), hd = WID, lane = tid & 63;
  float* red = (float*)lds;
  unsigned short* rt_e = (unsigned short*)(lds + 32768);
  float* rt_g = (float*)(lds + 40960);
  float* sred = (float*)(lds + 57344);
  float* w8 = (float*)(lds + 58368);
  const bool last = (l == 1);
  const unsigned short* sc = (const unsigned short*)(p->ws + WS_B + B_SCORE);
  bf16_t* h = (bf16_t*)(p->ws + WS_A);
  const unsigned char* tu = p->ws + WS_D + D_TU8;
  const unsigned char* tv = p->ws + WS_D + D_TV8;
  const float* mod = (const float*)(p->ws + WS_MISC + MISC_MOD);
  float* x = p->out;
  float* ba = (float*)(p->ws + WS_B + B_BA);
  if (!last) {
    const float* w_in_n = p->in[I_WIN] + (size_t)(l + 1) * 1024 * IN_COLS;
    for (int i = tid; i < 8192; i += NTHR) w8[i] = w_in_n[(size_t)(i >> 3) * IN_COLS + 2048 + (i & 7)];
  }
  for (int tile = blockIdx.x; tile < TOK / 32; tile += gridDim.x) {
    __syncthreads();
    {
      const int tokl = tid >> 4, list = tid & 15;
      const unsigned short* sp = sc + (size_t)(tile * 32 + tokl) * 2048 + list * 128;
      float best[16];
#pragma unroll 1
      for (int grp = 0; grp < 8; ++grp) {
        const u32x4 r0 = *(const u32x4*)(sp + grp * 16), r1 = *(const u32x4*)(sp + grp * 16 + 8);
        float cur[16];
#pragma unroll
        for (int q = 0; q < 4; ++q) {
          const unsigned w0 = r0[q], w1 = r1[q];
          cur[2 * q] = __uint_as_float(__float_as_uint(h16f(w0 & 0xffffu)) | (unsigned)(grp * 16 + 2 * q));
          cur[2 * q + 1] = __uint_as_float(__float_as_uint(h16f(w0 >> 16)) | (unsigned)(grp * 16 + 2 * q + 1));
          cur[8 + 2 * q] = __uint_as_float(__float_as_uint(h16f(w1 & 0xffffu)) | (unsigned)(grp * 16 + 8 + 2 * q));
          cur[8 + 2 * q + 1] = __uint_as_float(__float_as_uint(h16f(w1 >> 16)) | (unsigned)(grp * 16 + 8 + 2 * q + 1));
        }
        sort16_desc(cur);
        if (grp == 0) {
#pragma unroll
          for (int i = 0; i < 16; ++i) best[i] = cur[i];
        } else merge16_desc(best, cur);
      }
      float v1[16], v2[16];
      const bool ishalf1 = (list & 1) != 0;
#pragma unroll
      for (int i = 0; i < 16; ++i) {
        const float o = shx(best[i], 1, lane);
        v1[i] = ishalf1 ? o : best[i];
        v2[i] = ishalf1 ? best[i] : o;
      }
      float c[4][16];
#pragma unroll
      for (int i = 0; i < 64; ++i) c[i >> 4][i & 15] = -INFINITY;
      {
        int n = 0;
#pragma unroll
        for (int a = 0; a < 16; ++a) {
#pragma unroll
          for (int bq = 0; bq < 16; ++bq) {
            if ((a + 1) * (bq + 1) <= 16) {
              const unsigned ua_ = __float_as_uint(v1[a]), ub_ = __float_as_uint(v2[bq]);
              const float s = __uint_as_float(ua_ & ~0x7fu) + __uint_as_float(ub_ & ~0x7fu);
              c[n >> 4][n & 15] = __uint_as_float((__float_as_uint(s) & ~0x3fffu) | ((ua_ & 0x7fu) << 7) | (ub_ & 0x7fu));
              ++n;
            }
          }
        }
      }
      sort16_desc(c[0]); sort16_desc(c[1]); sort16_desc(c[2]); sort16_desc(c[3]);
      merge16_desc(c[0], c[1]); merge16_desc(c[2], c[3]); merge16_desc(c[0], c[2]);
      const float s0 = __uint_as_float(__float_as_uint(c[0][0]) & ~0x3fffu);
      float e[16], esum = 0.f;
#pragma unroll
      for (int i = 0; i < 16; ++i) { e[i] = __expf(__uint_as_float(__float_as_uint(c[0][i]) & ~0x3fffu) - s0); esum += e[i]; }
      const float inv = 1.f / esum;
      if (!ishalf1) {
        const int o = tokl * 128 + (list >> 1) * 16;
#pragma unroll
        for (int i = 0; i < 16; ++i) { rt_e[o + i] = (unsigned short)(__float_as_uint(c[0][i]) & 0x3fffu); rt_g[o + i] = e[i] * inv; }
      }
    }
    __syncthreads();
    for (int tk = 0; tk < 32; ++tk) {
      const int t = tile * 32 + tk, b = t >> 12;
      float hv[16];
      {
        const u32x4 a = *(const u32x4*)(h + (size_t)t * 1024 + lane * 16), c2 = *(const u32x4*)(h + (size_t)t * 1024 + lane * 16 + 8);
        hv[0] = bflo(a.x); hv[1] = bfhi(a.x); hv[2] = bflo(a.y); hv[3] = bfhi(a.y); hv[4] = bflo(a.z); hv[5] = bfhi(a.z); hv[6] = bflo(a.w); hv[7] = bfhi(a.w);
        hv[8] = bflo(c2.x); hv[9] = bfhi(c2.x); hv[10] = bflo(c2.y); hv[11] = bfhi(c2.y); hv[12] = bflo(c2.z); hv[13] = bfhi(c2.z); hv[14] = bflo(c2.w); hv[15] = bfhi(c2.w);
      }
      u32x4 ur[16], vr[16];
      unsigned eidv = rt_e[tk * 128 + hd * 16 + (lane & 15)];
#pragma unroll
      for (int k = 0; k < 16; ++k) {
        const unsigned e = (unsigned)__builtin_amdgcn_readlane((int)eidv, k);
        ur[k] = *(const u32x4*)(tu + (size_t)e * 1024 + lane * 16);
      }
#pragma unroll
      for (int k = 0; k < 16; ++k) {
        const unsigned e = (unsigned)__builtin_amdgcn_readlane((int)eidv, k);
        vr[k] = *(const u32x4*)(tv + (size_t)e * 1024 + lane * 16);
      }
      float pt[16];
#pragma unroll
      for (int k = 0; k < 16; ++k) {
        float s = 0.f;
#pragma unroll
        for (int q = 0; q < 4; ++q) {
          const f32x2 lo = __builtin_amdgcn_cvt_pk_f32_fp8((int)ur[k][q], false), hi = __builtin_amdgcn_cvt_pk_f32_fp8((int)ur[k][q], true);
          s += hv[4 * q] * lo[0] + hv[4 * q + 1] * lo[1] + hv[4 * q + 2] * hi[0] + hv[4 * q + 3] * hi[1];
        }
        pt[k] = s;
      }
      float r8[8], r4[4], r2[2], r1;
      {
        const bool up = (lane & 32) != 0;
#pragma unroll
        for (int k = 0; k < 8; ++k) { const float snd = up ? pt[k] : pt[k + 8], keep = up ? pt[k + 8] : pt[k]; r8[k] = keep + shx(snd, 32, lane); }
      }
      {
        const bool up = (lane & 16) != 0;
#pragma unroll
        for (int k = 0; k < 4; ++k) { const float snd = up ? r8[k] : r8[k + 4], keep = up ? r8[k + 4] : r8[k]; r4[k] = keep + shx(snd, 16, lane); }
      }
      {
        const bool up = (lane & 8) != 0;
#pragma unroll
        for (int k = 0; k < 2; ++k) { const float snd = up ? r4[k] : r4[k + 2], keep = up ? r4[k + 2] : r4[k]; r2[k] = keep + shx(snd, 8, lane); }
      }
      {
        const bool up = (lane & 4) != 0;
        const float snd = up ? r2[0] : r2[1], keep = up ? r2[1] : r2[0];
        r1 = keep + shx(snd, 4, lane);
      }
      r1 += shx(r1, 2, lane);
      r1 += shx(r1, 1, lane);
      const int myk = ((lane >> 5) & 1) * 8 + ((lane >> 4) & 1) * 4 + ((lane >> 3) & 1) * 2 + ((lane >> 2) & 1);
      const float wmine = rt_g[tk * 128 + hd * 16 + myk] * gelu_f(r1 * (1.f / 64.f)) * 0.25f;
      float acc[16];
#pragma unroll
      for (int j = 0; j < 16; ++j) acc[j] = 0.f;
#pragma unroll
      for (int k = 0; k < 16; ++k) {
        const int owner = ((k >> 3) & 1) * 32 + ((k >> 2) & 1) * 16 + ((k >> 1) & 1) * 8 + (k & 1) * 4;
        const float wk = __int_as_float(__builtin_amdgcn_readlane(__float_as_int(wmine), owner));
#pragma unroll
        for (int q = 0; q < 4; ++q) {
          const f32x2 lo = __builtin_amdgcn_cvt_pk_f32_fp8((int)vr[k][q], false), hi = __builtin_amdgcn_cvt_pk_f32_fp8((int)vr[k][q], true);
          acc[4 * q] += wk * lo[0]; acc[4 * q + 1] += wk * lo[1]; acc[4 * q + 2] += wk * hi[0]; acc[4 * q + 3] += wk * hi[1];
        }
      }
#pragma unroll
      for (int q = 0; q < 4; ++q) *(f32x4*)(red + hd * 1024 + lane * 16 + 4 * q) = (f32x4){acc[4 * q], acc[4 * q + 1], acc[4 * q + 2], acc[4 * q + 3]};
      __syncthreads();
      const int c0 = tid * 2;
      float o0 = 0.f, o1 = 0.f;
#pragma unroll
      for (int j = 0; j < 8; ++j) { const f32x2 rr = *(const f32x2*)(red + j * 1024 + c0); o0 += rr[0]; o1 += rr[1]; }
      const float* g2 = mod + ((size_t)l * 8 + b) * 6144 + 5120;
      float* xr = x + (size_t)t * 1024 + c0;
      const f32x2 xin = *(const f32x2*)xr, g2v = *(const f32x2*)(g2 + c0);
      const float x0 = xin[0] + g2v[0] * o0, x1 = xin[1] + g2v[1] * o1;
      float ss = WSUM(x0 * x0 + x1 * x1);
      if (lane == 0) sred[hd * 9 + 8] = ss;
      __syncthreads();
      ss = 0.f;
#pragma unroll
      for (int j = 0; j < 8; ++j) ss += sred[j * 9 + 8];
      const float r = rsqrtf(ss * (1.f / 1024.f) + 1e-6f);
      if (dry) { if (x0 == 1.2345e30f) xr[0] = x0; __syncthreads(); }
      else if (last) {
        const f32x2 fw = *(const f32x2*)(p->in[I_FNW] + c0);
        *(f32x2*)xr = (f32x2){x0 * r * fw[0], x1 * r * fw[1]};
      } else {
        *(f32x2*)xr = (f32x2){x0, x1};
        const float* nw = p->in[I_N1W] + (l + 1) * 1024;
        const float* mn = mod + ((size_t)(l + 1) * 8 + b) * 6144;
        const float h0 = x0 * r * nw[c0] * (1.f + mn[1024 + c0]) + mn[c0];
        const float h1 = x1 * r * nw[c0 + 1] * (1.f + mn[1024 + c0 + 1]) + mn[c0 + 1];
        *(unsigned*)(h + (size_t)t * 1024 + c0) = pk2bf(h0, h1);
        float a8[8];
#pragma unroll
        for (int j = 0; j < 8; ++j) a8[j] = WSUM(h0 * w8[c0 * 8 + j] + h1 * w8[(c0 + 1) * 8 + j]);
        if (lane == 0) {
#pragma unroll
          for (int j = 0; j < 8; ++j) sred[hd * 9 + j] = a8[j];
        }
        __syncthreads();
        if (tid < 8) { float a = 0.f; for (int j = 0; j < 8; ++j) a += sred[j * 9 + tid]; ba[(size_t)t * 8 + tid] = a; }
      }
    }
  }
}

#define D_EID (32 * MiB)
#define D_GATE (40 * MiB)
#define D_WTS (56 * MiB)
#define C_PD 0
#define B_PO 0

__device__ __forceinline__ void peer_route(const int WID, KP p, unsigned char* lds) {
  const int tid = lt(), lane = tid & 63;
  const unsigned short* sc = (const unsigned short*)(p->ws + WS_B + B_SCORE);
  unsigned short* eidg = (unsigned short*)(p->ws + WS_D + D_EID);
  float* gateg = (float*)(p->ws + WS_D + D_GATE);
  for (int tile = blockIdx.x; tile < TOK / 32; tile += gridDim.x) {
    const int tokl = tid >> 4, list = tid & 15;
    const unsigned short* sp = sc + (size_t)(tile * 32 + tokl) * 2048 + list * 128;
    float best[16];
    u32x4 rr[16];
#pragma unroll
    for (int i = 0; i < 16; ++i) rr[i] = *(const u32x4*)(sp + i * 8);
#pragma unroll
    for (int grp = 0; grp < 8; ++grp) {
      const u32x4 r0 = rr[2 * grp], r1 = rr[2 * grp + 1];
      float cur[16];
#pragma unroll
      for (int q = 0; q < 4; ++q) {
        const unsigned w0 = r0[q], w1 = r1[q];
        cur[2 * q] = __uint_as_float(__float_as_uint(h16f(w0 & 0xffffu)) | (unsigned)(grp * 16 + 2 * q));
        cur[2 * q + 1] = __uint_as_float(__float_as_uint(h16f(w0 >> 16)) | (unsigned)(grp * 16 + 2 * q + 1));
        cur[8 + 2 * q] = __uint_as_float(__float_as_uint(h16f(w1 & 0xffffu)) | (unsigned)(grp * 16 + 8 + 2 * q));
        cur[8 + 2 * q + 1] = __uint_as_float(__float_as_uint(h16f(w1 >> 16)) | (unsigned)(grp * 16 + 8 + 2 * q + 1));
      }
      sort16_desc(cur);
      if (grp == 0) {
#pragma unroll
        for (int i = 0; i < 16; ++i) best[i] = cur[i];
      } else merge16_desc(best, cur);
    }
    float v1[16], v2[16];
    const bool ishalf1 = (list & 1) != 0;
#pragma unroll
    for (int i = 0; i < 16; ++i) {
      const float o = shx(best[i], 1, lane);
      v1[i] = ishalf1 ? o : best[i];
      v2[i] = ishalf1 ? best[i] : o;
    }
    float c[4][16];
#pragma unroll
    for (int i = 0; i < 64; ++i) c[i >> 4][i & 15] = -INFINITY;
    {
      int n = 0;
#pragma unroll
      for (int a = 0; a < 16; ++a) {
#pragma unroll
        for (int bq = 0; bq < 16; ++bq) {
          if ((a + 1) * (bq + 1) <= 16) {
            const unsigned ua_ = __float_as_uint(v1[a]), ub_ = __float_as_uint(v2[bq]);
            const float s = __uint_as_float(ua_ & ~0x7fu) + __uint_as_float(ub_ & ~0x7fu);
            c[n >> 4][n & 15] = __uint_as_float((__float_as_uint(s) & ~0x3fffu) | ((ua_ & 0x7fu) << 7) | (ub_ & 0x7fu));
            ++n;
          }
        }
      }
    }
    sort16_desc(c[0]); sort16_desc(c[1]); sort16_desc(c[2]); sort16_desc(c[3]);
    merge16_desc(c[0], c[1]); merge16_desc(c[2], c[3]); merge16_desc(c[0], c[2]);
    const float s0 = __uint_as_float(__float_as_uint(c[0][0]) & ~0x3fffu);
    float e[16], esum = 0.f;
#pragma unroll
    for (int i = 0; i < 16; ++i) { e[i] = __expf(__uint_as_float(__float_as_uint(c[0][i]) & ~0x3fffu) - s0); esum += e[i]; }
    const float inv = 1.f / esum;
    if (!ishalf1) {
      const int hd = list >> 1;
      const size_t o = (size_t)(tile * 32 + tokl) * 128 + (hd >> 2) * 64 + (hd & 3) * 2;
#pragma unroll
      for (int j = 0; j < 16; ++j) {
        const int kp = (j & 7) * 8 + (j >> 3);
        eidg[o + kp] = (unsigned short)(__float_as_uint(c[0][j]) & 0x3fffu);
        gateg[o + kp] = e[j] * inv;
      }
    }
  }
}

__device__ __forceinline__ u32x4 pz_ld_e(const unsigned short* eidg, int t, int half, int r) { return *(const u32x4*)(eidg + (size_t)t * 128 + 64 * half + 8 * r); }
__device__ __forceinline__ void pz_ld_r8(const unsigned char* tab, const u32x4& ep, int off, u32x4 (&rows)[8]) {
#pragma unroll
  for (int i = 0; i < 8; ++i) {
    const unsigned e = (i & 1) ? (ep[i >> 1] >> 16) : (ep[i >> 1] & 0xffffu);
    rows[i] = *(const u32x4*)(tab + (size_t)e * 128 + off);
  }
}
__device__ __forceinline__ void pz_u_half(const float (&hv)[16], const u32x4 (&rows)[8], int lane, float* pdhalf) {
  float pt[8];
#pragma unroll
  for (int i = 0; i < 8; ++i) {
    float s = 0.f;
#pragma unroll
    for (int q = 0; q < 4; ++q) {
      const f32x2 lo = __builtin_amdgcn_cvt_pk_f32_fp8((int)rows[i][q], false), hi = __builtin_amdgcn_cvt_pk_f32_fp8((int)rows[i][q], true);
      s += hv[4 * q] * lo[0] + hv[4 * q + 1] * lo[1] + hv[4 * q + 2] * hi[0] + hv[4 * q + 3] * hi[1];
    }
    pt[i] = s;
  }
  float r4[4], r2[2], r1;
  {
    const bool up = (lane & 4) != 0;
#pragma unroll
    for (int k = 0; k < 4; ++k) { const float snd = up ? pt[k] : pt[k + 4], keep = up ? pt[k + 4] : pt[k]; r4[k] = keep + shx(snd, 4, lane); }
  }
  {
    const bool up = (lane & 2) != 0;
#pragma unroll
    for (int k = 0; k < 2; ++k) { const float snd = up ? r4[k] : r4[k + 2], keep = up ? r4[k + 2] : r4[k]; r2[k] = keep + shx(snd, 2, lane); }
  }
  {
    const bool up = (lane & 1) != 0;
    const float snd = up ? r2[0] : r2[1], keep = up ? r2[1] : r2[0];
    r1 = keep + shx(snd, 1, lane);
  }
  pdhalf[(lane >> 3) * 8 + 4 * ((lane >> 2) & 1) + 2 * ((lane >> 1) & 1) + (lane & 1)] = r1;
}
__device__ __forceinline__ void pz_hv(const u32x4& ha, const u32x4& hb, float (&hv)[16]) {
  hv[0] = bflo(ha.x); hv[1] = bfhi(ha.x); hv[2] = bflo(ha.y); hv[3] = bfhi(ha.y); hv[4] = bflo(ha.z); hv[5] = bfhi(ha.z); hv[6] = bflo(ha.w); hv[7] = bfhi(ha.w);
  hv[8] = bflo(hb.x); hv[9] = bfhi(hb.x); hv[10] = bflo(hb.y); hv[11] = bfhi(hb.y); hv[12] = bflo(hb.z); hv[13] = bfhi(hb.z); hv[14] = bflo(hb.w); hv[15] = bfhi(hb.w);
}
__device__ __forceinline__ void peer_u(const int WID, KP p) {
  const int lane = lane_l(), r = lane >> 3, c = lane & 7;
  const int s = blockIdx.x & 7, tg = blockIdx.x >> 3, ng = gridDim.x >> 3;
  const unsigned short* eidg = (const unsigned short*)(p->ws + WS_D + D_EID);
  const unsigned char* tu = p->ws + WS_D + D_TU8 + (size_t)(blockIdx.x & 7) * (16384 * 128) - 128 * (blockIdx.x & 7);
  const bf16_t* h = (const bf16_t*)(p->ws + WS_A);
  float* pd = (float*)(p->ws + WS_C + C_PD) + (size_t)s * TOK * 128;
  const int off = 128 * s + 16 * c;
  const int ts = ng * 8;
  const int t0 = tg * 8 + WID;
  if (t0 >= TOK) return;
#define CLT(x) ((x) < TOK ? (x) : t0)
  u32x4 rA0[8], rA1[8], rB0[8], rB1[8];
  u32x4 eA0, eA1, eB0, eB1, hA0, hA1, hB0, hB1;
  {
    const int ta = t0, tb = CLT(t0 + ts);
    eA0 = pz_ld_e(eidg, ta, 0, r); eA1 = pz_ld_e(eidg, ta, 1, r); eB0 = pz_ld_e(eidg, tb, 0, r); eB1 = pz_ld_e(eidg, tb, 1, r);
    hA0 = *(const u32x4*)(h + (size_t)ta * 1024 + off); hA1 = *(const u32x4*)(h + (size_t)ta * 1024 + off + 8);
    hB0 = *(const u32x4*)(h + (size_t)tb * 1024 + off); hB1 = *(const u32x4*)(h + (size_t)tb * 1024 + off + 8);
    pz_ld_r8(tu, eA0, off, rA0); pz_ld_r8(tu, eA1, off, rA1); pz_ld_r8(tu, eB0, off, rB0); pz_ld_r8(tu, eB1, off, rB1);
    const int tc = CLT(t0 + 2 * ts), td = CLT(t0 + 3 * ts);
    eA0 = pz_ld_e(eidg, tc, 0, r); eA1 = pz_ld_e(eidg, tc, 1, r); eB0 = pz_ld_e(eidg, td, 0, r); eB1 = pz_ld_e(eidg, td, 1, r);
  }
  for (int t = t0; t < TOK; t += 2 * ts) {
    const int tb = t + ts, tc = CLT(t + 2 * ts), td = CLT(t + 3 * ts), te = CLT(t + 4 * ts), tf = CLT(t + 5 * ts);
    float hv[16];
    pz_hv(hA0, hA1, hv);
    hA0 = *(const u32x4*)(h + (size_t)tc * 1024 + off); hA1 = *(const u32x4*)(h + (size_t)tc * 1024 + off + 8);
    pz_u_half(hv, rA0, lane, pd + (size_t)t * 128);
    pz_ld_r8(tu, eA0, off, rA0); eA0 = pz_ld_e(eidg, te, 0, r);
    pz_u_half(hv, rA1, lane, pd + (size_t)t * 128 + 64);
    pz_ld_r8(tu, eA1, off, rA1); eA1 = pz_ld_e(eidg, te, 1, r);
    if (tb < TOK) {
      pz_hv(hB0, hB1, hv);
      hB0 = *(const u32x4*)(h + (size_t)td * 1024 + off); hB1 = *(const u32x4*)(h + (size_t)td * 1024 + off + 8);
      pz_u_half(hv, rB0, lane, pd + (size_t)tb * 128);
      pz_ld_r8(tu, eB0, off, rB0); eB0 = pz_ld_e(eidg, tf, 0, r);
      pz_u_half(hv, rB1, lane, pd + (size_t)tb * 128 + 64);
      pz_ld_r8(tu, eB1, off, rB1); eB1 = pz_ld_e(eidg, tf, 1, r);
    }
  }
}
__device__ __forceinline__ void peer_w(const int WID, KP p) {
  const float* pd = (const float*)(p->ws + WS_C + C_PD);
  const float* gateg = (const float*)(p->ws + WS_D + D_GATE);
  unsigned short* wts = (unsigned short*)(p->ws + WS_D + D_WTS);
  const size_t n = (size_t)TOK * 128, stride = (size_t)gridDim.x * NTHR * 4;
  for (size_t i = ((size_t)blockIdx.x * NTHR + lt()) * 4; i < n; i += stride) {
    f32x4 a = *(const f32x4*)(pd + i);
#pragma unroll
    for (int s = 1; s < 8; ++s) a = a + *(const f32x4*)(pd + (size_t)s * n + i);
    const f32x4 g = *(const f32x4*)(gateg + i);
    u32x2 wv;
    wv.x = (unsigned)f2h(g[0] * gelu_f(a[0] * (1.f / 64.f)) * 0.25f) | ((unsigned)f2h(g[1] * gelu_f(a[1] * (1.f / 64.f)) * 0.25f) << 16);
    wv.y = (unsigned)f2h(g[2] * gelu_f(a[2] * (1.f / 64.f)) * 0.25f) | ((unsigned)f2h(g[3] * gelu_f(a[3] * (1.f / 64.f)) * 0.25f) << 16);
    *(u32x2*)(wts + i) = wv;
  }
}
__device__ __forceinline__ void pz_v_half(const u32x4& wp, const u32x4 (&rows)[8], float (&acc)[16]) {
#pragma unroll
  for (int i = 0; i < 8; ++i) {
    const float wv = h2f((unsigned short)((i & 1) ? (wp[i >> 1] >> 16) : (wp[i >> 1] & 0xffffu)));
#pragma unroll
    for (int q = 0; q < 4; ++q) {
      const f32x2 lo = __builtin_amdgcn_cvt_pk_f32_fp8((int)rows[i][q], false), hi = __builtin_amdgcn_cvt_pk_f32_fp8((int)rows[i][q], true);
      acc[4 * q] += wv * lo[0]; acc[4 * q + 1] += wv * lo[1]; acc[4 * q + 2] += wv * hi[0]; acc[4 * q + 3] += wv * hi[1];
    }

  }
}
__device__ __forceinline__ void pz_v_finish(const float (&acc)[16], int lane, bf16_t* porow) {
  float r8[8], r4[4], r2[2];
  {
    const bool up = (lane & 32) != 0;
#pragma unroll
    for (int k = 0; k < 8; ++k) { const float snd = up ? acc[k] : acc[k + 8], keep = up ? acc[k + 8] : acc[k]; r8[k] = keep + shx(snd, 32, lane); }
  }
  {
    const bool up = (lane & 16) != 0;
#pragma unroll
    for (int k = 0; k < 4; ++k) { const float snd = up ? r8[k] : r8[k + 4], keep = up ? r8[k + 4] : r8[k]; r4[k] = keep + shx(snd, 16, lane); }
  }
  {
    const bool up = (lane & 8) != 0;
#pragma unroll
    for (int k = 0; k < 2; ++k) { const float snd = up ? r4[k] : r4[k + 2], keep = up ? r4[k + 2] : r4[k]; r2[k] = keep + shx(snd, 8, lane); }
  }
  const int col = 16 * (lane & 7) + 8 * ((lane >> 5) & 1) + 4 * ((lane >> 4) & 1) + 2 * ((lane >> 3) & 1);
  *(unsigned*)(porow + col) = pk2bf(r2[0], r2[1]);
}
__device__ __forceinline__ u32x4 pz_ld_w(const unsigned short* wts, int t, int half, int r) { return *(const u32x4*)(wts + (size_t)t * 128 + 64 * half + 8 * r); }
__device__ __forceinline__ void peer_v(const int WID, KP p, int l, const bool dry) {
  const int lane = lane_l(), r = lane >> 3, c = lane & 7;
  const int s = blockIdx.x & 7, tg = blockIdx.x >> 3, ng = gridDim.x >> 3;
  const unsigned short* eidg = (const unsigned short*)(p->ws + WS_D + D_EID);
  const unsigned short* wts = (const unsigned short*)(p->ws + WS_D + D_WTS);
  const unsigned char* tv = p->ws + WS_D + D_TV8 + (size_t)(blockIdx.x & 7) * (16384 * 128) - 128 * (blockIdx.x & 7);
  bf16_t* po = (bf16_t*)(p->ws + WS_B + B_PO) + 128 * s;
  const int off = 128 * s + 16 * c;
  const int ts = ng * 8;
  const int t0 = tg * 8 + WID;
  if (t0 >= TOK) return;
  u32x4 rA[8], rB[8], eA, eB, wA, wB, nA, nB, nwA, nwB;
  eA = pz_ld_e(eidg, t0, 0, r); eB = pz_ld_e(eidg, t0, 1, r); wA = pz_ld_w(wts, t0, 0, r); wB = pz_ld_w(wts, t0, 1, r);
  pz_ld_r8(tv, eA, off, rA);
  { const int tn = CLT(t0 + ts); nA = pz_ld_e(eidg, tn, 0, r); nB = pz_ld_e(eidg, tn, 1, r); nwA = pz_ld_w(wts, tn, 0, r); nwB = pz_ld_w(wts, tn, 1, r); }
  for (int t = t0; t < TOK; t += ts) {
    const int tn2 = CLT(t + 2 * ts);
    pz_ld_r8(tv, eB, off, rB);
    float acc[16];
#pragma unroll
    for (int j = 0; j < 16; ++j) acc[j] = 0.f;
    pz_v_half(wA, rA, acc);
    pz_ld_r8(tv, nA, off, rA);
    pz_v_half(wB, rB, acc);
    pz_v_finish(acc, lane, po + (size_t)t * 1024);
    eB = nB; wA = nwA; wB = nwB;
    nA = pz_ld_e(eidg, tn2, 0, r); nB = pz_ld_e(eidg, tn2, 1, r); nwA = pz_ld_w(wts, tn2, 0, r); nwB = pz_ld_w(wts, tn2, 1, r);
  }
}
__device__ __forceinline__ void phase_resnorm(const int WID, KP p, int l, unsigned char* lds) {
  const int tid = lt(), wave = tid >> 6, lane = tid & 63;
  const bool last = (l == 1);
  float* w8 = (float*)lds;
  float* x = p->out;
  const bf16_t* po = (const bf16_t*)(p->ws + WS_B + B_PO);
  const float* mod = (const float*)(p->ws + WS_MISC + MISC_MOD);
  bf16_t* h = (bf16_t*)(p->ws + WS_A);
  float* ba = (float*)(p->ws + WS_B + B_BA);
  if (!last) {
    const float* w_in_n = p->in[I_WIN] + (size_t)(l + 1) * 1024 * IN_COLS;
    for (int i = tid; i < 8192; i += NTHR) w8[i] = w_in_n[(size_t)(i >> 3) * IN_COLS + 2048 + (i & 7)];
    __syncthreads();
  }
  for (int t = blockIdx.x * 8 + wave; t < TOK; t += gridDim.x * 8) {
    const int b = t >> 12;
    const float* g2 = mod + ((size_t)l * 8 + b) * 6144 + 5120;
    f32x4 v[4];
    float ss = 0.f;
#pragma unroll
    for (int i = 0; i < 4; ++i) {
      const int c = i * 256 + lane * 4;
      const u32x2 pv = *(const u32x2*)(po + (size_t)t * 1024 + c);
      const f32x4 gv = *(const f32x4*)(g2 + c);
      const u32x2 xw = *(const u32x2*)((const bf16_t*)x + (size_t)t * 2048 + c);
      v[i] = (f32x4){bflo(xw.x), bfhi(xw.x), bflo(xw.y), bfhi(xw.y)} + gv * (f32x4){bflo(pv.x), bfhi(pv.x), bflo(pv.y), bfhi(pv.y)};
      ss += v[i][0] * v[i][0] + v[i][1] * v[i][1] + v[i][2] * v[i][2] + v[i][3] * v[i][3];
    }
    ss = WSUM(ss);
    const float r = rsqrtf(ss * (1.f / 1024.f) + 1e-6f);
    if (last) {
#pragma unroll
      for (int i = 0; i < 4; ++i) *(f32x4*)(x + (size_t)t * 1024 + i * 256 + lane * 4) = v[i] * r * *(const f32x4*)(p->in[I_FNW] + i * 256 + lane * 4);
    } else {
      const float* nw = p->in[I_N1W] + (l + 1) * 1024;
      const float* mn = mod + ((size_t)(l + 1) * 8 + b) * 6144;
      float a8[8];
#pragma unroll
      for (int j = 0; j < 8; ++j) a8[j] = 0.f;
#pragma unroll
      for (int i = 0; i < 4; ++i) {
        const int c = i * 256 + lane * 4;
        { u32x2 xo; xo.x = pk2bf(v[i][0], v[i][1]); xo.y = pk2bf(v[i][2], v[i][3]); *(u32x2*)((bf16_t*)x + (size_t)t * 2048 + c) = xo; }
        const f32x4 hv = v[i] * r * *(const f32x4*)(nw + c) * (*(const f32x4*)(mn + 1024 + c) + 1.f) + *(const f32x4*)(mn + c);
        u32x2 wv; wv.x = pk2bf(hv[0], hv[1]); wv.y = pk2bf(hv[2], hv[3]);
        *(u32x2*)(h + (size_t)t * 1024 + c) = wv;
        { int q = __builtin_amdgcn_cvt_pk_fp8_f32(hv[0], hv[1], 0, false); q = __builtin_amdgcn_cvt_pk_fp8_f32(hv[2], hv[3], q, true); *(int*)((unsigned char*)x + (size_t)t * 4096 + 2048 + c) = q; }
#pragma unroll
        for (int k = 0; k < 4; ++k)
#pragma unroll
          for (int j = 0; j < 8; ++j) a8[j] += hv[k] * w8[(c + k) * 8 + j];
      }
      const float tot = reduce8(a8, lane);
      if ((lane & 7) == 0) ba[(size_t)t * 8 + ((lane >> 5) & 1) * 4 + ((lane >> 4) & 1) * 2 + ((lane >> 3) & 1)] = tot;
    }
  }
  __syncthreads();
}
__device__ __forceinline__ void phase_final(const int WID, KP p) {
  const int tid = lt(), wave = tid >> 6, lane = tid & 63;
  float* x = p->out;
  const float* fw = p->in[I_FNW];
  for (int t = blockIdx.x * 8 + wave; t < TOK; t += gridDim.x * 8) {
    f32x4 v[4];
    float ss = 0.f;
#pragma unroll
    for (int i = 0; i < 4; ++i) {
      v[i] = *(const f32x4*)(x + (size_t)t * 1024 + i * 256 + lane * 4);
      ss += v[i][0] * v[i][0] + v[i][1] * v[i][1] + v[i][2] * v[i][2] + v[i][3] * v[i][3];
    }
    ss = WSUM(ss);
    const float r = rsqrtf(ss * (1.f / 1024.f) + 1e-6f);
#pragma unroll
    for (int i = 0; i < 4; ++i) *(f32x4*)(x + (size_t)t * 1024 + i * 256 + lane * 4) = v[i] * r * *(const f32x4*)(fw + i * 256 + lane * 4);
  }
}

#define WSP(off) (P->ws + (off))
#define MODP ((float*)(P->ws + WS_MISC + MISC_MOD))
template <int l, int PASSNO>
__device__ __forceinline__ void layer_body(const int WID, unsigned char* lds, const XcdBarrier& bar) {
#define GSYNC() xcd_barrier(bar)

    { KP P = getp(); EpiIn<0> E{WSP(WS_B)}; run_gemm(WID, lds, (const bf16_t*)((const unsigned char*)P->out + 2048), (const bf16_t*)WSP(WS_W + W_IN), TOK, 2048, 512, E, 2048); }
    { KP P = getp(); EpiIn<1> E{WSP(WS_B)}; run_gemm(WID, lds, (const bf16_t*)((const unsigned char*)P->out + 2048), (const bf16_t*)(WSP(WS_W + W_IN) + (size_t)2048 * 1024), TOK, 1024, 512, E, 2048); }
    GSYNC();
    STAMP(3 + 12 * l);
    REPB(3,
    { KP P = getp(); gdn_prep(WID, P, l, lds); }
    STAMP(40 + 3 * l);
    { KP P = getp(); moba_kmean(WID, P, lds); }
    STAMP(41 + 3 * l);
    { KP P = getp(); s5_tables(WID, P, l, lds); }
    STAMP(42 + 3 * l);
    )
    GSYNC();
    STAMP(4 + 12 * l);
    if constexpr (PROBE_DUP == 40) {
      { KP P = getp(); gdn_scan(WID, P, lds); }
      { KP P = getp(); moba_select(WID, P, l, lds); }
      { KP P = getp(); s5_mfma(WID, P, l, lds); }
      { KP P = getp(); moba_attn2(WID, P, l, l * 2 + 1, lds); }
      GSYNC();
    }
    REPB(41,  KP P = getp(); gdn_scan(WID, P, lds); )
    STAMP(5 + 12 * l);
    { KP P = getp(); moba_select(WID, P, l, lds); }
    REPB(42,  KP P = getp(); s5_mfma(WID, P, l, lds); )
    STAMP(6 + 12 * l);
    REPB(43,  KP P = getp(); moba_attn2(WID, P, l, l * 2 + rep_, lds); )
    STAMP(7 + 12 * l);
    GSYNC();
    STAMP(8 + 12 * l);
    REPB(50, KP P = getp(); moba_combine(WID, P); )
    { KP P = getp(); gdn_outnorm(WID, P, l); }
    REPB(52,  KP P = getp(); EpiGlu E{(bf16_t*)WSP(WS_D + D_S5O), P->in[I_GLUB] + l * 512}; run_gemm(WID, lds, (const bf16_t*)WSP(WS_D + D_ZG), (const bf16_t*)WSP(WS_W + W_GLU), TOK, 512, 256, E); )
    GSYNC();
    STAMP(9 + 12 * l);
    REPB(6,
    { KP P = getp(); EpiGate E{(bf16_t*)WSP(WS_C + C_S)}; run_gemm(WID, lds, (const bf16_t*)((const unsigned char*)P->out + 2048), (const bf16_t*)(WSP(WS_W + W_G) + (size_t)0 * 1024 * 1024), TOK, 1024, 512, E, 2048); }
    { KP P = getp(); EpiMerge<true> E{(const bf16_t*)WSP(WS_C + C_S), (bf16_t*)WSP(WS_C + C_MERGED)}; run_gemm(WID, lds, (const bf16_t*)WSP(WS_D + D_GA), (const bf16_t*)WSP(WS_W + W_A), TOK, 1024, 512, E); }
    { KP P = getp(); EpiGate E{(bf16_t*)WSP(WS_C + C_S)}; run_gemm(WID, lds, (const bf16_t*)((const unsigned char*)P->out + 2048), (const bf16_t*)(WSP(WS_W + W_G) + (size_t)1 * 1024 * 1024), TOK, 1024, 512, E, 2048); }
    { KP P = getp(); EpiMerge<false> E{(const bf16_t*)WSP(WS_C + C_S), (bf16_t*)WSP(WS_C + C_MERGED)}; run_gemm(WID, lds, (const bf16_t*)WSP(WS_D + D_S5O), (const bf16_t*)WSP(WS_W + W_B), TOK, 1024, 256, E); }
    { KP P = getp(); EpiGate E{(bf16_t*)WSP(WS_C + C_S)}; run_gemm(WID, lds, (const bf16_t*)((const unsigned char*)P->out + 2048), (const bf16_t*)(WSP(WS_W + W_G) + (size_t)2 * 1024 * 1024), TOK, 1024, 512, E, 2048); }
    { KP P = getp(); EpiMerge<false> E{(const bf16_t*)WSP(WS_C + C_S), (bf16_t*)WSP(WS_C + C_MERGED)}; run_gemm(WID, lds, (const bf16_t*)WSP(WS_D + D_MO), (const bf16_t*)WSP(WS_W + W_C), TOK, 1024, 256, E); }
    )
    GSYNC();
    STAMP(10 + 12 * l);
    REPB(7, KP P = getp(); EpiOut<(l == 1)> E{l == 0 ? P->in[I_X] : P->out, P->out, MODP + (size_t)l * 8 * 6144 + 2048, dry_}; run_gemm(WID, lds, (const bf16_t*)WSP(WS_C + C_MERGED), (const bf16_t*)WSP(WS_W + W_OUT), TOK, 1024, 1024, E); )
    GSYNC();
    STAMP(11 + 12 * l);
    REPB(8,
    { KP P = getp(); phase_norm<true>(WID, P->out, nullptr, P->in[I_N2W] + l * 1024, MODP + (size_t)l * 8 * 6144, 3072, 4096, (bf16_t*)WSP(WS_A), nullptr, nullptr, lds); }
    { KP P = getp(); conv_flat8(WID, P->in[I_PU] + (size_t)l * 16384 * 1024, WSP(WS_D + D_TU8), (size_t)16384 * 1024, 64.f); }
    { KP P = getp(); conv_flat8(WID, P->in[I_PV] + (size_t)l * 16384 * 1024, WSP(WS_D + D_TV8), (size_t)16384 * 1024, 4.f); }
    if (l == 0) { KP P = getp(); phase_convert_weights(WID, P, 1, lds); }
    )
    GSYNC();
    STAMP(12 + 12 * l);
    REPB(9,  KP P = getp(); EpiScore E{(unsigned short*)WSP(WS_B + B_SCORE)}; run_gemm(WID, lds, (const bf16_t*)WSP(WS_A), (const bf16_t*)WSP(WS_W + W_EFF), TOK, 2048, 1024, E); )
    GSYNC();
    STAMP(13 + 12 * l);
    if (l == 0) { KP P = getp(); phase_weff(WID, P->in[I_WQ] + (size_t)1024 * 2048, P->in[I_K1] + (size_t)8 * 128 * 128, P->in[I_K2] + (size_t)8 * 128 * 128, (bf16_t*)WSP(WS_W + W_EFF), lds); }
    { KP P = getp(); peer_route(WID, P, lds); }
    GSYNC();
    STAMP(30 + 5 * l);
    REPB(101, KP P = getp(); peer_u(WID, P); )
    GSYNC();
    STAMP(31 + 5 * l);
    { KP P = getp(); peer_w(WID, P); }
    GSYNC();
    STAMP(32 + 5 * l);
    REPB(102, KP P = getp(); peer_v(WID, P, l, dry_); )
    GSYNC();
    STAMP(33 + 5 * l);
    { KP P = getp(); phase_resnorm(WID, P, l, lds); }
    GSYNC();
}

template <int PASSNO>
__device__ __forceinline__ void full_pass(const int WID, unsigned char* lds, const XcdBarrier& bar) {
#define GSYNC() xcd_barrier(bar)
  STAMP(0);
  REPB(0,
  { KP P = getp(); phase_mod(WID, P, lds); }
  { KP P = getp(); phase_convert_weights(WID, P, 0, lds); }
  { KP P = getp(); phase_weff(WID, P->in[I_WQ], P->in[I_K1], P->in[I_K2], (bf16_t*)WSP(WS_W + W_EFF), lds); }
  )
  GSYNC();
  STAMP(1);
  REPB(1,  KP P = getp(); phase_norm(WID, P->in[I_X], nullptr, P->in[I_N1W], MODP, 0, 1024, (bf16_t*)WSP(WS_A), P->in[I_WIN], (float*)WSP(WS_B + B_BA), lds, TOK, (unsigned char*)P->out + 2048); )
  GSYNC();
  STAMP(2);
  layer_body<0, PASSNO>(WID, lds, bar);
  STAMP(14);
  layer_body<1, PASSNO>(WID, lds, bar);
  STAMP(26);

}

__global__ void __launch_bounds__(NTHR) fwd_megakernel(Params p_unused) {
  extern __shared__ __attribute__((aligned(16))) unsigned char lds[];
  volatile LAS unsigned* bst = (volatile LAS unsigned*)(lds + LDS_BYTES - 16);
  if (threadIdx.x < 4) bst[threadIdx.x] = 0u;
  __syncthreads();
  const XcdBarrier bar = xcd_barrier_post((unsigned*)(getp()->ws + WS_MISC + MISC_BAR), bst);
#define GSYNC() xcd_barrier(bar)
  const int WID = __builtin_amdgcn_readfirstlane((int)(threadIdx.x >> 6));
#ifdef PROBE_TWICE
  full_pass<0>(WID, lds, bar);
  GSYNC();
  full_pass<1>(WID, lds, bar);
#else
  full_pass<1>(WID, lds, bar);
#endif
#ifdef PROBE_LO
  GSYNC();
  {
    const unsigned long long* ts = (const unsigned long long*)(getp()->ws + WS_MISC + MISC_TS);
    const float us = exp2f(floorf(log2f((float)(ts[PROBE_HI] - ts[PROBE_LO]) * 0.01f) * 4.f + PROBE_OFF) / 4.f);
    float* o = getp()->out;
    for (size_t i = (size_t)blockIdx.x * NTHR + lt(); i < (size_t)TOK * 1024; i += (size_t)gridDim.x * NTHR) o[i] = us;
  }
#endif
}

extern "C" void kernel_launch(void* const* d_in, const int* in_sizes, int n_in, void* d_out, int out_size, void* d_ws, size_t ws_size, hipStream_t stream) {
  static int grid_blocks = 0;
  if (grid_blocks == 0) {
    int dev = 0, cus = 0, per_cu = 0;
    if (ws_size < WS_END || n_in != 31) { fprintf(stderr, "kernel_launch: need %zu bytes of workspace, got %zu (n_in %d)\n", (size_t)WS_END, ws_size, n_in); grid_blocks = -1; return; }
    (void)hipGetDevice(&dev);
    (void)hipDeviceGetAttribute(&cus, hipDeviceAttributeMultiprocessorCount, dev);
    (void)hipFuncSetAttribute((const void*)fwd_megakernel, hipFuncAttributeMaxDynamicSharedMemorySize, LDS_BYTES);
    (void)hipOccupancyMaxActiveBlocksPerMultiprocessor(&per_cu, (const void*)fwd_megakernel, NTHR, LDS_BYTES);
    if (per_cu < 1) { fprintf(stderr, "kernel_launch: occupancy query says %d blocks per CU\n", per_cu); per_cu = 1; }
    grid_blocks = cus;
    fprintf(stderr, "kernel_launch: cus %d per_cu %d grid %d ws %zu\n", cus, per_cu, grid_blocks, ws_size);
  }
  if (grid_blocks < 0) return;
  Params p{};
  for (int i = 0; i < 31; ++i) p.in[i] = (const float*)d_in[i];
  p.out = (float*)d_out; p.ws = (unsigned char*)d_ws;
  (void)hipMemsetAsync((char*)d_ws + WS_MISC + MISC_BAR, 0, XCD_BAR_WORDS * 4, stream);
  void* args[] = {&p};
  hipError_t e = hipLaunchCooperativeKernel((const void*)fwd_megakernel, dim3(grid_blocks), dim3(NTHR), args, LDS_BYTES, stream);
  if (e != hipSuccess) fprintf(stderr, "cooperative launch failed: %s (grid %d)\n", hipGetErrorString(e), grid_blocks);
}
```
